# Optimizing an MI355X kernel written in HIP

```python
import math
import jax, jax.numpy as jnp
from jax import lax
import numpy as np

D_MODEL = 1024
BATCH = 16
SEQ = 2048
DEPTH = 4

GRID_W = 64
CTX_LEN = 256
HEAD_DIM = 64
NA_HEADS = D_MODEL // (2 * HEAD_DIM)
NA_WIN_H = 8
NA_WIN_W = 16
NA_COL_BLOCK = 16
NA_BAND_W = NA_COL_BLOCK + NA_WIN_W
DIFF_HEADS = D_MODEL // (4 * HEAD_DIM)
DIFF_DV = 2 * HEAD_DIM
Q_BLOCK = 128
A_W = NA_HEADS * HEAD_DIM
B_QK_W = DIFF_HEADS * 2 * HEAD_DIM
B_V_W = DIFF_HEADS * DIFF_DV
ATT_IN_W = 3 * A_W + 2 * B_QK_W + B_V_W
ATT_OUT_W = A_W + B_V_W
REC_HEADS = 8
REC_DK = D_MODEL // REC_HEADS
REC_DV = D_MODEL // REC_HEADS
REC_CHUNK = 32
REC_IN_W = 5 * D_MODEL
N_EXPERTS = 16
EXPERT_FF = 2 * D_MODEL
EC_CAPACITY_FACTOR = 2
ROPE_THETA = 10000.0
NORM_EPS = 1e-6
NEG_INF = -1e30
N_EVEN = (DEPTH + 1) // 2
N_ODD = DEPTH // 2

kernel_name = 'hybrid_na_diffattn_hgrn2_ec_dit'


def rmsnorm(x, g):
    xf = x.astype(jnp.float32)
    y = xf * lax.rsqrt(jnp.mean(xf * xf, axis=-1, keepdims=True) + NORM_EPS)
    return (y * g.astype(jnp.float32)).astype(x.dtype)


def modulation(cvec, w_mod, b_mod):
    m = jnp.einsum('...d,de->...e', jax.nn.silu(cvec), w_mod) + b_mod
    return jnp.split(m, 6, axis=-1)


def _split_heads(a, n_heads):
    b, t, _ = a.shape
    return jnp.transpose(a.reshape(b, t, n_heads, -1), (0, 2, 1, 3))


def _split_pair_heads(a):
    b, t, _ = a.shape
    return jnp.transpose(a.reshape(b, t, DIFF_HEADS, 2, HEAD_DIM), (0, 2, 3, 1, 4))


def _merge_heads(a):
    b, h, t, d = a.shape
    return jnp.transpose(a, (0, 2, 1, 3)).reshape(b, t, h * d)


def axial_rope(n, dim):
    t = jnp.arange(n, dtype=jnp.int32)
    rows = (t // GRID_W).astype(jnp.float32)
    cols = (t % GRID_W).astype(jnp.float32)
    n_freq = dim // 4
    inv = ROPE_THETA ** (-jnp.arange(n_freq, dtype=jnp.float32) / n_freq)
    ang = jnp.concatenate([rows[:, None] * inv, cols[:, None] * inv], axis=-1)
    return jnp.cos(ang), jnp.sin(ang)


def apply_rope(a, cos, sin):
    a1, a2 = jnp.split(a, 2, axis=-1)
    cos = cos.astype(a.dtype)
    sin = sin.astype(a.dtype)
    return jnp.concatenate([a1 * cos - a2 * sin, a2 * cos + a1 * sin], axis=-1)


def _softmax_attend(q, k, v, scale):
    s = jnp.einsum('bhqd,bhkd->bhqk', q, k).astype(jnp.float32) * scale
    p = jax.nn.softmax(s, axis=-1).astype(v.dtype)
    return jnp.einsum('bhqk,bhkd->bhqd', p, v)


def _diff_attend(q12, k12, v, lam, scale):
    s = jnp.einsum('bhmqd,bhmkd->bhmqk', q12, k12).astype(jnp.float32) * scale
    p = jax.nn.softmax(s, axis=-1)
    a = (p[:, :, 0] - lam * p[:, :, 1]).astype(v.dtype)
    return jnp.einsum('bhqk,bhkd->bhqd', a, v)


def diff_attention_latent(q12, k12_all, v_all, lam, scale):
    b, h, _, n, d = q12.shape
    nb = n // Q_BLOCK
    qb = jnp.moveaxis(q12.reshape(b, h, 2, nb, Q_BLOCK, d), 3, 0)
    o = lax.map(lambda qi: _diff_attend(qi, k12_all, v_all, lam, scale), qb)
    return jnp.moveaxis(o, 0, 2).reshape(b, h, n, -1)


def neighbourhood_attention(q, k, v, k_ctx, v_ctx, rpb):
    b, h, n, d = q.shape
    rows = n // GRID_W
    kh = min(NA_WIN_H, rows)
    n_cb = GRID_W // NA_COL_BLOCK
    scale = d ** -0.5
    qcol = np.arange(GRID_W).reshape(n_cb, NA_COL_BLOCK)
    cstart = np.clip(qcol - NA_WIN_W // 2, 0, GRID_W - NA_WIN_W)
    bstart = np.clip(np.arange(n_cb) * NA_COL_BLOCK - NA_WIN_W // 2, 0, GRID_W - NA_BAND_W)
    kcol = bstart[:, None] + np.arange(NA_BAND_W)[None, :]
    col_ok = (kcol[:, None, :] >= cstart[:, :, None]) & (kcol[:, None, :] < cstart[:, :, None] + NA_WIN_W)
    mask = jnp.asarray(np.broadcast_to(col_ok[:, :, None, :], (n_cb, NA_COL_BLOCK, kh, NA_BAND_W)).reshape(n_cb, NA_COL_BLOCK, kh * NA_BAND_W))
    dcol = np.clip(kcol[:, None, :] - qcol[:, :, None] + NA_WIN_W - 1, 0, 2 * NA_WIN_W - 2)
    rpb_c = rpb[:, :, dcol]
    kg = k.reshape(b, h, rows, GRID_W, d)
    vg = v.reshape(b, h, rows, GRID_W, d)
    qg = jnp.moveaxis(q.reshape(b, h, rows, n_cb, NA_COL_BLOCK, d), 2, 0)
    n_loc = kh * NA_BAND_W

    def one_row(args):
        q_r, r = args
        rs = jnp.clip(r - kh // 2, 0, rows - kh)
        k_band = lax.dynamic_slice_in_dim(kg, rs, kh, axis=2)[:, :, :, kcol]
        v_band = lax.dynamic_slice_in_dim(vg, rs, kh, axis=2)[:, :, :, kcol]
        k_band = jnp.moveaxis(k_band, 3, 2).reshape(b, h, n_cb, n_loc, d)
        v_band = jnp.moveaxis(v_band, 3, 2).reshape(b, h, n_cb, n_loc, d)
        bias = jnp.take(rpb_c, rs - r + jnp.arange(kh, dtype=jnp.int32) + NA_WIN_H - 1, axis=1)
        bias = jnp.transpose(bias, (0, 2, 3, 1, 4)).reshape(h, n_cb, NA_COL_BLOCK, n_loc)
        s_loc = jnp.einsum('bhjqd,bhjkd->bhjqk', q_r, k_band).astype(jnp.float32) * scale + bias.astype(jnp.float32)
        s_loc = jnp.where(mask, s_loc, NEG_INF)
        s_ctx = jnp.einsum('bhjqd,bhkd->bhjqk', q_r, k_ctx).astype(jnp.float32) * scale
        p = jax.nn.softmax(jnp.concatenate([s_loc, s_ctx], axis=-1), axis=-1).astype(v.dtype)
        return (jnp.einsum('bhjqk,bhjkd->bhjqd', p[..., :n_loc], v_band)
                + jnp.einsum('bhjqk,bhkd->bhjqd', p[..., n_loc:], v_ctx))

    o = lax.map(one_row, (qg, jnp.arange(rows, dtype=jnp.int32)))
    return jnp.moveaxis(o, 0, 2).reshape(b, h, n, d)


def even_layer_mixer(h_lat, h_ctx, w_in, w_out, rpb, lam_vecs, subln_g, layer_idx, with_ctx_out):
    n = h_lat.shape[1]
    scale = HEAD_DIM ** -0.5
    kv_off = A_W + B_QK_W
    kv_splits = [A_W, 2 * A_W, 2 * A_W + B_QK_W]
    p_lat = jnp.einsum('btd,de->bte', h_lat, w_in)
    q_a, q_b, kv_lat = jnp.split(p_lat, [A_W, kv_off], axis=-1)
    if with_ctx_out:
        p_ctx = jnp.einsum('btd,de->bte', h_ctx, w_in)
        q_ac, q_bc, kv_ctx = jnp.split(p_ctx, [A_W, kv_off], axis=-1)
    else:
        kv_ctx = jnp.einsum('btd,de->bte', h_ctx, w_in[:, kv_off:])
    k_a, v_a, k_b, v_b = jnp.split(kv_lat, kv_splits, axis=-1)
    k_ac, v_ac, k_bc, v_bc = jnp.split(kv_ctx, kv_splits, axis=-1)
    k_ac = _split_heads(k_ac, NA_HEADS)
    v_ac = _split_heads(v_ac, NA_HEADS)

    o_a = neighbourhood_attention(_split_heads(q_a, NA_HEADS), _split_heads(k_a, NA_HEADS),
                                  _split_heads(v_a, NA_HEADS), k_ac, v_ac, rpb)

    lam_init = 0.8 - 0.6 * math.exp(-0.3 * layer_idx)
    lv = lam_vecs.astype(jnp.float32)
    lam = jnp.exp(jnp.sum(lv[0] * lv[1])) - jnp.exp(jnp.sum(lv[2] * lv[3])) + lam_init
    cos, sin = axial_rope(n, HEAD_DIM)
    k12_ctx = _split_pair_heads(k_bc)
    v_ctx_b = _split_heads(v_bc, DIFF_HEADS)
    q12 = apply_rope(_split_pair_heads(q_b), cos, sin)
    k12_all = jnp.concatenate([apply_rope(_split_pair_heads(k_b), cos, sin), k12_ctx], axis=3)
    v_all = jnp.concatenate([_split_heads(v_b, DIFF_HEADS), v_ctx_b], axis=2)
    o_b = rmsnorm(diff_attention_latent(q12, k12_all, v_all, lam, scale), subln_g) * (1.0 - lam_init)
    y_lat = jnp.einsum('bte,ed->btd', jnp.concatenate([_merge_heads(o_a), _merge_heads(o_b)], axis=-1), w_out)
    if not with_ctx_out:
        return y_lat, None
    o_ac = _softmax_attend(_split_heads(q_ac, NA_HEADS), k_ac, v_ac, scale)
    o_bc = rmsnorm(_diff_attend(_split_pair_heads(q_bc), k12_ctx, v_ctx_b, lam, scale), subln_g) * (1.0 - lam_init)
    y_ctx = jnp.einsum('bte,ed->btd', jnp.concatenate([_merge_heads(o_ac), _merge_heads(o_bc)], axis=-1), w_out)
    return y_lat, y_ctx


def _hgrn_gates(fx, lb):
    lbb = lb[None, :, None, :]
    logf = jnp.logaddexp(jnp.log(lbb), jnp.log1p(-lbb) + jax.nn.log_sigmoid(fx))
    k = (1.0 - lbb) * jax.nn.sigmoid(-fx)
    return k, logf


def hgrn2_chunk_scan(k, v, logf, s0, q):
    b, h, t, dk = k.shape
    nc = t // REC_CHUNK
    tri = jnp.asarray(np.tril(np.ones((REC_CHUNK, REC_CHUNK), dtype=bool)))

    def chunks(a):
        return jnp.moveaxis(a.reshape(b, h, nc, REC_CHUNK, a.shape[-1]), 2, 0)

    def body(s, xs):
        kc, vc, gc = xs[0], xs[1], xs[2]
        bcum = jnp.cumsum(gc, axis=2)
        blast = bcum[:, :, -1:, :]
        s_new = jnp.exp(blast[:, :, 0])[..., None] * s + jnp.einsum('bhcd,bhce->bhde', kc * jnp.exp(blast - bcum), vc)
        if q is None:
            return s_new, None
        qc = xs[3]
        rel = jnp.where(tri[None, None, :, :, None], bcum[:, :, :, None, :] - bcum[:, :, None, :, :], -jnp.inf)
        scores = jnp.einsum('bhtsd,bhsd->bhts', qc[:, :, :, None, :] * jnp.exp(rel), kc)
        o = jnp.einsum('bhtd,bhde->bhte', qc * jnp.exp(bcum), s) + jnp.einsum('bhts,bhse->bhte', scores, vc)
        return s_new, o

    xs = (chunks(k), chunks(v), chunks(logf)) + ((chunks(q),) if q is not None else ())
    s_fin, o = lax.scan(body, s0, xs)
    if q is not None:
        o = jnp.moveaxis(o, 0, 2).reshape(b, h, t, -1)
    return o, s_fin


def _hgrn_out(o, g, gnorm_g, w_out, dtype):
    o = _merge_heads(rmsnorm(o, gnorm_g)).astype(dtype) * jax.nn.silu(g)
    return jnp.einsum('bte,ed->btd', o, w_out)


def odd_layer_mixer(h_lat, h_ctx, w_in, w_out, lb_fwd, lb_bwd, gnorm_g, with_ctx_out):
    f32 = jnp.float32
    heads = lambda a: _split_heads(a, REC_HEADS).astype(f32)
    flip = lambda a: jnp.flip(a, axis=2)
    lb_f = lb_fwd.reshape(REC_HEADS, REC_DK)
    lb_b = lb_bwd.reshape(REC_HEADS, REC_DK)
    q, ff, fb, inp, g = jnp.split(jnp.einsum('btd,de->bte', h_lat, w_in), 5, axis=-1)
    if with_ctx_out:
        qc, ffc, fbc, inpc, gc = jnp.split(jnp.einsum('btd,de->bte', h_ctx, w_in), 5, axis=-1)
        qc = jax.nn.silu(heads(qc))
    else:
        ffc, fbc, inpc = jnp.split(jnp.einsum('btd,de->bte', h_ctx, w_in[:, D_MODEL:4 * D_MODEL]), 3, axis=-1)
        qc = None
    vc = heads(inpc)
    kcf, gcf = _hgrn_gates(heads(ffc), lb_f)
    kcb, gcb = _hgrn_gates(heads(fbc), lb_b)
    s0 = jnp.zeros((h_ctx.shape[0], REC_HEADS, REC_DK, REC_DV), f32)
    o_cf, s_cf = hgrn2_chunk_scan(kcf, vc, gcf, s0, qc)
    o_cb, s_cb = hgrn2_chunk_scan(flip(kcb), flip(vc), flip(gcb), s0, None if qc is None else flip(qc))
    ql = jax.nn.silu(heads(q))
    vl = heads(inp)
    klf, glf = _hgrn_gates(heads(ff), lb_f)
    klb, glb = _hgrn_gates(heads(fb), lb_b)
    o_lf, _ = hgrn2_chunk_scan(klf, vl, glf, s_cf, ql)
    o_lb, _ = hgrn2_chunk_scan(flip(klb), flip(vl), flip(glb), s_cb, flip(ql))
    y_lat = _hgrn_out(o_lf + flip(o_lb), g, gnorm_g, w_out, h_lat.dtype)
    if not with_ctx_out:
        return y_lat, None
    y_ctx = _hgrn_out(o_cf + flip(o_cb), gc, gnorm_g, w_out, h_ctx.dtype)
    return y_lat, y_ctx


def expert_choice_ffn(h, w_router, w_gate, w_up, w_down):
    b, t, d = h.shape
    cap = EC_CAPACITY_FACTOR * t // N_EXPERTS
    aff = jax.nn.softmax(jnp.einsum('btd,de->bte', h, w_router).astype(jnp.float32), axis=-1)
    gate, idx = lax.top_k(jnp.swapaxes(aff, 1, 2), cap)
    x_sel = jax.vmap(lambda hb, ib: hb[ib])(h, idx)
    hid = jax.nn.silu(jnp.einsum('becd,edf->becf', x_sel, w_gate)) * jnp.einsum('becd,edf->becf', x_sel, w_up)
    y_sel = jnp.einsum('becf,efd->becd', hid, w_down) * gate[..., None].astype(h.dtype)
    return jax.vmap(lambda ib, yb: jnp.zeros((t, d), h.dtype).at[ib.reshape(-1)].add(yb.reshape(-1, d)))(idx, y_sel)


def setup_inputs(seed: int = 0) -> dict:
    key = jax.random.key(seed)
    ks = jax.random.split(key, 21)
    f32 = jnp.float32

    def nrm(k, shape, std):
        return jax.random.normal(k, shape, f32) * std

    def gain(k, shape):
        return 1.0 + 0.02 * jax.random.normal(k, shape, f32)

    return {
        'x': nrm(ks[0], (BATCH, SEQ, D_MODEL), 1.0),
        'c': nrm(ks[1], (BATCH, D_MODEL), 1.0),
        'ctx': nrm(ks[2], (BATCH, CTX_LEN, D_MODEL), 1.0),
        'c_ctx': nrm(ks[3], (D_MODEL,), 1.0),
        'w_mod': nrm(ks[4], (DEPTH, D_MODEL, 6 * D_MODEL), 0.5 * D_MODEL ** -0.5),
        'b_mod': nrm(ks[5], (DEPTH, 6 * D_MODEL), 0.02),
        'norm_g': gain(ks[6], (DEPTH, 2, D_MODEL)),
        'att_w_in': nrm(ks[7], (N_EVEN, D_MODEL, ATT_IN_W), D_MODEL ** -0.5),
        'att_w_out': nrm(ks[8], (N_EVEN, ATT_OUT_W, D_MODEL), ATT_OUT_W ** -0.5),
        'na_rpb': nrm(ks[9], (N_EVEN, NA_HEADS, 2 * NA_WIN_H - 1, 2 * NA_WIN_W - 1), 0.1),
        'diff_lambda': nrm(ks[10], (N_EVEN, 4, HEAD_DIM), 0.1),
        'diff_subln_g': gain(ks[11], (N_EVEN, DIFF_DV)),
        'rec_w_in': nrm(ks[12], (N_ODD, D_MODEL, REC_IN_W), D_MODEL ** -0.5),
        'rec_w_out': nrm(ks[13], (N_ODD, D_MODEL, D_MODEL), D_MODEL ** -0.5),
        'rec_lb_logits': 1.0 + 0.1 * jax.random.normal(ks[14], (2, DEPTH, D_MODEL), f32),
        'rec_gnorm_g': gain(ks[15], (N_ODD, REC_DV)),
        'moe_router': nrm(ks[16], (DEPTH, D_MODEL, N_EXPERTS), D_MODEL ** -0.5),
        'moe_w_gate': nrm(ks[17], (DEPTH, N_EXPERTS, D_MODEL, EXPERT_FF), D_MODEL ** -0.5),
        'moe_w_up': nrm(ks[18], (DEPTH, N_EXPERTS, D_MODEL, EXPERT_FF), D_MODEL ** -0.5),
        'moe_w_down': nrm(ks[19], (DEPTH, N_EXPERTS, EXPERT_FF, D_MODEL), EXPERT_FF ** -0.5),
        'final_g': gain(ks[20], (D_MODEL,)),
    }


def reference(x, c, ctx, c_ctx, w_mod, b_mod, norm_g, att_w_in, att_w_out, na_rpb, diff_lambda,
              diff_subln_g, rec_w_in, rec_w_out, rec_lb_logits, rec_gnorm_g, moe_router, moe_w_gate,
              moe_w_up, moe_w_down, final_g):
    sm = jax.nn.softmax(rec_lb_logits.astype(jnp.float32), axis=1)
    lower_bounds = jnp.cumsum(sm, axis=1) - sm[:, :1]
    for l in range(DEPTH):
        last = l == DEPTH - 1
        sh1, sc1, g1, sh2, sc2, g2 = [m[:, None, :] for m in modulation(c, w_mod[l], b_mod[l])]
        csh1, csc1, cg1, csh2, csc2, cg2 = modulation(c_ctx, w_mod[l], b_mod[l])
        h_lat = rmsnorm(x, norm_g[l, 0]) * (1.0 + sc1) + sh1
        h_ctx = rmsnorm(ctx, norm_g[l, 0]) * (1.0 + csc1) + csh1
        if l % 2 == 0:
            e = l // 2
            y_lat, y_ctx = even_layer_mixer(h_lat, h_ctx, att_w_in[e], att_w_out[e], na_rpb[e],
                                            diff_lambda[e], diff_subln_g[e], l, not last)
        else:
            o = l // 2
            y_lat, y_ctx = odd_layer_mixer(h_lat, h_ctx, rec_w_in[o], rec_w_out[o], lower_bounds[0, l],
                                           lower_bounds[1, l], rec_gnorm_g[o], not last)
        x = x + g1 * y_lat
        x = x + g2 * expert_choice_ffn(rmsnorm(x, norm_g[l, 1]) * (1.0 + sc2) + sh2,
                                       moe_router[l], moe_w_gate[l], moe_w_up[l], moe_w_down[l])
        if not last:
            ctx = ctx + cg1 * y_ctx
            ctx = ctx + cg2 * expert_choice_ffn(rmsnorm(ctx, norm_g[l, 1]) * (1.0 + csc2) + csh2,
                                                moe_router[l], moe_w_gate[l], moe_w_up[l], moe_w_down[l])
    return rmsnorm(x, final_g)
```

```cpp
#include <hip/hip_runtime.h>
#include <cstdio>
#include <cstdint>

constexpr int DM = 1024, NB = 16, SEQ = 2048, CTXL = 256, DEPTH = 4;
constexpr int RL = NB * SEQ;
constexpr int RC = NB * CTXL;
constexpr int RT = RL + RC;
constexpr int NEXP = 16, FFD = 2048, CAPL = 256, CAPC = 32;
constexpr int XT_E = 18;
constexpr int XR_E = XT_E * 256;
constexpr int XR = NEXP * XR_E;
constexpr int LD_EVEN = 3072, LD_ODD = 5120;
constexpr float NORM_EPS = 1e-6f;
constexpr int NWAVES = 8, NTHR = 512;
#ifndef IN8_EVEN
#define IN8_EVEN 1
#endif
#ifndef IN8_ODD
#define IN8_ODD 0
#endif
constexpr bool IN8E = IN8_EVEN != 0, IN8O = IN8_ODD != 0;

namespace pg8 {
#define PG8_LAS __attribute__((address_space(3)))
typedef unsigned short bf16_t;
typedef short bf16x8 __attribute__((ext_vector_type(8)));
typedef float f32x4 __attribute__((ext_vector_type(4)));
typedef unsigned u32x4 __attribute__((ext_vector_type(4)));
typedef int v4i_t __attribute__((ext_vector_type(4)));
typedef int v8i_t __attribute__((ext_vector_type(8)));
constexpr int BM = 256, BK = 64, HALF = 128, HTB = HALF * BK * 2  , STAGE_BYTES = 8 * HTB, NXCD = 8, WGM = 8;

__host__ __device__ __forceinline__ int lds_byte(int r, int c) { const int st = (r >> 4) * 2 + (c >> 5), rr = r & 15, cc = c & 31, ob = rr * 64 + cc * 2; return st * 1024 + (ob ^ (((ob >> 9) & 1) << 5)); }
__host__ __device__ __forceinline__ void stage_rc(int b, int& R, int& C) { const int st = b / 1024, sb = b % 1024, swz = sb ^ (((sb >> 9) & 1) << 5); R = (st >> 1) * 16 + swz / 64; C = (st & 1) * 32 + (swz % 64) / 2; }
__host__ __device__ __forceinline__ int perm32(int rho) { const int n = rho >> 4, i = rho & 15; return 8 * (i >> 2) + 4 * n + (i & 3); }

struct Unit { int pm, pn; };
struct Gemm { const bf16_t* A; const bf16_t* Bt; int M, N, K; };
typedef __bf16 bf16x2_t __attribute__((ext_vector_type(2)));
typedef float f32x2_t __attribute__((ext_vector_type(2)));
__device__ __forceinline__ unsigned cvt_pk_bf16(float lo, float hi) { const f32x2_t v = {lo, hi}; const bf16x2_t b = __builtin_convertvector(v, bf16x2_t); return __builtin_bit_cast(unsigned, b); }
typedef unsigned u32x2 __attribute__((ext_vector_type(2)));
typedef float f32x2 __attribute__((ext_vector_type(2)));
__device__ __forceinline__ u32x2 pk4(f32x4 v) { u32x2 w; w.x = cvt_pk_bf16(v[0], v[1]); w.y = cvt_pk_bf16(v[2], v[3]); return w; }
__device__ __forceinline__ float silu_f(float x) { return x * __builtin_amdgcn_rcpf(1.0f + __builtin_amdgcn_exp2f(-1.4426950408889634f * x)); }

constexpr float FP8_ACT = 8.0f, FP8_WGT = 64.0f, FP8_UNSCALE = 1.0f / (FP8_ACT * FP8_WGT);
__device__ __forceinline__ float clamp448(float v) { return __builtin_amdgcn_fmed3f(v, -448.0f, 448.0f); }
__device__ __forceinline__ unsigned pack4_fp8(float a, float b, float c, float d) { unsigned v = 0u; v = __builtin_amdgcn_cvt_pk_fp8_f32(clamp448(a), clamp448(b), v, false); v = __builtin_amdgcn_cvt_pk_fp8_f32(clamp448(c), clamp448(d), v, true); return v; }
__device__ __forceinline__ int xcd_remap(int L, int nwg) { const int q = nwg / NXCD, r = nwg % NXCD, xcd = L % NXCD, off = L / NXCD; return (xcd < r ? xcd * (q + 1) : r * (q + 1) + (xcd - r) * q) + off; }
__device__ __forceinline__ void grp8(int wgid, int nM, int nN, int& pm, int& pn) { const int nig = WGM * nN, gid = wgid / nig, fm = gid * WGM, gsz = (nM - fm) < WGM ? (nM - fm) : WGM; pm = fm + ((wgid % nig) % gsz); pn = (wgid % nig) / gsz; }
struct RectOrder {
    int nMA, nNA, pmA, pnA, nA, nMB, nNB, pmB, pnB, nB, G, c;
    __device__ __forceinline__ void init(int nMA_, int nNA_, int pmA_, int pnA_, int nMB_, int nNB_, int pmB_, int pnB_, int G_, int c_) {
        nMA = nMA_; nNA = nNA_; pmA = pmA_; pnA = pnA_; nA = nMA_ * nNA_; nMB = nMB_; nNB = nNB_; pmB = pmB_; pnB = pnB_; nB = nMB_ * nNB_; G = G_; c = c_; }
    __device__ __forceinline__ bool next(int i, Unit& u) const {
        long L = (long)i * G + c; int pm, pn;
        if (L < nA) { grp8(xcd_remap((int)L, nA), nMA, nNA, pm, pn); u.pm = pmA + pm; u.pn = pnA + pn; return true; }
        L -= nA; if (L < nB) { grp8(xcd_remap((int)L, nB), nMB, nNB, pm, pn); u.pm = pmB + pm; u.pn = pnB + pn; return true; }
        return false;
    }
    __device__ __forceinline__ void a_ready(const Unit&) const {}
    __device__ __forceinline__ void done(const Unit&) const {}
};
struct Rect3Order {
    int nM[3], nN[3], pm0[3], pn0[3], n[3], G, c;
    __device__ __forceinline__ void init(int nMA, int nNA, int pmA, int pnA, int nMB, int nNB, int pmB, int pnB, int nMC, int nNC, int pmC, int pnC, int G_, int c_) {
        nM[0] = nMA; nN[0] = nNA; pm0[0] = pmA; pn0[0] = pnA; nM[1] = nMB; nN[1] = nNB; pm0[1] = pmB; pn0[1] = pnB; nM[2] = nMC; nN[2] = nNC; pm0[2] = pmC; pn0[2] = pnC;
        n[0] = nMA * nNA; n[1] = nMB * nNB; n[2] = nMC * nNC; G = G_; c = c_; }
    __device__ __forceinline__ bool next(int i, Unit& u) const {
        long L = (long)i * G + c; int pm, pn;
        if (L < n[0]) { grp8(xcd_remap((int)L, n[0]), nM[0], nN[0], pm, pn); u.pm = pm0[0] + pm; u.pn = pn0[0] + pn; return true; }
        L -= n[0]; if (L < n[1]) { grp8(xcd_remap((int)L, n[1]), nM[1], nN[1], pm, pn); u.pm = pm0[1] + pm; u.pn = pn0[1] + pn; return true; }
        L -= n[1]; if (L < n[2]) { grp8(xcd_remap((int)L, n[2]), nM[2], nN[2], pm, pn); u.pm = pm0[2] + pm; u.pn = pn0[2] + pn; return true; }
        return false;
    }
    __device__ __forceinline__ void a_ready(const Unit&) const {}
    __device__ __forceinline__ void done(const Unit&) const {}
};
struct MoeOrder {
    int nj, npn, per_e, total, G, c;
    __device__ __forceinline__ void init(int nj_, int npn_, int G_, int c_) { nj = nj_; npn = npn_; per_e = nj_ * npn_; total = 16 * per_e; G = G_; c = c_; }
    __device__ __forceinline__ bool next(int i, Unit& u) const {
        const long L = (long)i * G + c; if (L >= total) return false;
        const int wgid = xcd_remap((int)L, total), e = wgid / per_e, r = wgid % per_e; int j, pn; grp8(r, nj, npn, j, pn);
        u.pm = e * 18 + j; u.pn = e * npn + pn; return true;
    }
    __device__ __forceinline__ void a_ready(const Unit&) const {}
    __device__ __forceinline__ void done(const Unit&) const {}
};


template <bool F8> struct EpiEvenIn {
    static constexpr bool PERM = false, AFTER_DRAIN = false; static constexpr float US = F8 ? FP8_UNSCALE : 1.0f;
    bf16_t* P;
    __device__ __forceinline__ void operator()(const f32x4 (&acc)[2][2][4][2], const Unit& u, int wr, int wc, int fr, int fq) const {
        const int pn = u.pn; const bool ropet = (pn == 2) | (pn == 3) | (pn == 8) | (pn == 9); const bool latent = u.pm < 128;
        const int row0 = u.pm * BM + wr * 64 + fr;
        if (!ropet) {
            const int col0 = pn * BM + wc * 32 + 8 * fq;
#pragma unroll
            for (int ai = 0; ai < 2; ++ai)
#pragma unroll
                for (int m = 0; m < 4; ++m) { bf16_t* rowp = P + (size_t)(row0 + ai * HALF + m * 16) * 3072 + col0;
#pragma unroll
                    for (int bj = 0; bj < 2; ++bj) { const u32x2 a = pk4(F8 ? acc[ai][bj][m][0] * US : acc[ai][bj][m][0]), b = pk4(F8 ? acc[ai][bj][m][1] * US : acc[ai][bj][m][1]); *(u32x4*)(rowp + bj * HALF) = (u32x4){a.x, a.y, b.x, b.y}; } }
        } else {
            const int col0 = pn * BM + (wc >> 1) * 64 + (wc & 1) * 16 + 4 * fq;
            float ir[4];
#pragma unroll
            for (int i = 0; i < 4; ++i) ir[i] = __builtin_amdgcn_exp2f(-(float)(4 * fq + i) * 0.8304820237218406f) * 0.15915494309189535f;
#pragma unroll
            for (int ai = 0; ai < 2; ++ai)
#pragma unroll
                for (int m = 0; m < 4; ++m) { const int row = row0 + ai * HALF + m * 16; const int t = row & 2047; const float pos = (float)((wc & 1) ? (t & 63) : (t >> 6));
                    f32x4 cs, sn;
#pragma unroll
                    for (int i = 0; i < 4; ++i) { float rev = pos * ir[i]; rev -= __builtin_rintf(rev); sn[i] = latent ? (F8 ? __builtin_amdgcn_sinf(rev) * US : __builtin_amdgcn_sinf(rev)) : 0.f; cs[i] = latent ? (F8 ? __builtin_amdgcn_cosf(rev) * US : __builtin_amdgcn_cosf(rev)) : US; }
                    bf16_t* rowp = P + (size_t)row * 3072 + col0;
#pragma unroll
                    for (int bj = 0; bj < 2; ++bj) { const f32x4 a1 = acc[ai][bj][m][0], a2 = acc[ai][bj][m][1];
                        *(u32x2*)(rowp + bj * HALF) = pk4(a1 * cs - a2 * sn); *(u32x2*)(rowp + bj * HALF + 32) = pk4(a2 * cs + a1 * sn); } }
        }
    }
};
template <bool F8> struct EpiOddIn {
    static constexpr bool PERM = false, AFTER_DRAIN = false; static constexpr float US = F8 ? FP8_UNSCALE : 1.0f;
    bf16_t* P; int pn_off;
    __device__ __forceinline__ void operator()(const f32x4 (&acc)[2][2][4][2], const Unit& u, int wr, int wc, int fr, int fq) const {
        const int pn = u.pn + pn_off; const int act = ((pn < 4) | (pn >= 16)) ? 1 : (pn < 12 ? 2 : 0);
        const int row0 = u.pm * BM + wr * 64 + fr, col0 = pn * BM + wc * 32 + 8 * fq;
#pragma unroll
        for (int ai = 0; ai < 2; ++ai)
#pragma unroll
            for (int m = 0; m < 4; ++m) { bf16_t* rowp = P + (size_t)(row0 + ai * HALF + m * 16) * 5120 + col0;
#pragma unroll
                for (int bj = 0; bj < 2; ++bj) { f32x4 v0 = acc[ai][bj][m][0], v1 = acc[ai][bj][m][1]; if (F8) { v0 *= US; v1 *= US; }
                    if (act) {
#pragma unroll
                        for (int i = 0; i < 4; ++i) { const float s0 = __builtin_amdgcn_rcpf(1.0f + __builtin_amdgcn_exp2f(-1.4426950408889634f * v0[i])), s1 = __builtin_amdgcn_rcpf(1.0f + __builtin_amdgcn_exp2f(-1.4426950408889634f * v1[i]));
                            v0[i] = (act == 1) ? v0[i] * s0 : s0; v1[i] = (act == 1) ? v1[i] * s1 : s1; } }
                    const u32x2 a = pk4(v0), b = pk4(v1); *(u32x4*)(rowp + bj * HALF) = (u32x4){a.x, a.y, b.x, b.y}; } }
    }
};
struct EpiOutRes {
    static constexpr bool PERM = false, AFTER_DRAIN = false;
    const float* srcL; const float* srcC; bf16_t* X; const float* gmod; bool src32;
    __device__ __forceinline__ void operator()(const f32x4 (&acc)[2][2][4][2], const Unit& u, int wr, int wc, int fr, int fq) const {
        const bool latent = u.pm < 128; const int bidx = latent ? (u.pm >> 3) : 16;
        const int row0 = u.pm * BM + wr * 64 + fr, col0 = u.pn * BM + wc * 32 + 8 * fq;
        const float* src = latent ? srcL : srcC - (size_t)32768 * 1024;
        f32x4 gv[2][2];
#pragma unroll
        for (int bj = 0; bj < 2; ++bj)
#pragma unroll
            for (int n = 0; n < 2; ++n) gv[bj][n] = *(const f32x4*)(gmod + (size_t)bidx * 6144 + col0 + bj * HALF + n * 4);
#pragma unroll
        for (int ai = 0; ai < 2; ++ai)
#pragma unroll
            for (int m = 0; m < 4; ++m) { const size_t off = (size_t)(row0 + ai * HALF + m * 16) * 1024 + col0;
#pragma unroll
                for (int bj = 0; bj < 2; ++bj) { f32x4 s0, s1;
                    if (src32) { s0 = *(const f32x4*)(src + off + bj * HALF); s1 = *(const f32x4*)(src + off + bj * HALF + 4); }
                    else { const u32x4 w = *(const u32x4*)(X + off + bj * HALF); s0 = (f32x4){__builtin_bit_cast(float, w.x << 16), __builtin_bit_cast(float, w.x & 0xffff0000u), __builtin_bit_cast(float, w.y << 16), __builtin_bit_cast(float, w.y & 0xffff0000u)};
                        s1 = (f32x4){__builtin_bit_cast(float, w.z << 16), __builtin_bit_cast(float, w.z & 0xffff0000u), __builtin_bit_cast(float, w.w << 16), __builtin_bit_cast(float, w.w & 0xffff0000u)}; }
                    const u32x2 a = pk4(s0 + gv[bj][0] * acc[ai][bj][m][0]), b = pk4(s1 + gv[bj][1] * acc[ai][bj][m][1]); *(u32x4*)(X + off + bj * HALF) = (u32x4){a.x, a.y, b.x, b.y}; }
                asm volatile("" ::: "memory"); }
    }
};
struct EpiSwiGLU {
    static constexpr bool PERM = false, AFTER_DRAIN = false;
    unsigned char* HID;
    __device__ __forceinline__ void operator()(const f32x4 (&acc)[2][2][4][2], const Unit& u, int wr, int wc, int fr, int fq) const {
        const int pnl = u.pn & 15; const int row0 = u.pm * BM + wr * 64 + fr, col0 = pnl * 128 + wc * 32 + 8 * fq;
        constexpr float KA = -1.4426950408889634f * FP8_UNSCALE, KB = FP8_UNSCALE * FP8_UNSCALE * FP8_ACT;
#pragma unroll
        for (int ai = 0; ai < 2; ++ai)
#pragma unroll
            for (int m = 0; m < 4; ++m) { unsigned w[2];
#pragma unroll
                for (int bj = 0; bj < 2; ++bj) { const f32x4 g = acc[ai][bj][m][0], up = acc[ai][bj][m][1]; float hv[4];
#pragma unroll
                    for (int q = 0; q < 2; ++q) { const f32x2 g2 = {g[2 * q], g[2 * q + 1]}, u2 = {up[2 * q], up[2 * q + 1]}; const f32x2 a2 = g2 * KA;
                        f32x2 e2; e2.x = __builtin_amdgcn_exp2f(a2.x); e2.y = __builtin_amdgcn_exp2f(a2.y); const f32x2 d2 = e2 + 1.0f;
                        f32x2 r2; r2.x = __builtin_amdgcn_rcpf(d2.x); r2.y = __builtin_amdgcn_rcpf(d2.y); const f32x2 h2 = ((g2 * u2) * KB) * r2; hv[2 * q] = h2.x; hv[2 * q + 1] = h2.y; }
                    w[bj] = pack4_fp8(hv[0], hv[1], hv[2], hv[3]); }
                *(u32x2*)(HID + (size_t)(row0 + ai * HALF + m * 16) * 2048 + col0) = (u32x2){w[0], w[1]}; }
    }
};
constexpr float FP8_Y = 64.0f;
struct EpiDown {
    static constexpr bool PERM = false, AFTER_DRAIN = false;
    unsigned char* Y; const float* gate;
    __device__ __forceinline__ void operator()(const f32x4 (&acc)[2][2][4][2], const Unit& u, int wr, int wc, int fr, int fq) const {
        const int pnl = u.pn & 3; const int row0 = u.pm * BM + wr * 64 + fr, col0 = pnl * BM + wc * 32 + 8 * fq;
#pragma unroll
        for (int ai = 0; ai < 2; ++ai)
#pragma unroll
            for (int m = 0; m < 4; ++m) { const int row = row0 + ai * HALF + m * 16; const float gt = gate[row] * (FP8_UNSCALE * FP8_Y); unsigned char* rowp = Y + (size_t)row * 1024 + col0;
#pragma unroll
                for (int bj = 0; bj < 2; ++bj) { const f32x4 a = acc[ai][bj][m][0] * gt, b = acc[ai][bj][m][1] * gt; *(u32x2*)(rowp + bj * HALF) = (u32x2){pack4_fp8(a[0], a[1], a[2], a[3]), pack4_fp8(b[0], b[1], b[2], b[3])}; } }
    }
};

template <class Epi, class Sched, bool ALIGN_EPI = false, bool SP2 = false, bool FP8 = false, bool GATHER = false>
__device__ __forceinline__ void gemm_phase(PG8_LAS unsigned char* lds, const Gemm g, const Sched& S, const Epi& E, int wid_in, const unsigned short* gidx = nullptr, PG8_LAS unsigned short* gtab = nullptr) {
    static_assert(!GATHER || SP2, "the gathered A operand is wired into the SP2 loop only");
    int lane_; asm volatile("v_mbcnt_lo_u32_b32 %0, -1, 0\n\tv_mbcnt_hi_u32_b32 %0, -1, %0" : "=v"(lane_));
    const int lane = lane_, wid = wid_in, tid = wid * 64 + lane, wr = wid >> 2, wc = wid & 3, fr = lane & 15, fq = lane >> 4;
    const int K = g.K, nt = K / BK;
    unsigned voffA[2], voffB[2];
#pragma unroll
    for (int i = 0; i < 2; ++i) { int R, C; stage_rc(tid * 16 + i * 8192, R, C); const int Rb = Epi::PERM ? ((R & ~31) + perm32(R & 31)) : R;
        voffA[i] = (unsigned)(R * K + C) * 2u; voffB[i] = (unsigned)(Rb * K + C) * 2u; }
    unsigned vc[2][2] = {{0u, 0u}, {0u, 0u}};
#define PG8_GV(dst, ui_) do { _Pragma("unroll") for (int _i = 0; _i < 2; ++_i) { int R_, C_; stage_rc(tid * 16 + _i * 8192, R_, C_); _Pragma("unroll") for (int _h = 0; _h < 2; ++_h) \
        dst[_h][_i] = (unsigned)gtab[(ui_) * 256 + _h * HALF + R_] * (unsigned)(K * 2) + (unsigned)(C_ * 2); } } while (0)
#define PG8_STAGE_A(bufoff, ptr, h, usenext) do { if constexpr (GATHER) { PG8_STAGE(bufoff, ptr, vc[h]); } else PG8_STAGE(bufoff, (ptr) + ((h) ? hstep : 0), voffA); } while (0)
    if constexpr (GATHER) { Unit u_; for (int i_ = 0; S.next(i_, u_); ++i_) if (tid < 256) gtab[i_ * 256 + tid] = gidx[(size_t)u_.pm * 256 + tid];
        asm volatile("s_waitcnt vmcnt(0) lgkmcnt(0)" ::: "memory"); __builtin_amdgcn_s_barrier(); asm volatile("" ::: "memory"); }
    const size_t kstep = (size_t)(BK * 2);
    const size_t hstep = (size_t)HALF * K * 2;
    const size_t tstep = 2 * hstep;
    const unsigned ldsw = (unsigned)wid * 1024u;
    const int aoff = lds_byte(wr * 64 + fr, fq * 8), boff = lds_byte(wc * 32 + fr, fq * 8);
#define PG8_SA(b, h) (((b) * 2 + (h)) * HTB)
#define PG8_SB(b, h) ((4 + (b) * 2 + (h)) * HTB)
#define PG8_STAGE(bufoff, gbase, voff) do { _Pragma("unroll") for (int _i = 0; _i < 2; ++_i) \
        __builtin_amdgcn_global_load_lds((const unsigned*)((const char*)(gbase) + (voff)[_i]), (PG8_LAS unsigned*)(lds + (bufoff) + ldsw + _i * 8192), 16, 0, 0); } while (0)
#define PG8_LDA(dst, b, h) do { if constexpr (FP8) { _Pragma("unroll") for (int m = 0; m < 4; ++m) dst##8[m] = __builtin_shufflevector(*(const PG8_LAS v4i_t*)(lds + PG8_SA(b, h) + aoff + m * 2048), *(const PG8_LAS v4i_t*)(lds + PG8_SA(b, h) + aoff + m * 2048 + 1024), 0, 1, 2, 3, 4, 5, 6, 7); } \
        else { _Pragma("unroll") for (int m = 0; m < 4; ++m) _Pragma("unroll") for (int k = 0; k < 2; ++k) dst[m][k] = *(const PG8_LAS bf16x8*)(lds + PG8_SA(b, h) + aoff + m * 2048 + k * 1024); } } while (0)
#define PG8_LDB(dst, b, h) do { if constexpr (FP8) { _Pragma("unroll") for (int n = 0; n < 2; ++n) dst##8[n] = __builtin_shufflevector(*(const PG8_LAS v4i_t*)(lds + PG8_SB(b, h) + boff + n * 2048), *(const PG8_LAS v4i_t*)(lds + PG8_SB(b, h) + boff + n * 2048 + 1024), 0, 1, 2, 3, 4, 5, 6, 7); } \
        else { _Pragma("unroll") for (int n = 0; n < 2; ++n) _Pragma("unroll") for (int k = 0; k < 2; ++k) dst[n][k] = *(const PG8_LAS bf16x8*)(lds + PG8_SB(b, h) + boff + n * 2048 + k * 1024); } } while (0)
#define PG8_MMA(ai, bj, At, Bt) do { __builtin_amdgcn_s_setprio(1); if constexpr (FP8) { _Pragma("unroll") for (int m = 0; m < 4; ++m) _Pragma("unroll") for (int n = 0; n < 2; ++n) \
        asm volatile("v_mfma_f32_16x16x128_f8f6f4 %0, %1, %2, %0" : "+v"(acc[ai][bj][m][n]) : "v"(Bt##8[n]), "v"(At##8[m])); } else { \
        _Pragma("unroll") for (int m = 0; m < 4; ++m) _Pragma("unroll") for (int n = 0; n < 2; ++n) _Pragma("unroll") for (int k = 0; k < 2; ++k) \
        acc[ai][bj][m][n] = __builtin_amdgcn_mfma_f32_16x16x32_bf16(Bt[n][k], At[m][k], acc[ai][bj][m][n], 0, 0, 0); } __builtin_amdgcn_s_setprio(0); } while (0)
#define PG8_WAIT_V(n) asm volatile("s_waitcnt vmcnt(" #n ")" ::: "memory")
#define PG8_WAIT_L(n) asm volatile("s_waitcnt lgkmcnt(" #n ")" ::: "memory")
#define PG8_BAR __builtin_amdgcn_s_barrier()
#define PG8_SCHED __builtin_amdgcn_sched_barrier(0)
    Unit cur, nxt; int ui = 0;
    if (!S.next(0, cur)) return;
    f32x4 acc[2][2][4][2];
#pragma unroll
    for (int a = 0; a < 2; ++a)
#pragma unroll
        for (int b = 0; b < 2; ++b)
#pragma unroll
            for (int m = 0; m < 4; ++m)
#pragma unroll
                for (int n = 0; n < 2; ++n) acc[a][b][m][n] = (f32x4){0.f, 0.f, 0.f, 0.f};
    bf16x8 At[4][2], B0[2][2], B1[2][2]; v8i_t At8[4], B08[2], B18[2];
    const char* cA = (const char*)g.A + (GATHER ? (size_t)0 : (size_t)cur.pm * tstep); const char* cB = (const char*)g.Bt + (size_t)cur.pn * tstep;
    if constexpr (GATHER) { PG8_GV(vc, 0); }
    S.a_ready(cur);
    if constexpr (SP2) {
        PG8_STAGE(PG8_SB(0, 0), cB, voffB); PG8_STAGE(PG8_SB(0, 1), cB + hstep, voffB); PG8_STAGE_A(PG8_SA(0, 0), cA, 0, false); PG8_STAGE_A(PG8_SA(0, 1), cA, 1, false);
        if (wr == 1) PG8_BAR;
        PG8_WAIT_V(2); PG8_BAR;
        PG8_STAGE(PG8_SB(1, 0), cB + kstep, voffB); PG8_STAGE_A(PG8_SA(1, 0), cA + kstep, 0, false); PG8_STAGE(PG8_SB(1, 1), cB + hstep + kstep, voffB);
        PG8_WAIT_V(6); PG8_BAR;
    } else {
        PG8_STAGE(PG8_SB(0, 0), cB, voffB); PG8_STAGE(PG8_SA(0, 0), cA, voffA); PG8_STAGE(PG8_SB(0, 1), cB + hstep, voffB); PG8_STAGE(PG8_SA(0, 1), cA + hstep, voffA);
        if (wr == 1) PG8_BAR;
        PG8_WAIT_V(4); PG8_BAR;
        PG8_STAGE(PG8_SB(1, 0), cB + kstep, voffB); PG8_STAGE(PG8_SA(1, 0), cA + kstep, voffA); PG8_STAGE(PG8_SB(1, 1), cB + hstep + kstep, voffB);
        PG8_WAIT_V(6); PG8_BAR;
    }
    for (;;) {
        const bool has_next = S.next(ui + 1, nxt);
        const char* nA = (has_next && !GATHER) ? (const char*)g.A + (size_t)nxt.pm * tstep : cA; const char* nB = has_next ? (const char*)g.Bt + (size_t)nxt.pn * tstep : cB;
        for (int t = 0; t < nt; t += 2) {
            const bool last = (t == nt - 2);
            const char* a1 = cA + (size_t)(t + 1) * kstep;
            const char* a2 = last ? nA : cA + (size_t)(t + 2) * kstep; const char* b2 = last ? nB : cB + (size_t)(t + 2) * kstep;
            const char* a3 = a2 + kstep; const char* b3 = b2 + kstep;
            if (last && has_next) S.a_ready(nxt);
            if constexpr (SP2) {
            PG8_LDB(B0, 0, 0); PG8_LDB(B1, 0, 1); PG8_SCHED; PG8_LDA(At, 0, 0); PG8_STAGE_A(PG8_SA(1, 1), a1, 1, false);
            if constexpr (GATHER) { if (last && has_next) { PG8_GV(vc, ui + 1); } }
            PG8_WAIT_V(8); PG8_WAIT_L(0); PG8_BAR; PG8_MMA(0, 0, At, B0); PG8_MMA(0, 1, At, B1); PG8_BAR; PG8_SCHED;
            PG8_LDA(At, 0, 1); PG8_STAGE(PG8_SB(0, 0), b2, voffB); PG8_STAGE(PG8_SB(0, 1), b2 + hstep, voffB); PG8_STAGE_A(PG8_SA(0, 0), a2, 0, last);
            PG8_WAIT_V(8); PG8_WAIT_L(0); PG8_BAR; PG8_MMA(1, 0, At, B0); PG8_MMA(1, 1, At, B1); PG8_BAR; PG8_SCHED;
            PG8_LDB(B0, 1, 0); PG8_LDB(B1, 1, 1); PG8_SCHED; PG8_LDA(At, 1, 0); PG8_STAGE_A(PG8_SA(0, 1), a2, 1, last);
            PG8_WAIT_V(8); PG8_WAIT_L(0); PG8_BAR; PG8_MMA(0, 0, At, B0); PG8_MMA(0, 1, At, B1); PG8_BAR; PG8_SCHED;
            PG8_LDA(At, 1, 1); PG8_STAGE(PG8_SB(1, 0), b3, voffB); PG8_STAGE(PG8_SB(1, 1), b3 + hstep, voffB); PG8_STAGE_A(PG8_SA(1, 0), a3, 0, last);
            PG8_WAIT_V(8); PG8_WAIT_L(0); PG8_BAR; PG8_MMA(1, 0, At, B0); PG8_MMA(1, 1, At, B1); PG8_BAR; PG8_SCHED;
            } else {
            PG8_LDB(B0, 0, 0); PG8_SCHED; PG8_LDA(At, 0, 0); PG8_STAGE(PG8_SA(1, 1), a1 + hstep, voffA);
            PG8_WAIT_L(8); PG8_BAR; PG8_WAIT_L(0); PG8_MMA(0, 0, At, B0); PG8_BAR; PG8_SCHED;
            PG8_LDB(B1, 0, 1); PG8_STAGE(PG8_SB(0, 0), b2, voffB);
            PG8_BAR; PG8_WAIT_L(0); PG8_MMA(0, 1, At, B1); PG8_BAR;
            PG8_LDA(At, 0, 1); PG8_STAGE(PG8_SA(0, 0), a2, voffA);
            PG8_BAR; PG8_WAIT_L(0); PG8_MMA(1, 0, At, B0); PG8_BAR; PG8_SCHED;
            PG8_STAGE(PG8_SB(0, 1), b2 + hstep, voffB);
            PG8_WAIT_V(6); PG8_BAR; PG8_MMA(1, 1, At, B1); PG8_BAR;
            PG8_LDB(B0, 1, 0); PG8_SCHED; PG8_LDA(At, 1, 0); PG8_STAGE(PG8_SA(0, 1), a2 + hstep, voffA);
            PG8_WAIT_L(8); PG8_BAR; PG8_WAIT_L(0); PG8_MMA(0, 0, At, B0); PG8_BAR; PG8_SCHED;
            PG8_LDB(B1, 1, 1); PG8_STAGE(PG8_SB(1, 0), b3, voffB);
            PG8_BAR; PG8_WAIT_L(0); PG8_MMA(0, 1, At, B1); PG8_BAR;
            PG8_LDA(At, 1, 1); PG8_STAGE(PG8_SA(1, 0), a3, voffA);
            PG8_BAR; PG8_WAIT_L(0); PG8_MMA(1, 0, At, B0); PG8_BAR; PG8_SCHED;
            PG8_STAGE(PG8_SB(1, 1), b3 + hstep, voffB);
            PG8_WAIT_V(6); PG8_BAR; PG8_MMA(1, 1, At, B1); PG8_BAR;
            }
        }
        if constexpr (FP8) { PG8_SCHED; asm volatile("s_nop 15\n\ts_nop 15\n\ts_nop 15" ::: "memory"); PG8_SCHED; }
        if constexpr (ALIGN_EPI) { if (wr == 0) PG8_BAR; }
        if constexpr (!Epi::AFTER_DRAIN) { E(acc, cur, wr, wc, fr, fq); S.done(cur); }
        if (!has_next) break;
#pragma unroll
        for (int a = 0; a < 2; ++a)
#pragma unroll
            for (int b = 0; b < 2; ++b)
#pragma unroll
                for (int m = 0; m < 4; ++m)
#pragma unroll
                    for (int n = 0; n < 2; ++n) acc[a][b][m][n] = (f32x4){0.f, 0.f, 0.f, 0.f};
        cur = nxt; cA = nA; cB = nB; ++ui;
        if constexpr (ALIGN_EPI) { if (wr == 1) PG8_BAR; }
    }
    PG8_WAIT_V(0);
    if constexpr (!ALIGN_EPI) { if (wr == 0) PG8_BAR; }
    PG8_BAR;
    if constexpr (Epi::AFTER_DRAIN) { E.fused(acc, cur, wr, wc, fr, fq, lds, wid, lane); S.done(cur); }
#undef PG8_SA
#undef PG8_SB
#undef PG8_STAGE
#undef PG8_STAGE_A
#undef PG8_GV
#undef PG8_LDA
#undef PG8_LDB
#undef PG8_MMA
#undef PG8_WAIT_V
#undef PG8_WAIT_L
#undef PG8_BAR
#undef PG8_SCHED
}
}

constexpr size_t MiB = (size_t)1 << 20;
constexpr size_t WS_CTL = 0, CTL_ZERO_BYTES = 32768;
constexpr size_t WS_MOD = 1 * MiB;
constexpr size_t WS_AFF = 4 * MiB;
constexpr size_t WS_GATE = 7 * MiB;
constexpr size_t WS_IDX = 7 * MiB + 512 * 1024;
constexpr size_t WS_INV = 8 * MiB;
constexpr size_t WS_WATT_IN = 10 * MiB, WS_WATT_OUT = 22 * MiB, WS_WREC_IN = 26 * MiB, WS_WREC_OUT = 46 * MiB;
constexpr size_t WS_WMOE1 = 50 * MiB;
constexpr size_t WS_H8O = 320 * MiB;
constexpr size_t WS_WREC_F8 = 360 * MiB;
constexpr size_t WS_WMOE2 = 562 * MiB;
constexpr size_t WS_X = 818 * MiB;
constexpr size_t WS_H = 962 * MiB;
constexpr size_t WS_P = 1034 * MiB;
constexpr size_t WS_O = 1394 * MiB;
constexpr size_t WS_OF = WS_O + 72 * MiB, WS_OB = WS_O + 144 * MiB;
constexpr size_t WS_END = 1610 * MiB;
static_assert((size_t)RT * 1024 * 4 <= 144 * MiB && (size_t)RT * 5120 * 2 <= 360 * MiB && (size_t)XR * 2048 * 2 <= 360 * MiB && (size_t)XR * 1024 * 2 <= 216 * MiB, "ws map");
constexpr int CW_BAR = 4096;

constexpr int LDS_BYTES = 147456;
constexpr int MISC_OFF = LDS_BYTES - 256;

#define GAS __attribute__((address_space(1)))
#define LAS __attribute__((address_space(3)))
typedef unsigned short bf16;
typedef float f32x4 __attribute__((ext_vector_type(4)));
typedef unsigned v4u __attribute__((ext_vector_type(4)));
typedef unsigned v2u __attribute__((ext_vector_type(2)));
typedef short bf16x8 __attribute__((ext_vector_type(8)));
typedef short s16x4 __attribute__((ext_vector_type(4)));
typedef float f32x16 __attribute__((ext_vector_type(16)));
#define LDS_WAIT() asm volatile("s_waitcnt lgkmcnt(0)" ::: "memory")
#define VM_WAIT() asm volatile("s_waitcnt vmcnt(0)" ::: "memory")
__device__ __forceinline__ unsigned f2bf(float f) { const __bf16 b = (__bf16)f; return (unsigned)__builtin_bit_cast(unsigned short, b); }
__device__ __forceinline__ unsigned pk2(float lo, float hi) { return pg8::cvt_pk_bf16(lo, hi); }
__device__ __forceinline__ float bf2f(unsigned short b) { return __builtin_bit_cast(float, (unsigned)b << 16); }
__device__ __forceinline__ float bflo(unsigned w) { return __builtin_bit_cast(float, w << 16); }
__device__ __forceinline__ float bfhi(unsigned w) { return __builtin_bit_cast(float, w & 0xffff0000u); }
template <int CTRL> __device__ __forceinline__ float dppx(float x) { return __builtin_bit_cast(float, __builtin_amdgcn_update_dpp(0, __builtin_bit_cast(int, x), CTRL, 0xF, 0xF, true)); }
__device__ __forceinline__ float lx1(float x) { return __shfl_xor(x, 1); }
__device__ __forceinline__ float lx2(float x) { return __shfl_xor(x, 2); }
__device__ __forceinline__ float lx4(float x) { return __shfl_xor(x, 4); }
__device__ __forceinline__ float lx8(float x) { return __shfl_xor(x, 8); }
__device__ __forceinline__ float sw16sum(float a, float b) { auto r = __builtin_amdgcn_permlane16_swap(__float_as_uint(a), __float_as_uint(b), false, false); return __uint_as_float(r[0]) + __uint_as_float(r[1]); }
__device__ __forceinline__ float sw32sum(float a, float b) { auto r = __builtin_amdgcn_permlane32_swap(__float_as_uint(a), __float_as_uint(b), false, false); return __uint_as_float(r[0]) + __uint_as_float(r[1]); }
__device__ __forceinline__ float sw16max(float a) { auto r = __builtin_amdgcn_permlane16_swap(__float_as_uint(a), __float_as_uint(a), false, false); return fmaxf(__uint_as_float(r[0]), __uint_as_float(r[1])); }
__device__ __forceinline__ float sw32max(float a) { auto r = __builtin_amdgcn_permlane32_swap(__float_as_uint(a), __float_as_uint(a), false, false); return fmaxf(__uint_as_float(r[0]), __uint_as_float(r[1])); }
__device__ __forceinline__ float wave_sum_x(float v) { v += lx1(v); v += lx2(v); v += lx4(v); v += lx8(v); v = sw16sum(v, v); v = sw32sum(v, v); return v; }
__device__ __forceinline__ float wave_sum(float v) {
#pragma unroll
    for (int o = 1; o < 64; o <<= 1) v += __shfl_xor(v, o);
    return v;
}
__device__ __forceinline__ int wave_sum_i(int v) {
#pragma unroll
    for (int o = 1; o < 64; o <<= 1) v += __shfl_xor(v, o);
    return v;
}
__device__ __forceinline__ int wave_incl_scan(int v, int lane) {
#pragma unroll
    for (int o = 1; o < 64; o <<= 1) { const int t = __shfl_up(v, o); if (lane >= o) v += t; }
    return v;
}

#define XB_TMO      128
#define XB_XCNT(j)  (256  + 64 * (j))
#define XB_XSUB(j)  (1280 + 64 * (j))
#define XB_XGEN(j)  (2304 + 64 * (j))
#define XB_TOP      3328
#define XB_TOPGEN   3392
#define XCD_BAR_WORDS 3456
#define XB_SPIN_CAP (1u << 18)

__device__ __forceinline__ unsigned xb_ld(unsigned* p)              { return __hip_atomic_load(p, __ATOMIC_RELAXED, __HIP_MEMORY_SCOPE_AGENT); }
__device__ __forceinline__ unsigned xb_add(unsigned* p, unsigned v) { return __hip_atomic_fetch_add(p, v, __ATOMIC_RELAXED, __HIP_MEMORY_SCOPE_AGENT); }
__device__ __forceinline__ unsigned xb_xcc_id() { return (unsigned)__builtin_amdgcn_s_getreg((3 << 11) | 20) & 0xFu; }
#define XB_SPIN(cond, bar) do { unsigned _sp = 0; while (cond) { __builtin_amdgcn_s_sleep(1); \
    if ((++_sp & 255u) == 0u) { if (xb_ld(&(bar)[XB_TMO])) break; if (_sp > XB_SPIN_CAP) { atomicAdd(&(bar)[XB_TMO], 1u); break; } } } } while (0)

struct XcdBarrier {
    unsigned* bar; unsigned x;
    volatile LAS unsigned* st;
};

__device__ __forceinline__ XcdBarrier xcd_barrier_post(unsigned* bar, volatile LAS unsigned* st) {
    XcdBarrier b; b.bar = bar; b.x = xb_xcc_id(); b.st = st;
    if (threadIdx.x == 0) (void)xb_add(&bar[XB_XCNT(b.x)], 1u);
    return b;
}
__device__ __forceinline__ void xcd_barrier_complete(unsigned* bar, unsigned x, unsigned& nloc, unsigned& nx) {
    const unsigned G = gridDim.x * gridDim.y * gridDim.z;
    unsigned sum, cnt, mine, sp = 0u;
    for (;;) {
        sum = 0u; cnt = 0u; mine = 0u;
#pragma unroll
        for (unsigned j = 0; j < 16; ++j) { const unsigned c = xb_ld(&bar[XB_XCNT(j)]); sum += c; cnt += (c > 0u) ? 1u : 0u; mine = (j == x) ? c : mine; }
        if (sum == G) break;
        __builtin_amdgcn_s_sleep(1);
        if ((++sp & 255u) == 0u) { if (xb_ld(&bar[XB_TMO])) break; if (sp > XB_SPIN_CAP) { atomicAdd(&bar[XB_TMO], 1u); break; } }
    }
    nloc = mine > 0u ? mine : 1u; nx = cnt > 0u ? cnt : 1u;
}

__device__ __forceinline__ void xcd_barrier(const XcdBarrier& b) {
    asm volatile("s_waitcnt vmcnt(0)" ::: "memory");
    __syncthreads();
    if (threadIdx.x == 0) {
        unsigned* bar = b.bar;
        __builtin_amdgcn_s_waitcnt(0);
        unsigned nloc = b.st[0], nx = b.st[1];
        if (nloc == 0u) { xcd_barrier_complete(bar, b.x, nloc, nx); b.st[0] = nloc; b.st[1] = nx; }
        const unsigned old = xb_add(&bar[XB_XSUB(b.x)], 1u);
        const unsigned gen = old / nloc;
        if (old + 1u == (gen + 1u) * nloc) {
            __builtin_amdgcn_fence(__ATOMIC_RELEASE, "agent");
            asm volatile("s_waitcnt vmcnt(0)" ::: "memory");
            const unsigned og = xb_add(&bar[XB_TOP], 1u);
            const unsigned tg = og / nx;
            if (og + 1u == (tg + 1u) * nx) xb_add(&bar[XB_TOPGEN], 1u);
            else XB_SPIN(xb_ld(&bar[XB_TOPGEN]) == tg, bar);
            __builtin_amdgcn_fence(__ATOMIC_ACQUIRE, "agent");
            xb_add(&bar[XB_XGEN(b.x)], 1u);
            asm volatile("s_waitcnt vmcnt(0)" ::: "memory");
        } else {
            XB_SPIN(xb_ld(&bar[XB_XGEN(b.x)]) == gen, bar);
            __builtin_amdgcn_fence(__ATOMIC_ACQUIRE, "agent");
            asm volatile("s_waitcnt vmcnt(0)" ::: "memory");
        }
    }
    __syncthreads();
}

struct Frame {
    LAS unsigned char* lds;
    int tid, lane, wave, vcu, G;
    const float *x_in, *c_in, *ctx_in, *cctx_in, *w_mod, *b_mod, *norm_g, *att_w_in, *att_w_out, *na_rpb, *diff_lambda, *diff_subln_g, *rec_w_in, *rec_w_out, *rec_lb_logits, *rec_gnorm_g,
                *moe_router, *moe_w_gate, *moe_w_up, *moe_w_down, *final_g;
    float* out; unsigned char* ws;
};

__device__ __forceinline__ int perm_inv32(int n) { const int c5 = n & 31; return (n & ~31) + 16 * ((c5 >> 2) & 1) + 4 * (c5 >> 3) + (c5 & 3); }
__device__ __forceinline__ int rowmap(int n, int kind) {
    if (kind == 1) { const bool rp = (n >= 512 && n < 1024) || (n >= 2048 && n < 2560); const int d = n & 63; return rp ? ((n & ~63) + 32 * ((d >> 4) & 1) + 16 * (d >> 5) + (d & 15)) : perm_inv32(n); }
    if (kind >= 2) { const int pn = n >> 7, r = n & 127, wc = r >> 5, fq = (r >> 3) & 3, bj = (r >> 2) & 1, i = r & 3; return 256 * pn + 128 * bj + 32 * wc + 16 * (kind - 2) + 4 * fq + i; }
    return perm_inv32(n);
}
__device__ __forceinline__ void transpose_item(const float* W, int K, int N, bf16* WT, int kind, LAS float* scr, int item, int lane) {
    const int nblk = N / 64, kb = item / nblk, nb = item % nblk, k0 = 64 * kb, n0 = 64 * nb;
    { const float* wp = W + (size_t)(k0 + (lane >> 4)) * N + n0 + 4 * (lane & 15); LAS float* sp = scr + (lane >> 4) * 65 + 4 * (lane & 15); f32x4 tv[16];
#pragma unroll
      for (int i = 0; i < 16; ++i) tv[i] = __builtin_nontemporal_load((const f32x4*)(wp + (size_t)(4 * i) * N));
#pragma unroll
      for (int i = 0; i < 16; ++i) { sp[(4 * i) * 65 + 0] = tv[i].x; sp[(4 * i) * 65 + 1] = tv[i].y; sp[(4 * i) * 65 + 2] = tv[i].z; sp[(4 * i) * 65 + 3] = tv[i].w; } }
    LDS_WAIT(); asm volatile("" ::: "memory");
    const int c = lane & 7;
#pragma unroll
    for (int j = 0; j < 8; ++j) { const int n = (lane >> 3) + 8 * j; const LAS float* s = scr + (8 * c) * 65 + n;
        v4u o; o.x = pk2(s[0 * 65], s[1 * 65]); o.y = pk2(s[2 * 65], s[3 * 65]); o.z = pk2(s[4 * 65], s[5 * 65]); o.w = pk2(s[6 * 65], s[7 * 65]);
        __builtin_nontemporal_store(o, (GAS v4u*)(WT + (size_t)rowmap(n0 + n, kind) * K + k0 + 8 * c)); }
    LDS_WAIT(); asm volatile("" ::: "memory");
}
__device__ __forceinline__ void transpose_item8(const float* W, int K, int N, unsigned char* WT, int kind, LAS float* scr, int item, int lane) {
    const int nblk = N / 64, kb = item / nblk, nb = item % nblk, k0 = 64 * kb, n0 = 64 * nb;
    { const float* wp = W + (size_t)(k0 + (lane >> 4)) * N + n0 + 4 * (lane & 15); LAS float* sp = scr + (lane >> 4) * 65 + 4 * (lane & 15); f32x4 tv[16];
#pragma unroll
      for (int i = 0; i < 16; ++i) tv[i] = __builtin_nontemporal_load((const f32x4*)(wp + (size_t)(4 * i) * N));
#pragma unroll
      for (int i = 0; i < 16; ++i) { const f32x4 t = tv[i] * pg8::FP8_WGT; sp[(4 * i) * 65 + 0] = t.x; sp[(4 * i) * 65 + 1] = t.y; sp[(4 * i) * 65 + 2] = t.z; sp[(4 * i) * 65 + 3] = t.w; } }
    LDS_WAIT(); asm volatile("" ::: "memory");
    const int c = lane & 7;
#pragma unroll
    for (int j = 0; j < 8; ++j) { const int n = (lane >> 3) + 8 * j; const LAS float* s = scr + (8 * c) * 65 + n;
        v2u o; o.x = pg8::pack4_fp8(s[0 * 65], s[1 * 65], s[2 * 65], s[3 * 65]); o.y = pg8::pack4_fp8(s[4 * 65], s[5 * 65], s[6 * 65], s[7 * 65]);
        __builtin_nontemporal_store(o, (GAS v2u*)(WT + (size_t)rowmap(n0 + n, kind) * K + k0 + 8 * c)); }
    LDS_WAIT(); asm volatile("" ::: "memory");
}
struct MoeItem { const float* W; unsigned char* WT; int K, N, kind, k0, n0; };
__device__ __forceinline__ MoeItem moe_item_desc(Frame& F, int r) {
    const int le = r / 768, q = r % 768, which = q / 256, item = q % 256; MoeItem d;
    if (which == 0) { d.W = F.moe_w_gate + (size_t)le * 1024 * 2048; d.WT = F.ws + WS_WMOE1 + (size_t)le * 4096 * 1024; d.K = 1024; d.N = 2048; d.kind = 2; }
    else if (which == 1) { d.W = F.moe_w_up + (size_t)le * 1024 * 2048; d.WT = F.ws + WS_WMOE1 + (size_t)le * 4096 * 1024; d.K = 1024; d.N = 2048; d.kind = 3; }
    else { d.W = F.moe_w_down + (size_t)le * 2048 * 1024; d.WT = F.ws + WS_WMOE2 + (size_t)le * 1024 * 2048; d.K = 2048; d.N = 1024; d.kind = 0; }
    const int nblk = d.N / 64; d.k0 = 128 * (item / nblk); d.n0 = 64 * (item % nblk); return d;
}
__device__ __forceinline__ void moe_half_load(const MoeItem& d, int h, int lane, f32x4 (&tv)[16]) {
    const float* wp = d.W + (size_t)(d.k0 + 64 * h + 16 * (lane >> 4)) * d.N + d.n0 + 4 * (lane & 15);
#pragma unroll
    for (int i = 0; i < 16; ++i) tv[i] = __builtin_nontemporal_load((const f32x4*)(wp + (size_t)i * d.N));
}
__device__ __forceinline__ void moe_half_pack(int h, LAS unsigned* scr, int lane, const f32x4 (&tv)[16]) {
    LAS unsigned* sp = scr + (4 * (lane & 15)) * 36 + 16 * h + 4 * (lane >> 4);
#pragma unroll
    for (int g = 0; g < 4; ++g) { const f32x4 t0 = tv[4 * g] * pg8::FP8_WGT, t1 = tv[4 * g + 1] * pg8::FP8_WGT, t2 = tv[4 * g + 2] * pg8::FP8_WGT, t3 = tv[4 * g + 3] * pg8::FP8_WGT;
        sp[0 * 36 + g] = pg8::pack4_fp8(t0.x, t1.x, t2.x, t3.x); sp[1 * 36 + g] = pg8::pack4_fp8(t0.y, t1.y, t2.y, t3.y);
        sp[2 * 36 + g] = pg8::pack4_fp8(t0.z, t1.z, t2.z, t3.z); sp[3 * 36 + g] = pg8::pack4_fp8(t0.w, t1.w, t2.w, t3.w); }
}
__device__ __forceinline__ void moe_item_store(const MoeItem& d, LAS unsigned* scr, int lane) {
    LDS_WAIT(); asm volatile("" ::: "memory");
    const int c = lane & 7;
#pragma unroll
    for (int j = 0; j < 8; ++j) { const int n = (lane >> 3) + 8 * j; const v4u o = *(const LAS v4u*)(scr + n * 36 + 4 * c);
        __builtin_nontemporal_store(o, (GAS v4u*)(d.WT + (size_t)rowmap(d.n0 + n, d.kind) * d.K + d.k0 + 16 * c)); }
    LDS_WAIT(); asm volatile("" ::: "memory");
}
template <class RMap>
__device__ __forceinline__ void moe_items_pipelined(Frame& F, LAS float* scr_f, int j0, int step, int jend, const RMap& rmap) {
    f32x4 ta[16], tb[16]; int j = j0; LAS unsigned* scr = (LAS unsigned*)scr_f;
    if (j >= jend) return;
    MoeItem d = moe_item_desc(F, rmap(j)); moe_half_load(d, 0, F.lane, ta);
    for (;;) {
        moe_half_load(d, 1, F.lane, tb);
        moe_half_pack(0, scr, F.lane, ta);
        const int jn = j + step; const bool more = jn < jend; MoeItem dn = d;
        if (more) { dn = moe_item_desc(F, rmap(jn)); moe_half_load(dn, 0, F.lane, ta); }
        moe_half_pack(1, scr, F.lane, tb);
        moe_item_store(d, scr, F.lane);
        if (!more) break;
        d = dn; j = jn;
    }
}
#ifndef Q_OUT_V
#define Q_OUT_V 1
#define Q_DN_V 2
#define Q_SEL_V 2
#endif
constexpr int LITEMS = 12288, Q_EI = 1, Q_AT = 1, Q_OUT = Q_OUT_V, Q_SEL = Q_SEL_V, Q_DN = Q_DN_V;
constexpr int Z_EI = 64 * 8 * Q_EI, Z_AT = 128 * 8 * Q_AT, Z_OUT = 192 * 8 * Q_OUT, Z_SEL = 256 * 6 * Q_SEL, Z_DN = 128 * 8 * Q_DN, Z_OI1 = 192 * 8 + 64 * 8 * 2, Z_OI3 = Z_OI1;
constexpr int G0I = 0, G0A = G0I + Z_EI, G0O = G0A + Z_AT, G0S = G0O + Z_OUT, G0D = G0S + Z_SEL,
              G1I = G0D + Z_DN, G1O = G1I + Z_OI1, G1S = G1O + Z_OUT, G1D = G1S + Z_SEL,
              G2I = G1D + Z_DN, G2A = G2I + Z_EI, G2O = G2A + Z_AT, G2S = G2O + Z_OUT, G2D = G2S + Z_SEL,
              G3I = G2D + Z_DN, GEND = G3I + Z_OI3;
static_assert(GEND <= 3 * LITEMS, "the slots have no cap check");
constexpr int GD = 3 * LITEMS - GEND;
static_assert(GD + G1D >= LITEMS && GD + G2D >= 2 * LITEMS, "a layer's items must be converted before its expert GEMMs");
__device__ __forceinline__ void tail_convert(Frame& F, int l, int kind  , int bx) {
    int start = -1, rank = -1, nrank = 1, cnt = 0;
    if (kind == 0 && (l & 1)) {
        int r1, r2;
        if (l == 1) { r1 = bx < 128 ? bx : (bx >= 192 ? bx - 64 : -1); r2 = bx >= 192 ? bx - 192 : -1; } else { r1 = bx >= 64 ? bx - 64 : -1; r2 = (bx >= 64 && bx < 128) ? bx - 64 : -1; }
        if (r1 < 0) return;
        const int st = (l == 1) ? G1I : G3I, w1 = r1 * 8 + F.wave, w2 = r2 * 8 + F.wave;
        LAS float* scr = (LAS float*)(F.lds + F.wave * 16640);
        moe_items_pipelined(F, scr, 0, 1, r2 >= 0 ? 3 : 1, [=](int k) { return LITEMS + GD + (k == 0 ? st + w1 : st + 192 * 8 + (k - 1) * 64 * 8 + w2); });
        return; }
    if (kind == 0) { const int rem = 192; rank = (bx - rem) * 8 + F.wave; nrank = (256 - rem) * 8; cnt = Q_EI; if (bx < rem) rank = -1; start = (l == 0) ? G0I : G2I; }
    else if (kind == 1) { rank = (bx - 64) * 8 + F.wave; nrank = 192 * 8; cnt = Q_OUT; if (bx < 64) rank = -1; start = (l == 0) ? G0O : (l == 1) ? G1O : (l == 2) ? G2O : -1; }
    else if (kind == 2) { rank = (bx - 128) * 8 + F.wave; nrank = 128 * 8; cnt = Q_DN; if (bx < 128) rank = -1; start = (l == 0) ? G0D : (l == 1) ? G1D : (l == 2) ? G2D : -1; }
    else if (kind == 3) { rank = bx * 6 + F.wave - 2; nrank = 256 * 6; cnt = Q_SEL; if (F.wave < 2) rank = -1; start = (l == 0) ? G0S : (l == 1) ? G1S : (l == 2) ? G2S : -1; }
    else { rank = (bx - 128) * 8 + F.wave; nrank = 128 * 8; cnt = Q_AT; if (bx < 128) rank = -1; start = (l == 0) ? G0A : (l == 2) ? G2A : -1; }
    if (start < 0 || rank < 0) return;
    LAS float* scr = (LAS float*)(F.lds + F.wave * 16640);
    moe_items_pipelined(F, scr, 0, 1, cnt, [=](int k) { return LITEMS + GD + start + k * nrank + rank; });
}
#ifndef P0_REP_A
#define P0_REP_A 1
#define P0_REP_B 1
#endif
__device__ __forceinline__ void p0_prologue(Frame& F) {
    for (int repa_ = 0; repa_ < P0_REP_A; ++repa_) { if (repa_) __syncthreads();
        LAS float* S = (LAS float*)F.lds;
        LAS float* part = S + 17 * 1024;
        for (int idx = F.tid; idx < 17 * 1024; idx += NTHR) { const int r = idx >> 10, d = idx & 1023; const float v = r < 16 ? F.c_in[r * 1024 + d] : F.cctx_in[d]; S[idx] = v / (1.0f + expf(-v)); }
        __syncthreads();
        float* mod = (float*)(F.ws + WS_MOD);
        for (int item = blockIdx.x; item < 4 * 192; item += F.G) {
            const int l = item / 192, cb = item % 192, col = cb * 32 + (F.lane & 31), d0 = F.wave * 128 + 64 * (F.lane >> 5);
            float acc[17], w[64];
#pragma unroll
            for (int r = 0; r < 17; ++r) acc[r] = 0.f;
            const float* wp = F.w_mod + ((size_t)l * 1024 + d0) * 6144 + col;
#pragma unroll
            for (int i = 0; i < 64; ++i) w[i] = __builtin_nontemporal_load(wp + (size_t)i * 6144);
#pragma unroll
            for (int i = 0; i < 16; ++i) {
#pragma unroll
                for (int r = 0; r < 17; ++r) { const f32x4 s4 = *(const LAS f32x4*)(S + r * 1024 + d0 + 4 * i); acc[r] += (s4.x * w[4 * i] + s4.y * w[4 * i + 1]) + (s4.z * w[4 * i + 2] + s4.w * w[4 * i + 3]); } }
#pragma unroll
            for (int r = 0; r < 17; ++r) part[(F.wave * 17 + r) * 64 + F.lane] = acc[r];
            __syncthreads();
            for (int o = F.tid; o < 17 * 32; o += NTHR) { const int r = o >> 5, ln = o & 31; float s = 0.f;
#pragma unroll
                for (int w8 = 0; w8 < 8; ++w8) s += part[(w8 * 17 + r) * 64 + ln] + part[(w8 * 17 + r) * 64 + 32 + ln];
                mod[((size_t)l * 17 + r) * 6144 + cb * 32 + ln] = s + F.b_mod[l * 6144 + cb * 32 + ln]; }
            __syncthreads();
        }
    }
    for (int repb_ = 0; repb_ < P0_REP_B; ++repb_) { if (repb_) { VM_WAIT(); __syncthreads(); }
        LAS float* scr = (LAS float*)(F.lds + F.wave * 16640);
        const int gw = F.vcu * NWAVES + F.wave, NGW = F.G * NWAVES;
        constexpr int I_AIN = 16 * 48, I_SQ = 16 * 16, I_RIN = 16 * 80, I_MOE = 256;
        constexpr int T0 = 2 * I_AIN, T1 = T0 + 2 * I_SQ, T2 = T1 + 2 * I_RIN, T3 = T2 + 2 * I_SQ, NM = LITEMS + GD;
        static_assert(3 * I_MOE == 768 && 16 * 768 == LITEMS, "item arithmetic");
        bf16* wao = (bf16*)(F.ws + WS_WATT_OUT); bf16* wro = (bf16*)(F.ws + WS_WREC_OUT);
        for (int it = gw; it < T3; it += NGW) {
            int r = it;
            if (r < T0) { const int e = r / I_AIN; if (IN8E) transpose_item8(F.att_w_in + (size_t)e * 1024 * 3072, 1024, 3072, F.ws + WS_WATT_IN + (size_t)e * 3072 * 1024, 1, scr, r % I_AIN, F.lane);
                else transpose_item(F.att_w_in + (size_t)e * 1024 * 3072, 1024, 3072, (bf16*)(F.ws + WS_WATT_IN) + (size_t)e * 3072 * 1024, 1, scr, r % I_AIN, F.lane); continue; }
            if (r < T1) { r -= T0; const int e = r / I_SQ; transpose_item(F.att_w_out + (size_t)e * 1024 * 1024, 1024, 1024, wao + (size_t)e * 1024 * 1024, 0, scr, r % I_SQ, F.lane); continue; }
            if (r < T2) { r -= T1; const int e = r / I_RIN, it = r % I_RIN, nb = it % 80;
                if (nb >= 16 && nb < 48) transpose_item8(F.rec_w_in + (size_t)e * 1024 * 5120 + 1024, 1024, 5120, F.ws + WS_WREC_F8 + (size_t)e * 2048 * 1024, 0, scr, it - 16, F.lane);
                else transpose_item(F.rec_w_in + (size_t)e * 1024 * 5120, 1024, 5120, (bf16*)(F.ws + WS_WREC_IN) + (size_t)e * 5120 * 1024, 0, scr, it, F.lane); continue; }
            r -= T2; { const int e = r / I_SQ; transpose_item(F.rec_w_out + (size_t)e * 1024 * 1024, 1024, 1024, wro + (size_t)e * 1024 * 1024, 0, scr, r % I_SQ, F.lane); }
        }
        moe_items_pipelined(F, scr, (gw + NGW / 2) % NGW, NGW, NM, [](int r) { return r; });
    }
}

template <int MODE>
__device__ __forceinline__ void norm_phase(Frame& F, int l, int dbg_src_in = 0) {
    const float* mod = (const float*)(F.ws + WS_MOD);
    bf16* X = (bf16*)(F.ws + WS_X); bf16* H = (bf16*)(F.ws + WS_H);
    const int nrows = (MODE == 2 || (MODE == 1 && l == 3)) ? RL : RT;
    const int per = nrows / (F.G * NWAVES);
    const int gw = F.vcu * NWAVES + F.wave, lane = F.lane;
    LAS float* Wt = (LAS float*)F.lds;
    if (MODE == 1) {
        for (int idx = F.tid; idx < 4096; idx += NTHR) { const int d = idx >> 2, eg = idx & 3; const f32x4 w = *(const f32x4*)(F.moe_router + ((size_t)l * 1024 + d) * 16 + eg * 4);
#pragma unroll
            for (int i = 0; i < 4; ++i) Wt[(eg * 4 + i) * 1024 + d] = w[i]; }
        __syncthreads();
    }
    int cur_b = -1; f32x4 av[4], bv[4];
    const int kind_sh = (MODE == 0) ? 0 : 3, kind_sc = (MODE == 0) ? 1 : 4;
    const bool src_in = (MODE == 0 && l == 0) || (MODE == 2 && dbg_src_in);
    const bool comb = (MODE == 0 && l > 0) || (MODE == 2 && l >= 0);
#define XROW(r) ((r) < RL ? F.x_in + (size_t)(r) * 1024 : F.ctx_in + (size_t)((r) - RL) * 1024)
#define XLOAD(dst, r) do { if (src_in) { const float* xr_ = XROW(r); _Pragma("unroll") for (int j = 0; j < 4; ++j) dst[j] = *(const f32x4*)(xr_ + 256 * j + 4 * lane); } \
        else { const bf16* xr_ = X + (size_t)(r) * 1024; _Pragma("unroll") for (int j = 0; j < 4; ++j) { const v2u w_ = *(const v2u*)(xr_ + 256 * j + 4 * lane); dst[j] = (f32x4){bflo(w_.x), bfhi(w_.x), bflo(w_.y), bfhi(w_.y)}; } } } while (0)
    f32x4 nx[4]; v4u ni0 = {0u, 0u, 0u, 0u}, ni1 = {0u, 0u, 0u, 0u};
    { const int row = gw * per;
      XLOAD(nx, row);
      if (comb) { ni0 = *(const v4u*)(F.ws + WS_INV + (size_t)row * 32); ni1 = *(const v4u*)(F.ws + WS_INV + (size_t)row * 32 + 16); } }
    for (int rr = 0; rr < per; ++rr) {
        const int row = gw * per + rr; const bool latent = row < RL; const int bidx = latent ? (row >> 11) : 16;
        if (MODE != 2 && bidx != cur_b) { cur_b = bidx;
            const float* gq = F.norm_g + ((size_t)l * 2 + (MODE == 0 ? 0 : 1)) * 1024; const float* sc = mod + ((size_t)l * 17 + bidx) * 6144 + kind_sc * 1024; const float* sh = mod + ((size_t)l * 17 + bidx) * 6144 + kind_sh * 1024;
#pragma unroll
            for (int j = 0; j < 4; ++j) { const f32x4 g4 = *(const f32x4*)(gq + 256 * j + 4 * lane), s4 = *(const f32x4*)(sc + 256 * j + 4 * lane); av[j] = g4 * (s4 + 1.0f); bv[j] = *(const f32x4*)(sh + 256 * j + 4 * lane); } }
        f32x4 v[4];
#pragma unroll
        for (int j = 0; j < 4; ++j) v[j] = nx[j];
        const v4u i0 = ni0, i1 = ni1;
        if (rr + 1 < per) { const int rn = row + 1;
            XLOAD(nx, rn);
            if (comb) { ni0 = *(const v4u*)(F.ws + WS_INV + (size_t)rn * 32); ni1 = *(const v4u*)(F.ws + WS_INV + (size_t)rn * 32 + 16); } }
        if (comb) {
            const int lp = (MODE == 2) ? l : l - 1;
            const unsigned iw[8] = {i0.x, i0.y, i0.z, i0.w, i1.x, i1.y, i1.z, i1.w};
            const bf16* Y = (const bf16*)(F.ws + WS_O);
            const int xb = latent ? (row >> 11) * 256 : 4096 + ((row - RL) >> 8) * 32;
            f32x4 a[4];
#pragma unroll
            for (int j = 0; j < 4; ++j) a[j] = (f32x4){0.f, 0.f, 0.f, 0.f};
#pragma unroll
            for (int e = 0; e < 16; ++e) { const unsigned slot = (unsigned)__builtin_amdgcn_readfirstlane((int)((iw[e >> 1] >> (16 * (e & 1))) & 0xffffu));
                if (slot != 0xffffu) { const bf16* yr = Y + (size_t)(e * XR_E + xb + (int)slot) * 1024;
#pragma unroll
                    for (int j = 0; j < 4; ++j) { const v2u w = *(const v2u*)(yr + 256 * j + 4 * lane); a[j] += (f32x4){bflo(w.x), bfhi(w.x), bflo(w.y), bfhi(w.y)}; } } }
            const float* g2 = mod + ((size_t)lp * 17 + bidx) * 6144 + 5 * 1024;
#pragma unroll
            for (int j = 0; j < 4; ++j) { v[j] += *(const f32x4*)(g2 + 256 * j + 4 * lane) * a[j]; if (MODE == 0) { v2u w; w.x = pk2(v[j].x, v[j].y); w.y = pk2(v[j].z, v[j].w); *(v2u*)(X + (size_t)row * 1024 + 256 * j + 4 * lane) = w; } }
        }
        float ss = 0.f;
#pragma unroll
        for (int j = 0; j < 4; ++j) ss += (v[j].x * v[j].x + v[j].y * v[j].y) + (v[j].z * v[j].z + v[j].w * v[j].w);
        const float rstd = 1.0f / sqrtf(wave_sum(ss) * (1.0f / 1024.0f) + NORM_EPS);
        if (MODE == 2) {
#pragma unroll
            for (int j = 0; j < 4; ++j) *(f32x4*)(F.out + (size_t)row * 1024 + 256 * j + 4 * lane) = v[j] * rstd * *(const f32x4*)(F.final_g + 256 * j + 4 * lane);
            continue;
        }
        f32x4 hv[4];
#pragma unroll
        for (int j = 0; j < 4; ++j) { hv[j] = v[j] * rstd * av[j] + bv[j];
            if (MODE == 1 || (MODE == 0 && IN8E)) *(unsigned*)((unsigned char*)H + (size_t)row * 1024 + 256 * j + 4 * lane) = pg8::pack4_fp8(hv[j].x * pg8::FP8_ACT, hv[j].y * pg8::FP8_ACT, hv[j].z * pg8::FP8_ACT, hv[j].w * pg8::FP8_ACT);
            else { v2u w; w.x = pk2(hv[j].x, hv[j].y); w.y = pk2(hv[j].z, hv[j].w); *(v2u*)(H + (size_t)row * 1024 + 256 * j + 4 * lane) = w; } }
        if (MODE == 1) {
            float sp[16];
#pragma unroll
            for (int e = 0; e < 16; ++e) { float s = 0.f;
#pragma unroll
                for (int j = 0; j < 4; ++j) { const f32x4 w = *(const LAS f32x4*)(Wt + e * 1024 + 256 * j + 4 * lane); s += (hv[j].x * w.x + hv[j].y * w.y) + (hv[j].z * w.z + hv[j].w * w.w); }
                sp[e] = s; if ((e & 3) == 3) __builtin_amdgcn_sched_barrier(0); }
            { const bool b5 = (lane & 32) != 0, b4 = (lane & 16) != 0, b3 = (lane & 8) != 0, b2 = (lane & 4) != 0;
#pragma unroll
              for (int i = 0; i < 8; ++i) { const float mn = b5 ? sp[8 + i] : sp[i], ot = b5 ? sp[i] : sp[8 + i]; sp[i] = mn + __shfl_xor(ot, 32); }
#pragma unroll
              for (int i = 0; i < 4; ++i) { const float mn = b4 ? sp[4 + i] : sp[i], ot = b4 ? sp[i] : sp[4 + i]; sp[i] = mn + __shfl_xor(ot, 16); }
#pragma unroll
              for (int i = 0; i < 2; ++i) { const float mn = b3 ? sp[2 + i] : sp[i], ot = b3 ? sp[i] : sp[2 + i]; sp[i] = mn + __shfl_xor(ot, 8); }
              { const float mn = b2 ? sp[1] : sp[0], ot = b2 ? sp[0] : sp[1]; sp[0] = mn + __shfl_xor(ot, 4); }
              sp[0] += __shfl_xor(sp[0], 2); sp[0] += __shfl_xor(sp[0], 1); }
            float mine = sp[0], mx = mine;
#pragma unroll
            for (int o = 4; o < 64; o <<= 1) mx = fmaxf(mx, __shfl_xor(mx, o));
            const float ex = expf(mine - mx); float sum = ex;
#pragma unroll
            for (int o = 4; o < 64; o <<= 1) sum += __shfl_xor(sum, o);
            mine = ex / sum;
            const int eo = ((lane >> 5) & 1) * 8 + ((lane >> 4) & 1) * 4 + ((lane >> 3) & 1) * 2 + ((lane >> 2) & 1);
            if ((lane & 3) == 0) { float* aff = (float*)(F.ws + WS_AFF);
                if (latent) aff[((size_t)(row >> 11) * 16 + eo) * 2048 + (row & 2047)] = mine;
                else { const int rc = row - RL; aff[(size_t)524288 + ((size_t)(rc >> 8) * 16 + eo) * 256 + (rc & 255)] = mine; } }
        }
    }
    if (MODE == 1) __syncthreads();
#undef XROW
#undef XLOAD
}

__device__ __forceinline__ void router_norm_phase(Frame& F, int l) {
    const float* mod = (const float*)(F.ws + WS_MOD);
    const bf16* X = (const bf16*)(F.ws + WS_X); unsigned char* H8 = F.ws + WS_H;
    const int nrows = (l == 3) ? RL : RT, per = nrows / (F.G * NWAVES), gw = F.vcu * NWAVES + F.wave, lane = F.lane;
    LAS float* Wt = (LAS float*)F.lds;
    { f32x4 wv_[8];
#pragma unroll
      for (int k_ = 0; k_ < 8; ++k_) { const int idx = F.tid + k_ * NTHR; wv_[k_] = *(const f32x4*)(F.moe_router + ((size_t)l * 1024 + (idx >> 2)) * 16 + (idx & 3) * 4); }
#pragma unroll
      for (int k_ = 0; k_ < 8; ++k_) { const int idx = F.tid + k_ * NTHR, d = idx >> 2, eg = idx & 3;
#pragma unroll
          for (int i = 0; i < 4; ++i) Wt[(eg * 4 + i) * 1024 + d] = wv_[k_][i]; } }
    __syncthreads();
    int cur_b = -1; f32x4 av[4], bv[4];
    v2u nxa[4], nxb[4];
#ifndef N1_REP
#define N1_REP 1
#endif
#pragma unroll 1
    for (int n1rep_ = 0; n1rep_ < N1_REP; ++n1rep_) {
    { const bf16* xr = X + (size_t)(gw * per) * 1024;
#pragma unroll
      for (int j = 0; j < 4; ++j) { nxa[j] = *(const v2u*)(xr + 256 * j + 4 * lane); nxb[j] = *(const v2u*)(xr + 1024 + 256 * j + 4 * lane); } }
    const bool b5 = (lane & 32) != 0, b4 = (lane & 16) != 0, b3 = (lane & 8) != 0, b2 = (lane & 4) != 0;
    const int eo = ((lane >> 5) & 1) * 8 + ((lane >> 4) & 1) * 4 + ((lane >> 3) & 1) * 2 + ((lane >> 2) & 1);
    for (int rr = 0; rr < per; rr += 2) {
        const int row = gw * per + rr; const bool latent = row < RL; const int bidx = latent ? (row >> 11) : 16;
        if (bidx != cur_b) { cur_b = bidx;
            const float* gq = F.norm_g + ((size_t)l * 2 + 1) * 1024; const float* sc = mod + ((size_t)l * 17 + bidx) * 6144 + 4 * 1024; const float* sh = mod + ((size_t)l * 17 + bidx) * 6144 + 3 * 1024;
#pragma unroll
            for (int j = 0; j < 4; ++j) { const f32x4 g4 = *(const f32x4*)(gq + 256 * j + 4 * lane), s4 = *(const f32x4*)(sc + 256 * j + 4 * lane); av[j] = g4 * (s4 + 1.0f); bv[j] = *(const f32x4*)(sh + 256 * j + 4 * lane); } }
        f32x4 va[4], vb[4];
#pragma unroll
        for (int j = 0; j < 4; ++j) { va[j] = (f32x4){bflo(nxa[j].x), bfhi(nxa[j].x), bflo(nxa[j].y), bfhi(nxa[j].y)}; vb[j] = (f32x4){bflo(nxb[j].x), bfhi(nxb[j].x), bflo(nxb[j].y), bfhi(nxb[j].y)}; }
        if (rr + 2 < per) { const bf16* xr = X + (size_t)(row + 2) * 1024;
#pragma unroll
            for (int j = 0; j < 4; ++j) { nxa[j] = *(const v2u*)(xr + 256 * j + 4 * lane); nxb[j] = *(const v2u*)(xr + 1024 + 256 * j + 4 * lane); } }
        float ssa = 0.f, ssb = 0.f;
#pragma unroll
        for (int j = 0; j < 4; ++j) { ssa += (va[j].x * va[j].x + va[j].y * va[j].y) + (va[j].z * va[j].z + va[j].w * va[j].w); ssb += (vb[j].x * vb[j].x + vb[j].y * vb[j].y) + (vb[j].z * vb[j].z + vb[j].w * vb[j].w); }
        ssa = wave_sum_x(ssa); ssb = wave_sum_x(ssb);
        const float rsa = 1.0f / sqrtf(ssa * (1.0f / 1024.0f) + NORM_EPS), rsb = 1.0f / sqrtf(ssb * (1.0f / 1024.0f) + NORM_EPS);
#pragma unroll
        for (int j = 0; j < 4; ++j) { va[j] = va[j] * rsa * av[j] + bv[j]; vb[j] = vb[j] * rsb * av[j] + bv[j];
            *(unsigned*)(H8 + (size_t)row * 1024 + 256 * j + 4 * lane) = pg8::pack4_fp8(va[j].x * pg8::FP8_ACT, va[j].y * pg8::FP8_ACT, va[j].z * pg8::FP8_ACT, va[j].w * pg8::FP8_ACT);
            *(unsigned*)(H8 + (size_t)(row + 1) * 1024 + 256 * j + 4 * lane) = pg8::pack4_fp8(vb[j].x * pg8::FP8_ACT, vb[j].y * pg8::FP8_ACT, vb[j].z * pg8::FP8_ACT, vb[j].w * pg8::FP8_ACT); }
        float spa[16], spb[16];
        pg8::f32x2 h2[16];
#pragma unroll
        for (int j = 0; j < 4; ++j) { h2[4 * j] = (pg8::f32x2){va[j].x, vb[j].x}; h2[4 * j + 1] = (pg8::f32x2){va[j].y, vb[j].y}; h2[4 * j + 2] = (pg8::f32x2){va[j].z, vb[j].z}; h2[4 * j + 3] = (pg8::f32x2){va[j].w, vb[j].w}; }
#pragma unroll
        for (int e = 0; e < 16; ++e) { pg8::f32x2 s0 = {0.f, 0.f}, s1 = {0.f, 0.f};
#pragma unroll
            for (int j = 0; j < 4; ++j) { const f32x4 w = *(const LAS f32x4*)(Wt + e * 1024 + 256 * j + 4 * lane);
                s0 = __builtin_elementwise_fma(h2[4 * j], (pg8::f32x2){w.x, w.x}, s0); s1 = __builtin_elementwise_fma(h2[4 * j + 1], (pg8::f32x2){w.y, w.y}, s1);
                s0 = __builtin_elementwise_fma(h2[4 * j + 2], (pg8::f32x2){w.z, w.z}, s0); s1 = __builtin_elementwise_fma(h2[4 * j + 3], (pg8::f32x2){w.w, w.w}, s1); }
            const pg8::f32x2 st = s0 + s1; spa[e] = st.x; spb[e] = st.y; if ((e & 3) == 3) __builtin_amdgcn_sched_barrier(0); }
#pragma unroll
        for (int i = 0; i < 8; ++i) { spa[i] = sw32sum(spa[i], spa[8 + i]); spb[i] = sw32sum(spb[i], spb[8 + i]); }
#pragma unroll
        for (int i = 0; i < 4; ++i) { spa[i] = sw16sum(spa[i], spa[4 + i]); spb[i] = sw16sum(spb[i], spb[4 + i]); }
#pragma unroll
        for (int i = 0; i < 2; ++i) { const float ma = b3 ? spa[2 + i] : spa[i], oa = b3 ? spa[i] : spa[2 + i], mb = b3 ? spb[2 + i] : spb[i], ob = b3 ? spb[i] : spb[2 + i]; spa[i] = ma + lx8(oa); spb[i] = mb + lx8(ob); }
        { const float ma = b2 ? spa[1] : spa[0], oa = b2 ? spa[0] : spa[1], mb = b2 ? spb[1] : spb[0], ob = b2 ? spb[0] : spb[1]; spa[0] = ma + lx4(oa); spb[0] = mb + lx4(ob); }
        spa[0] += lx2(spa[0]); spb[0] += lx2(spb[0]); spa[0] += lx1(spa[0]); spb[0] += lx1(spb[0]);
        float mxa = spa[0], mxb = spb[0];
        mxa = fmaxf(mxa, lx4(mxa)); mxb = fmaxf(mxb, lx4(mxb)); mxa = fmaxf(mxa, lx8(mxa)); mxb = fmaxf(mxb, lx8(mxb)); mxa = sw16max(mxa); mxb = sw16max(mxb); mxa = sw32max(mxa); mxb = sw32max(mxb);
        const float exa = expf(spa[0] - mxa), exb = expf(spb[0] - mxb); float sma = exa, smb = exb;
        sma += lx4(sma); smb += lx4(smb); sma += lx8(sma); smb += lx8(smb); sma = sw16sum(sma, sma); smb = sw16sum(smb, smb); sma = sw32sum(sma, sma); smb = sw32sum(smb, smb);
        const float pa = exa / sma, pb = exb / smb;
        if ((lane & 3) == 0) { float* aff = (float*)(F.ws + WS_AFF);
            if (latent) { float* ap = aff + ((size_t)(row >> 11) * 16 + eo) * 2048 + (row & 2047); ap[0] = pa; ap[1] = pb; }
            else { const int rc = row - RL; float* ap = aff + (size_t)524288 + ((size_t)(rc >> 8) * 16 + eo) * 256 + (rc & 255); ap[0] = pa; ap[1] = pb; } }
    }
    }
    __syncthreads();
}

template <bool FINAL>
__device__ __forceinline__ void combine_norm_phase(Frame& F, int l, int lp) {
    const float* mod = (const float*)(F.ws + WS_MOD);
    bf16* X = (bf16*)(F.ws + WS_X); bf16* H = (bf16*)(F.ws + WS_H); const unsigned char* Y = F.ws + WS_O;
    const int nrows = FINAL ? RL : RT, per = nrows / (F.G * NWAVES), gw = F.vcu * NWAVES + F.wave, lane = F.lane, row0 = gw * per, rowend = row0 + per;
    struct XRow { v2u x[4]; };
    struct YBuf { unsigned y[4][4]; };
#define Y4F(w_) ({ const unsigned w__ = (w_); const pg8::f32x2 lo__ = __builtin_amdgcn_cvt_pk_f32_fp8((int)w__, false), hi__ = __builtin_amdgcn_cvt_pk_f32_fp8((int)w__, true); (f32x4){lo__.x, lo__.y, hi__.x, hi__.y}; })
    auto load_x = [&](XRow& R, int row) { if (row < rowend) {
#pragma unroll
        for (int j = 0; j < 4; ++j) R.x[j] = *(const v2u*)(X + (size_t)row * 1024 + 256 * j + 4 * lane); } };
    auto load_inv = [&](int row) -> unsigned { return (row < rowend) ? *(const unsigned*)(F.ws + WS_INV + (size_t)row * 32 + 4 * (lane & 7)) : 0xffffffffu; };
    auto mask_of = [&](unsigned inv) -> unsigned { unsigned m = 0u;
#pragma unroll
        for (int q = 0; q < 8; ++q) { const unsigned w = (unsigned)__builtin_amdgcn_readlane((int)inv, q); m |= ((w & 0xffffu) != 0xffffu ? 1u : 0u) << (2 * q); m |= ((w >> 16) != 0xffffu ? 1u : 0u) << (2 * q + 1); }
        return m; };
    auto slot_of = [&](unsigned inv, int e) -> int { unsigned w = 0u;
#pragma unroll
        for (int q = 0; q < 8; ++q) { const unsigned wq = (unsigned)__builtin_amdgcn_readlane((int)inv, q); w = ((e >> 1) == q) ? wq : w; }
        return (int)((w >> (16 * (e & 1))) & 0xffffu); };
    auto yrow = [&](int row, int e, int slot) -> const unsigned char* { const int xb = row < RL ? (row >> 11) * 256 : 4096 + ((row - RL) >> 8) * 32; return Y + (size_t)(e * XR_E + xb + slot) * 1024; };
    auto prefetch_y = [&](YBuf& B, unsigned inv, int row) { unsigned m = mask_of(inv);
#pragma unroll
        for (int k = 0; k < 4; ++k) { if (m) { const int e = __builtin_ctz(m); m &= m - 1u; const unsigned char* yr = yrow(row, e, slot_of(inv, e));
#pragma unroll
            for (int j = 0; j < 4; ++j) B.y[k][j] = *(const unsigned*)(yr + 256 * j + 4 * lane); } } };
    int cur_b = -1; f32x4 av[4], bv[4], g2v[4];
    const bool h8 = (l & 1) ? IN8O : IN8E;
    auto do_row = [&](const XRow& R, unsigned inv, const YBuf& B, int row) {
        const bool latent = row < RL; const int bidx = latent ? (row >> 11) : 16;
        if (bidx != cur_b) { cur_b = bidx;
            const float* g2 = mod + ((size_t)lp * 17 + bidx) * 6144 + 5 * 1024;
            const float* gq = FINAL ? F.final_g : F.norm_g + ((size_t)l * 2) * 1024; const float* sc = mod + ((size_t)l * 17 + bidx) * 6144 + 1 * 1024; const float* sh = mod + ((size_t)l * 17 + bidx) * 6144;
#pragma unroll
            for (int j = 0; j < 4; ++j) { g2v[j] = *(const f32x4*)(g2 + 256 * j + 4 * lane) * (1.0f / pg8::FP8_Y); const f32x4 g4 = *(const f32x4*)(gq + 256 * j + 4 * lane);
                if (FINAL) { av[j] = g4; bv[j] = (f32x4){0.f, 0.f, 0.f, 0.f}; } else { av[j] = g4 * (*(const f32x4*)(sc + 256 * j + 4 * lane) + 1.0f); bv[j] = *(const f32x4*)(sh + 256 * j + 4 * lane); } } }
        f32x4 a[4];
#pragma unroll
        for (int j = 0; j < 4; ++j) a[j] = (f32x4){0.f, 0.f, 0.f, 0.f};
        unsigned m = mask_of(inv);
#pragma unroll
        for (int k = 0; k < 4; ++k) { if (m) { m &= m - 1u;
#pragma unroll
            for (int j = 0; j < 4; ++j) a[j] += Y4F(B.y[k][j]); } }
        while (m) { const int e = __builtin_ctz(m); m &= m - 1u; const unsigned char* yr = yrow(row, e, slot_of(inv, e));
#pragma unroll
            for (int j = 0; j < 4; ++j) a[j] += Y4F(*(const unsigned*)(yr + 256 * j + 4 * lane)); }
        f32x4 v[4]; float ss = 0.f;
#pragma unroll
        for (int j = 0; j < 4; ++j) { v[j] = (f32x4){bflo(R.x[j].x), bfhi(R.x[j].x), bflo(R.x[j].y), bfhi(R.x[j].y)} + g2v[j] * a[j];
            if (!FINAL) { v2u w; w.x = pk2(v[j].x, v[j].y); w.y = pk2(v[j].z, v[j].w); *(v2u*)(X + (size_t)row * 1024 + 256 * j + 4 * lane) = w; } ss += (v[j].x * v[j].x + v[j].y * v[j].y) + (v[j].z * v[j].z + v[j].w * v[j].w); }
        const float rstd = 1.0f / sqrtf(wave_sum(ss) * (1.0f / 1024.0f) + NORM_EPS);
#pragma unroll
        for (int j = 0; j < 4; ++j) { const f32x4 hv = v[j] * rstd * av[j] + bv[j];
            if (FINAL) *(f32x4*)(F.out + (size_t)row * 1024 + 256 * j + 4 * lane) = hv;
            else if (h8) *(unsigned*)((unsigned char*)H + (size_t)row * 1024 + 256 * j + 4 * lane) = pg8::pack4_fp8(hv.x * pg8::FP8_ACT, hv.y * pg8::FP8_ACT, hv.z * pg8::FP8_ACT, hv.w * pg8::FP8_ACT);
            else { v2u w; w.x = pk2(hv.x, hv.y); w.y = pk2(hv.z, hv.w); *(v2u*)(H + (size_t)row * 1024 + 256 * j + 4 * lane) = w;
                if (l & 1) *(unsigned*)(F.ws + WS_H8O + (size_t)row * 1024 + 256 * j + 4 * lane) = pg8::pack4_fp8(hv.x * pg8::FP8_ACT, hv.y * pg8::FP8_ACT, hv.z * pg8::FP8_ACT, hv.w * pg8::FP8_ACT); } } };
    XRow XA, XB, XC, XD; YBuf YA, YB, YC, YD;
    unsigned iA = load_inv(row0), iB = load_inv(row0 + 1), iC = load_inv(row0 + 2), iD = load_inv(row0 + 3);
    load_x(XA, row0); load_x(XB, row0 + 1);
    prefetch_y(YA, iA, row0); prefetch_y(YB, iB, row0 + 1);
    for (int rr = 0; rr < per; rr += 2) {
        const int row = row0 + rr;
        load_x(XC, row + 2); load_x(XD, row + 3);
        const unsigned iE = load_inv(row + 4), iF = load_inv(row + 5);
        if (rr + 2 < per) { prefetch_y(YC, iC, row + 2); prefetch_y(YD, iD, row + 3); }
        do_row(XA, iA, YA, row);
        do_row(XB, iB, YB, row + 1);
        XA = XC; XB = XD; YA = YC; YB = YD; iA = iC; iB = iD; iC = iE; iD = iF;
    }
}

template <int NPL>
__device__ __forceinline__ void select_wave(const float* aff, int cap, int lane, LAS unsigned short* idx_lds, float* gate, unsigned short* inv, unsigned short* gidx, int rowbase) {
    unsigned v[NPL];
#pragma unroll
    for (int q = 0; q < NPL / 4; ++q) { const v4u w = *(const v4u*)(aff + lane * NPL + 4 * q); v[4 * q] = w.x; v[4 * q + 1] = w.y; v[4 * q + 2] = w.z; v[4 * q + 3] = w.w; }
    unsigned T = 0;
    for (int bit = 30; bit >= 0; --bit) { const unsigned cand = T | (1u << bit); int cnt = 0;
#pragma unroll
        for (int k = 0; k < NPL; ++k) cnt += __popcll(__ballot(v[k] >= cand));
        if (cnt >= cap) T = cand; }
    int cg = 0, ce = 0;
#pragma unroll
    for (int k = 0; k < NPL; ++k) { cg += (v[k] > T) ? 1 : 0; ce += (v[k] == T) ? 1 : 0; }
    const int need = cap - wave_sum_i(cg);
    int er = wave_incl_scan(ce, lane) - ce; int cs = 0; unsigned selmask = 0;
#pragma unroll
    for (int k = 0; k < NPL; ++k) { bool sel = v[k] > T; if (v[k] == T) { sel = er < need; ++er; } selmask |= (sel ? 1u : 0u) << k; cs += sel ? 1 : 0; }
    int slot = wave_incl_scan(cs, lane) - cs;
#pragma unroll
    for (int k = 0; k < NPL; ++k) { const int t = lane * NPL + k;
        if ((selmask >> k) & 1u) { idx_lds[slot] = (unsigned short)t; gidx[slot] = (unsigned short)(rowbase + t); gate[slot] = __builtin_bit_cast(float, v[k]); inv[(size_t)t * 16] = (unsigned short)slot; ++slot; }
        else inv[(size_t)t * 16] = (unsigned short)0xffffu; }
}
__device__ __forceinline__ void select_phase(Frame& F, int l, int parts = 3) {
    LAS unsigned short* idxL = (LAS unsigned short*)F.lds;
    LAS unsigned short* idxC = idxL + 256;
    const float* aff = (const float*)(F.ws + WS_AFF); float* gate = (float*)(F.ws + WS_GATE); unsigned short* inv = (unsigned short*)(F.ws + WS_INV);
    const unsigned char* H8 = F.ws + WS_H; unsigned char* XS = F.ws + WS_O;
    unsigned short* gix = (unsigned short*)(F.ws + WS_IDX);
    const bool with_ctx = l < 3;
    for (int u = F.vcu; u < 256; u += F.G) {
        const int b = u >> 4, e = u & 15;
        if ((parts & 1) && F.wave == 0) select_wave<32>(aff + ((size_t)b * 16 + e) * 2048, CAPL, F.lane, idxL, gate + (size_t)e * XR_E + b * 256, inv + (size_t)(b * 2048) * 16 + e, gix + (size_t)e * XR_E + b * 256, b * 2048);
        if ((parts & 1) && F.wave == 1 && with_ctx) select_wave<4>(aff + 524288 + ((size_t)b * 16 + e) * 256, CAPC, F.lane, idxC, gate + (size_t)e * XR_E + 4096 + b * 32, inv + (size_t)(RL + b * 256) * 16 + e, gix + (size_t)e * XR_E + 4096 + b * 32, RL + b * 256);
        __syncthreads();
        if (parts & 2) {
#pragma unroll 1
        for (int r0 = F.wave * 32; r0 < F.wave * 32 + 32; r0 += 8) { v4u tmp[8];
#pragma unroll
            for (int q = 0; q < 8; ++q) tmp[q] = ((const v4u*)(H8 + (size_t)(b * 2048 + (int)idxL[r0 + q]) * 1024))[F.lane];
#pragma unroll
            for (int q = 0; q < 8; ++q) ((v4u*)(XS + (size_t)(e * XR_E + b * 256 + r0 + q) * 1024))[F.lane] = tmp[q]; }
        if (with_ctx) { v4u tmp[4];
#pragma unroll
            for (int q = 0; q < 4; ++q) tmp[q] = ((const v4u*)(H8 + (size_t)(RL + b * 256 + (int)idxC[F.wave * 4 + q]) * 1024))[F.lane];
#pragma unroll
            for (int q = 0; q < 4; ++q) ((v4u*)(XS + (size_t)(e * XR_E + 4096 + b * 32 + F.wave * 4 + q) * 1024))[F.lane] = tmp[q]; }
        }
        __syncthreads();
    }
}


namespace att {
constexpr int SHM_V = 64 * 128 * 2, SHM_K = 64 * 128 * 2;
constexpr int OFF_V = 0, OFF_K = 2 * SHM_V, OFF_WS = OFF_K + 2 * SHM_K, OFF_RPB = OFF_WS + 8 * 1024, OFF_Q = OFF_RPB, OFF_END = OFF_Q + 8 * 8192;
#define KSWZ(row, colB) ((row) * 256 + ((colB) ^ (((row) & 7) << 4)))
#define SBAR() __builtin_amdgcn_sched_barrier(0)
__device__ __forceinline__ int crow(int r, int hi) { return (r & 3) + 8 * (r >> 2) + 4 * hi; }
__device__ __forceinline__ unsigned cvtpk(float lo, float hi) { return pg8::cvt_pk_bf16(lo, hi); }
__device__ __forceinline__ int v_st(int k, int c) { const int kk = (k & ~0xC) | ((k & 4) << 1) | ((k & 8) >> 1); return ((kk >> 3) * 4 + (c >> 5)) * 512 + ((kk & 7) * 32 + (c & 31)) * 2; }
__device__ __forceinline__ int v_rd_base(int lane) { return ((lane & 3) << 3) | (((lane >> 2) & 3) << 6) | (((lane >> 4) & 1) << 5) | (((lane >> 5) & 1) << 8); }
constexpr int v_rd_off(int d0, int ks, int half) { return d0 * 512 + ks * 4096 + half * 2048; }
template <int OFF> __device__ __forceinline__ s16x4 tr_read(int vb) { s16x4 r; asm volatile("ds_read_b64_tr_b16 %0, %1 offset:%2" : "=&v"(r) : "v"(vb), "i"(OFF) : "memory"); return r; }
template <int D0> __device__ __forceinline__ void pv_one(f32x16& od, int vb, bf16x8 pa0, bf16x8 pa1, bf16x8 pa2, bf16x8 pa3) {
    const s16x4 l0 = tr_read<v_rd_off(D0, 0, 0)>(vb), h0 = tr_read<v_rd_off(D0, 0, 1)>(vb), l1 = tr_read<v_rd_off(D0, 1, 0)>(vb), h1 = tr_read<v_rd_off(D0, 1, 1)>(vb);
    const s16x4 l2 = tr_read<v_rd_off(D0, 2, 0)>(vb), h2 = tr_read<v_rd_off(D0, 2, 1)>(vb), l3 = tr_read<v_rd_off(D0, 3, 0)>(vb), h3 = tr_read<v_rd_off(D0, 3, 1)>(vb);
    asm volatile("s_waitcnt lgkmcnt(0)" ::: "memory"); SBAR();
#define PKV(L, H) (bf16x8){L[0], L[1], L[2], L[3], H[0], H[1], H[2], H[3]}
    __builtin_amdgcn_s_setprio(1);
    od = __builtin_amdgcn_mfma_f32_32x32x16_bf16(pa0, PKV(l0, h0), od, 0, 0, 0);
    od = __builtin_amdgcn_mfma_f32_32x32x16_bf16(pa1, PKV(l1, h1), od, 0, 0, 0);
    od = __builtin_amdgcn_mfma_f32_32x32x16_bf16(pa2, PKV(l2, h2), od, 0, 0, 0);
    od = __builtin_amdgcn_mfma_f32_32x32x16_bf16(pa3, PKV(l3, h3), od, 0, 0, 0);
    __builtin_amdgcn_s_setprio(0);
#undef PKV
}
template <int MAP, bool QLDS> __device__ __forceinline__ void qkt_map(f32x16& p0, f32x16& p1, const LAS char* Ks, const bf16x8* qr, const LAS char* ql, int r32, int hi) {
    p0 = f32x16{}; p1 = f32x16{};
#pragma unroll
    for (int d0 = 4 * MAP; d0 < 4 * MAP + 4; ++d0) { const int cb = (d0 * 16 + hi * 8) * 2;
        const bf16x8 b0 = *(const LAS bf16x8*)(Ks + KSWZ(r32, cb));
        const bf16x8 b1 = *(const LAS bf16x8*)(Ks + KSWZ(32 + r32, cb));
        const bf16x8 q = QLDS ? *(const LAS bf16x8*)(ql + d0 * 1024) : qr[QLDS ? 0 : d0];
        p0 = __builtin_amdgcn_mfma_f32_32x32x16_bf16(b0, q, p0, 0, 0, 0);
        p1 = __builtin_amdgcn_mfma_f32_32x32x16_bf16(b1, q, p1, 0, 0, 0); }
}
template <bool RAW>
__device__ __forceinline__ void sm_step(f32x16& p0, f32x16& p1, float& m, float& l, float& alpha, bf16x8& pa0, bf16x8& pa1, bf16x8& pa2, bf16x8& pa3) {
    constexpr float C = 0.125f * 1.4426950408889634f;
    float pmax = p0[0];
#pragma unroll
    for (int r = 1; r < 16; ++r) pmax = fmaxf(pmax, p0[r]);
#pragma unroll
    for (int r = 0; r < 16; ++r) pmax = fmaxf(pmax, p1[r]);
    { auto rr = __builtin_amdgcn_permlane32_swap(__float_as_uint(pmax), __float_as_uint(pmax), false, false); pmax = fmaxf(__uint_as_float(rr[0]), __uint_as_float(rr[1])); }
    float mn;
    if (__builtin_expect(__all(pmax - m <= (RAW ? 64.0f : 11.5416f)), 1)) { mn = m; alpha = 1.f; }
    else { mn = fmaxf(m, pmax); alpha = __builtin_amdgcn_exp2f(RAW ? (m - mn) * C : (m - mn)); m = mn; }
    const float mnc = RAW ? -mn * C : -mn;
    typedef float f2v __attribute__((ext_vector_type(2)));
    f2v psv = {0.f, 0.f}; const f2v cv = {C, C}, mv = {mnc, mnc};
#pragma unroll
    for (int r = 0; r < 16; r += 2) { f2v t = {p0[r], p0[r + 1]}; t = RAW ? __builtin_elementwise_fma(t, cv, mv) : t + mv; t.x = __builtin_amdgcn_exp2f(t.x); t.y = __builtin_amdgcn_exp2f(t.y); p0[r] = t.x; p0[r + 1] = t.y; psv += t; }
#pragma unroll
    for (int r = 0; r < 16; r += 2) { f2v t = {p1[r], p1[r + 1]}; t = RAW ? __builtin_elementwise_fma(t, cv, mv) : t + mv; t.x = __builtin_amdgcn_exp2f(t.x); t.y = __builtin_amdgcn_exp2f(t.y); p1[r] = t.x; p1[r + 1] = t.y; psv += t; }
    float ps = psv.x + psv.y;
    { auto rr = __builtin_amdgcn_permlane32_swap(__float_as_uint(ps), __float_as_uint(ps), false, false); ps = __uint_as_float(rr[0]) + __uint_as_float(rr[1]); }
    l = l * alpha + ps;
#define PK4(P, BASE, OUT) do { unsigned a0 = cvtpk(P[BASE + 0], P[BASE + 1]), a1 = cvtpk(P[BASE + 2], P[BASE + 3]);   \
    unsigned b0 = cvtpk(P[BASE + 4], P[BASE + 5]), b1 = cvtpk(P[BASE + 6], P[BASE + 7]);                              \
    auto r0 = __builtin_amdgcn_permlane32_swap(a0, b0, false, false); auto r1 = __builtin_amdgcn_permlane32_swap(a1, b1, false, false); \
    v4u w = {r0[0], r1[0], r0[1], r1[1]}; OUT = __builtin_bit_cast(bf16x8, w); } while (0)
    PK4(p0, 0, pa0); PK4(p0, 8, pa1); PK4(p1, 0, pa2); PK4(p1, 8, pa3);
#undef PK4
}

struct UnitDesc {
    int qrow0;
    int qcol, kcol, vcol, ocol;
    int nloc, loc_row0, ctx_row0;
    int na_local;
    int qr0, kr0;
    int rpb_off;
};

template <bool DIFF>
__device__ __forceinline__ void attn_unit(LAS unsigned char* lds, const bf16* __restrict__ P, bf16* __restrict__ Out, const UnitDesc U, const float* __restrict__ rpb,
                                          float lam, float oscale, const float* __restrict__ subln_g, int wid_in) {
    int lane_; asm volatile("v_mbcnt_lo_u32_b32 %0, -1, 0\n\tv_mbcnt_hi_u32_b32 %0, -1, %0" : "=v"(lane_));
    const int lane = lane_, wid = wid_in, tid = wid * 64 + lane, r32 = lane & 31, hi = lane >> 5;
    constexpr float L2E = 1.4426950408889634f, C = 0.125f * L2E;
    LAS char* V_lds = (LAS char*)lds + OFF_V; LAS char* K_lds = (LAS char*)lds + OFF_K;
    LAS float* wsc = (LAS float*)(lds + OFF_WS) + wid * 256;
    LAS float* rpbx = (LAS float*)(lds + OFF_RPB);
    if (!DIFF && U.na_local) {
        float tv_[8];
#pragma unroll
        for (int k_ = 0; k_ < 8; ++k_) { const int idx = tid + k_ * NTHR; const int hd = idx / 1920, rem = idx % 1920, dr = rem >> 7, x = rem & 127;
            tv_[k_] = (idx < 2 * 15 * 128 && x >= 48 && x <= 78) ? rpb[U.rpb_off + hd * 465 + dr * 31 + (x - 48)] * L2E : 0.f; }
#pragma unroll
        for (int k_ = 0; k_ < 8; ++k_) { const int idx = tid + k_ * NTHR; if (idx < 2 * 15 * 128) rpbx[idx] = tv_[k_]; }
    }
    bf16x8 qr[DIFF ? 1 : 8];
    const LAS char* ql = (const LAS char*)lds + OFF_Q + wid * 8192 + lane * 16;
    { const bf16* Qw = P + (size_t)(U.qrow0 + wid * 32 + r32) * LD_EVEN + U.qcol + hi * 8;
#pragma unroll
      for (int d0 = 0; d0 < 8; ++d0) { const bf16x8 q = *(const bf16x8*)(Qw + d0 * 16); if (DIFF) *(LAS bf16x8*)((LAS char*)lds + OFF_Q + wid * 8192 + lane * 16 + d0 * 1024) = q; else qr[DIFF ? 0 : d0] = q; } }
    unsigned gK[2], gV[2];
#pragma unroll
    for (int p = 0; p < 2; ++p) { const int o = (2 * wid + p) * 1024 + 16 * lane;
        { const int row = o >> 8, cb = (o & 255) ^ ((row & 7) << 4); gK[p] = (unsigned)(row * LD_EVEN + (cb >> 1)); }
        { const int sub = o >> 9, w = (o & 511) >> 1, kk = (sub >> 2) * 8 + (w >> 5), c = (sub & 3) * 32 + (w & 31), k = (kk & ~0xC) | ((kk & 4) << 1) | ((kk & 8) >> 1); gV[p] = (unsigned)(k * LD_EVEN + c); } }
    const int vb0 = (int)(uintptr_t)V_lds + v_rd_base(lane);
    const int ntiles = U.nloc + 4;
    const int qrw = U.qr0 + (wid >> 1), qc = 32 * (wid & 1) + r32;
    const int cst = min(max(qc - 8, 0), 48), rsw = min(max(qrw - 4, 0), 24);
    float m0 = -1e30f, l0 = 0.f, m1 = -1e30f, l1 = 0.f;
    f32x16 oa[4] = {}, ob[DIFF ? 4 : 1] = {};
#define TILE_ROW(j) ((j) < U.nloc ? U.loc_row0 + 64 * (j) : U.ctx_row0 + 64 * ((j) - U.nloc))
#define SDMA(j, b) do { const bf16* base = P + (size_t)TILE_ROW(j) * LD_EVEN; _Pragma("unroll") for (int p = 0; p < 2; ++p) { \
        __builtin_amdgcn_global_load_lds((const unsigned*)(base + U.kcol + gK[p]), (LAS unsigned*)(K_lds + (b) * SHM_K + (2 * wid + p) * 1024), 16, 0, 0); \
        __builtin_amdgcn_global_load_lds((const unsigned*)(base + U.vcol + gV[p]), (LAS unsigned*)(V_lds + (b) * SHM_V + (2 * wid + p) * 1024), 16, 0, 0); } } while (0)
#define RESC(acc, n0, n1, a, slot) do { if (__any((a) < 1.f)) { if (hi == 0) wsc[(slot) * 32 + r32] = (a); asm volatile("s_waitcnt lgkmcnt(0)" ::: "memory"); \
        _Pragma("unroll") for (int r = 0; r < 16; ++r) { const float al = wsc[(slot) * 32 + crow(r, hi)]; _Pragma("unroll") for (int d = (n0); d < (n1); ++d) acc[d][r] *= al; } } } while (0)
    SDMA(0, 0); VM_WAIT(); __syncthreads();
    for (int j = 0; j < ntiles; ++j) {
        const int buf = j & 1;
        if (j + 1 < ntiles) SDMA(j + 1, buf ^ 1);
        const bool local = j < U.nloc;
        bool active = true; int kr = 0;
        if (!DIFF && U.na_local && local) { kr = U.kr0 + j; active = (kr >= rsw) && (kr < rsw + 8); }
        if (active) {
            const LAS char* Kb = K_lds + buf * SHM_K; const int vb = vb0 + buf * SHM_V;
            f32x16 p0, p1; bf16x8 pa0, pa1, pa2, pa3; float alpha;
            qkt_map<0, DIFF>(p0, p1, Kb, qr, ql, r32, hi);
            if (!DIFF && U.na_local && local) {
                const LAS float* bp = rpbx + (kr - qrw + 7) * 128 + (63 - qc + 4 * hi); const int vbs = 4 * hi - cst;
#pragma unroll
                for (int r = 0; r < 16; ++r) { const int kc0 = (r & 3) + 8 * (r >> 2);
                    p0[r] = ((unsigned)(vbs + kc0) < 16u) ? fmaf(p0[r], C, bp[kc0]) : -1e30f;
                    p1[r] = ((unsigned)(vbs + kc0 + 32) < 16u) ? fmaf(p1[r], C, bp[kc0 + 32]) : -1e30f; }
            } else if (!DIFF) {
#pragma unroll
                for (int r = 0; r < 16; ++r) { p0[r] *= C; p1[r] *= C; }
            }
            sm_step<DIFF>(p0, p1, m0, l0, alpha, pa0, pa1, pa2, pa3);
            if (DIFF) { RESC(oa, 0, 4, alpha, 0); pv_one<0>(oa[0], vb, pa0, pa1, pa2, pa3); pv_one<1>(oa[1], vb, pa0, pa1, pa2, pa3); pv_one<2>(oa[2], vb, pa0, pa1, pa2, pa3); pv_one<3>(oa[3], vb, pa0, pa1, pa2, pa3); }
            else      { RESC(oa, 0, 2, alpha, 0); pv_one<0>(oa[0], vb, pa0, pa1, pa2, pa3); pv_one<1>(oa[1], vb, pa0, pa1, pa2, pa3); }
            qkt_map<1, DIFF>(p0, p1, Kb, qr, ql, r32, hi);
            if (!DIFF && U.na_local && local) {
                const LAS float* bp = rpbx + 1920 + (kr - qrw + 7) * 128 + (63 - qc + 4 * hi); const int vbs = 4 * hi - cst;
#pragma unroll
                for (int r = 0; r < 16; ++r) { const int kc0 = (r & 3) + 8 * (r >> 2);
                    p0[r] = ((unsigned)(vbs + kc0) < 16u) ? fmaf(p0[r], C, bp[kc0]) : -1e30f;
                    p1[r] = ((unsigned)(vbs + kc0 + 32) < 16u) ? fmaf(p1[r], C, bp[kc0 + 32]) : -1e30f; }
            } else if (!DIFF) {
#pragma unroll
                for (int r = 0; r < 16; ++r) { p0[r] *= C; p1[r] *= C; }
            }
            sm_step<DIFF>(p0, p1, m1, l1, alpha, pa0, pa1, pa2, pa3);
            if (DIFF) { RESC(ob, 0, 4, alpha, 1); pv_one<0>(ob[0], vb, pa0, pa1, pa2, pa3); pv_one<1>(ob[1], vb, pa0, pa1, pa2, pa3); pv_one<2>(ob[2], vb, pa0, pa1, pa2, pa3); pv_one<3>(ob[3], vb, pa0, pa1, pa2, pa3); }
            else      { RESC(oa, 2, 4, alpha, 1); pv_one<2>(oa[2], vb, pa0, pa1, pa2, pa3); pv_one<3>(oa[3], vb, pa0, pa1, pa2, pa3); }
        }
        VM_WAIT(); __syncthreads();
    }
    if (hi == 0) { wsc[r32] = 1.0f / l0; wsc[32 + r32] = 1.0f / l1; }
    asm volatile("s_waitcnt lgkmcnt(0)" ::: "memory");
    bf16* Ow = Out + (size_t)(U.qrow0 + wid * 32) * 1024 + U.ocol;
    if (DIFF) {
        float gl[4];
#pragma unroll
        for (int d0 = 0; d0 < 4; ++d0) gl[d0] = subln_g[d0 * 32 + r32] * oscale;
#pragma unroll
        for (int r = 0; r < 16; ++r) { const int q = crow(r, hi); const float ra = wsc[q], rb = wsc[32 + q] * lam; float v[4], ss = 0.f;
#pragma unroll
            for (int d0 = 0; d0 < 4; ++d0) { v[d0] = oa[d0][r] * ra - ob[d0][r] * rb; ss += v[d0] * v[d0]; }
#pragma unroll
            for (int o = 1; o < 32; o <<= 1) ss += __shfl_xor(ss, o);
            const float rstd = 1.0f / sqrtf(ss * (1.0f / 128.0f) + NORM_EPS);
#pragma unroll
            for (int d0 = 0; d0 < 4; ++d0) Ow[(size_t)q * 1024 + d0 * 32 + r32] = (bf16)f2bf(v[d0] * rstd * gl[d0]); }
    } else {
#pragma unroll
        for (int r = 0; r < 16; ++r) { const int q = crow(r, hi); const float ra = wsc[q], rb = wsc[32 + q];
            Ow[(size_t)q * 1024 + r32] = (bf16)f2bf(oa[0][r] * ra); Ow[(size_t)q * 1024 + 32 + r32] = (bf16)f2bf(oa[1][r] * ra);
            Ow[(size_t)q * 1024 + 64 + r32] = (bf16)f2bf(oa[2][r] * rb); Ow[(size_t)q * 1024 + 96 + r32] = (bf16)f2bf(oa[3][r] * rb); }
    }
    __syncthreads();
#undef TILE_ROW
#undef SDMA
#undef RESC
}

__device__ __forceinline__ void attn_phase(Frame& F, int l) {
    const int ev = l >> 1;
    const bf16* P = (const bf16*)(F.ws + WS_P); bf16* O = (bf16*)(F.ws + WS_O);
    const float lam_init = 0.8f - 0.6f * expf(-0.3f * (float)l);
    const float* lv = F.diff_lambda + ev * 256;
    const float s01 = wave_sum(lv[F.lane] * lv[64 + F.lane]), s23 = wave_sum(lv[128 + F.lane] * lv[192 + F.lane]);
    const float lam = expf(s01) - expf(s23) + lam_init;
    const float* subln = F.diff_subln_g + ev * 128;
    const float* rpb = F.na_rpb + (size_t)ev * 8 * 465;
#pragma unroll 1
    for (int i = 0; i < 3; ++i) {
        UnitDesc U; U.na_local = 0; U.qr0 = 0; U.kr0 = 0; U.rpb_off = 0;
        if (i < 2) { const int u = F.vcu + 256 * i; if (u >= 512) break; const int b = u >> 5, h = (u >> 3) & 3, qb = u & 7;
            U.qrow0 = b * 2048 + qb * 256; U.nloc = 32; U.loc_row0 = b * 2048; U.ctx_row0 = RL + b * 256; U.qcol = 512 + h * 128; U.kcol = 2048 + h * 128; U.vcol = 2560 + h * 128; U.ocol = 512 + h * 128; }
        else { const int u = F.vcu; if (u >= 64) break; const int b = u >> 2, h = u & 3;
            U.qrow0 = RL + b * 256; U.nloc = 0; U.loc_row0 = 0; U.ctx_row0 = RL + b * 256; U.qcol = 512 + h * 128; U.kcol = 2048 + h * 128; U.vcol = 2560 + h * 128; U.ocol = 512 + h * 128; }
        attn_unit<true>(F.lds, P, O, U, rpb, lam, 1.0f - lam_init, subln, F.wave);
    }
#pragma unroll 1
    for (int i = 0; i < 3; ++i) {
        UnitDesc U;
        if (i < 2) { const int u = F.vcu + 256 * i; if (u >= 512) break; const int b = u >> 5, hp = (u >> 3) & 3, g = u & 7;
            const int krlo = min(max(4 * g - 4, 0), 24), krhi = min(max(4 * g + 3 - 4, 0), 24) + 7;
            U.qrow0 = b * 2048 + g * 256; U.nloc = krhi - krlo + 1; U.loc_row0 = b * 2048 + krlo * 64; U.ctx_row0 = RL + b * 256; U.qcol = hp * 128; U.kcol = 1024 + hp * 128; U.vcol = 1536 + hp * 128; U.ocol = hp * 128;
            U.na_local = 1; U.qr0 = 4 * g; U.kr0 = krlo; U.rpb_off = hp * 2 * 465; }
        else { const int u = F.vcu - 64; if (u < 0 || u >= 64) break; const int b = u >> 2, hp = u & 3;
            U.qrow0 = RL + b * 256; U.nloc = 0; U.loc_row0 = 0; U.ctx_row0 = RL + b * 256; U.qcol = hp * 128; U.kcol = 1024 + hp * 128; U.vcol = 1536 + hp * 128; U.ocol = hp * 128;
            U.na_local = 0; U.qr0 = 0; U.kr0 = 0; U.rpb_off = 0; }
        attn_unit<false>(F.lds, P, O, U, rpb, 0.f, 1.f, subln, F.wave);
    }
}
}


namespace scan {
typedef float f4 __attribute__((ext_vector_type(4)));
constexpr int QD_STRIDE = 272, KT_STRIDE = 80;
constexpr int OFF_QD = 0, OFF_KD = OFF_QD + 32 * QD_STRIDE, OFF_KLT = OFF_KD + 32 * QD_STRIDE, OFF_VT = OFF_KLT + 128 * KT_STRIDE, OFF_D = OFF_VT + 128 * KT_STRIDE, OFF_PT = OFF_D + 512, BUF_BYTES = OFF_PT + 2048;
__device__ __forceinline__ bf16x8 pack8(f4 a, f4 b) { v4u w; w.x = pg8::cvt_pk_bf16(a[0], a[1]); w.y = pg8::cvt_pk_bf16(a[2], a[3]); w.z = pg8::cvt_pk_bf16(b[0], b[1]); w.w = pg8::cvt_pk_bf16(b[2], b[3]); return __builtin_bit_cast(bf16x8, w); }
__device__ __forceinline__ bf16x8 ld2x8(const LAS char* p0, const LAS char* p1) { const v2u a = *(const LAS v2u*)p0, b = *(const LAS v2u*)p1; v4u w = {a.x, a.y, b.x, b.y}; return __builtin_bit_cast(bf16x8, w); }

__device__ __forceinline__ void scan_phase(Frame& F, int l) {
    const bf16* P = (const bf16*)(F.ws + WS_P);
    const int lane = F.lane, wid = F.wave, ln = lane & 15, g = lane >> 4;
    const bool prep = wid < 4; const int mw = wid - 4;
    const int d0 = 32 * (wid & 3) + 2 * (lane & 15), tg = lane >> 4;
    for (int u = F.vcu; u < 256; u += F.G) {
        const int b = u >> 4, h = (u >> 1) & 7, dir = u & 1, sgn = dir ? -1 : 1;
        bf16* Od = (bf16*)(F.ws + (dir ? WS_OB : WS_OF));
        float lbv[2];
#pragma unroll
        for (int cc = 0; cc < 2; ++cc) { const float* lg = F.rec_lb_logits + (size_t)dir * 4 * 1024 + h * 128 + d0 + cc; const float a0 = lg[0], a1 = lg[1024], a2 = lg[2048], a3 = lg[3072];
          const float mx = fmaxf(fmaxf(a0, a1), fmaxf(a2, a3)); const float e0 = expf(a0 - mx), e1 = expf(a1 - mx), e2 = expf(a2 - mx), e3 = expf(a3 - mx); const float inv = 1.0f / (e0 + e1 + e2 + e3);
          lbv[cc] = (l == 1) ? e1 * inv : (e1 + e2 + e3) * inv; }
        const float lb0 = lbv[0], lb1 = lbv[1], om0 = 1.0f - lb0, om1 = 1.0f - lb1;
        const int qcol = h * 128 + d0, fcol = (dir ? 2048 : 1024) + h * 128 + d0, vcol = 3072 + h * 128 + d0;
        f4 st[2][8];
#pragma unroll
        for (int s2 = 0; s2 < 2; ++s2)
#pragma unroll
            for (int k = 0; k < 8; ++k) st[s2][k] = (f4){0.f, 0.f, 0.f, 0.f};
        const int nchunks = 8 + 64;
        unsigned rq[8], rf[8], rv[8];
#define SROW0(c) ((c) < 8 ? (RL + b * 256 + (dir ? 255 - 32 * (c) : 32 * (c))) : (b * 2048 + (dir ? 2047 - 32 * ((c) - 8) : 32 * ((c) - 8))))
#define SLOADC(c) do { const unsigned rb_ = (unsigned)(SROW0(c) + sgn * 8 * tg) * (unsigned)(LD_ODD * 2); const unsigned rs_ = (unsigned)(sgn * LD_ODD * 2);     \
            _Pragma("unroll") for (int k = 0; k < 8; ++k) { const unsigned ro = rb_ + (unsigned)k * rs_; \
            rq[k] = *(const unsigned*)((const char*)P + (ro + 2u * (unsigned)qcol)); rf[k] = *(const unsigned*)((const char*)P + (ro + 2u * (unsigned)fcol)); rv[k] = *(const unsigned*)((const char*)P + (ro + 2u * (unsigned)vcol)); } } while (0)
        if (prep) SLOADC(0);
        for (int it = 0; it <= nchunks; ++it) {
            if (prep) {
                if (it < nchunks) {
                    const int c = it; LAS char* buf = (LAS char*)F.lds + (c & 1) * BUF_BYTES;
                    float kk0[8], kk1[8], lp0[8], lp1[8]; unsigned qp[8], vp[8];
                    { float run0 = 1.0f, run1 = 1.0f;
#pragma unroll
                      for (int k = 0; k < 8; ++k) { const float sg0 = bflo(rf[k]), sg1 = bfhi(rf[k]);
                          kk0[k] = om0 * (1.0f - sg0); kk1[k] = om1 * (1.0f - sg1); run0 *= lb0 + om0 * sg0; run1 *= lb1 + om1 * sg1; lp0[k] = run0; lp1[k] = run1; qp[k] = rq[k]; vp[k] = rv[k]; } }
                    if (c + 1 < nchunks) SLOADC(c + 1);
                    const float ta0 = __shfl_xor(lp0[7], 16), ta1 = __shfl_xor(lp1[7], 16); const float pp0 = lp0[7] * ta0, pp1 = lp1[7] * ta1;
                    const float pq0 = __shfl_xor(pp0, 32), pq1 = __shfl_xor(pp1, 32); const float plast0 = pp0 * pq0, plast1 = pp1 * pq1;
                    const float po0 = ((tg & 2) ? pq0 : 1.0f) * ((tg & 1) ? ta0 : 1.0f), po1 = ((tg & 2) ? pq1 : 1.0f) * ((tg & 1) ? ta1 : 1.0f);
                    float kl0[8], kl1[8];
#pragma unroll
                    for (int k = 0; k < 8; ++k) { const float p0 = po0 * lp0[k], p1 = po1 * lp1[k]; const float kd0 = kk0[k] * __builtin_amdgcn_rcpf(p0), kd1 = kk1[k] * __builtin_amdgcn_rcpf(p1);
                        kl0[k] = kd0 * plast0; kl1[k] = kd1 * plast1;
                        *(LAS unsigned*)(buf + OFF_QD + (8 * tg + k) * QD_STRIDE + 2 * d0) = pk2(bflo(qp[k]) * p0, bfhi(qp[k]) * p1);
                        *(LAS unsigned*)(buf + OFF_KD + (8 * tg + k) * QD_STRIDE + 2 * d0) = pk2(kd0, kd1); }
                    *(LAS v4u*)(buf + OFF_KLT + d0 * KT_STRIDE + 16 * tg) = (v4u){pk2(kl0[0], kl0[1]), pk2(kl0[2], kl0[3]), pk2(kl0[4], kl0[5]), pk2(kl0[6], kl0[7])};
                    *(LAS v4u*)(buf + OFF_KLT + (d0 + 1) * KT_STRIDE + 16 * tg) = (v4u){pk2(kl1[0], kl1[1]), pk2(kl1[2], kl1[3]), pk2(kl1[4], kl1[5]), pk2(kl1[6], kl1[7])};
                    *(LAS v4u*)(buf + OFF_VT + d0 * KT_STRIDE + 16 * tg) = (v4u){(vp[0] & 0xffffu) | (vp[1] << 16), (vp[2] & 0xffffu) | (vp[3] << 16), (vp[4] & 0xffffu) | (vp[5] << 16), (vp[6] & 0xffffu) | (vp[7] << 16)};
                    *(LAS v4u*)(buf + OFF_VT + (d0 + 1) * KT_STRIDE + 16 * tg) = (v4u){(vp[0] >> 16) | (vp[1] & 0xffff0000u), (vp[2] >> 16) | (vp[3] & 0xffff0000u), (vp[4] >> 16) | (vp[5] & 0xffff0000u), (vp[6] >> 16) | (vp[7] & 0xffff0000u)};
                    if (tg == 0) *(LAS v2u*)(buf + OFF_D + 4 * d0) = (v2u){__float_as_uint(plast0), __float_as_uint(plast1)};
                }
            } else if (it >= 1) {
                const int c = it - 1; const LAS char* buf = (const LAS char*)F.lds + (c & 1) * BUF_BYTES;
                const bool has_q = (c >= 8) || (l == 1);
                const LAS char* qd = buf + OFF_QD; const LAS char* kdp = buf + OFF_KD; const LAS char* klt = buf + OFF_KLT;
                const LAS char* vt0 = buf + OFF_VT + (32 * mw + ln) * KT_STRIDE; const LAS char* vt1 = vt0 + 16 * KT_STRIDE;
                if (has_q) {
                    f4 at00 = {0.f, 0.f, 0.f, 0.f}, at01 = at00, at11 = at00;
#pragma unroll
                    for (int ks = 0; ks < 4; ++ks) {
                        const bf16x8 kd0 = *(const LAS bf16x8*)(kdp + ln * QD_STRIDE + (32 * ks + 8 * g) * 2), kd1 = *(const LAS bf16x8*)(kdp + (16 + ln) * QD_STRIDE + (32 * ks + 8 * g) * 2);
                        const bf16x8 q0 = *(const LAS bf16x8*)(qd + ln * QD_STRIDE + (32 * ks + 8 * g) * 2), q1 = *(const LAS bf16x8*)(qd + (16 + ln) * QD_STRIDE + (32 * ks + 8 * g) * 2);
                        at00 = __builtin_amdgcn_mfma_f32_16x16x32_bf16(kd0, q0, at00, 0, 0, 0);
                        at01 = __builtin_amdgcn_mfma_f32_16x16x32_bf16(kd0, q1, at01, 0, 0, 0);
                        at11 = __builtin_amdgcn_mfma_f32_16x16x32_bf16(kd1, q1, at11, 0, 0, 0); }
#pragma unroll
                    for (int j = 0; j < 4; ++j) { const bool keep = (4 * g + j) <= ln; at00[j] = keep ? at00[j] : 0.f; at11[j] = keep ? at11[j] : 0.f; }
                    const bf16x8 a0p = pack8(at00, (f4){0.f, 0.f, 0.f, 0.f}), a1p = pack8(at01, at11);
                    const bf16x8 vp0 = ld2x8(vt0 + 8 * g, vt0 + 32 + 8 * g), vp1 = ld2x8(vt1 + 8 * g, vt1 + 32 + 8 * g);
                    f4 o00 = {0.f, 0.f, 0.f, 0.f}, o01 = o00, o10 = o00, o11 = o00;
                    o00 = __builtin_amdgcn_mfma_f32_16x16x32_bf16(a0p, vp0, o00, 0, 0, 0); o01 = __builtin_amdgcn_mfma_f32_16x16x32_bf16(a1p, vp0, o01, 0, 0, 0);
                    o10 = __builtin_amdgcn_mfma_f32_16x16x32_bf16(a0p, vp1, o10, 0, 0, 0); o11 = __builtin_amdgcn_mfma_f32_16x16x32_bf16(a1p, vp1, o11, 0, 0, 0);
#pragma unroll
                    for (int ks = 0; ks < 4; ++ks) {
                        const bf16x8 qa0 = ld2x8(qd + ln * QD_STRIDE + (32 * ks + 4 * g) * 2, qd + ln * QD_STRIDE + (32 * ks + 16 + 4 * g) * 2);
                        const bf16x8 qa1 = ld2x8(qd + (16 + ln) * QD_STRIDE + (32 * ks + 4 * g) * 2, qd + (16 + ln) * QD_STRIDE + (32 * ks + 16 + 4 * g) * 2);
                        const bf16x8 sb0 = pack8(st[0][2 * ks], st[0][2 * ks + 1]), sb1 = pack8(st[1][2 * ks], st[1][2 * ks + 1]);
                        o00 = __builtin_amdgcn_mfma_f32_16x16x32_bf16(qa0, sb0, o00, 0, 0, 0); o01 = __builtin_amdgcn_mfma_f32_16x16x32_bf16(qa1, sb0, o01, 0, 0, 0);
                        o10 = __builtin_amdgcn_mfma_f32_16x16x32_bf16(qa0, sb1, o10, 0, 0, 0); o11 = __builtin_amdgcn_mfma_f32_16x16x32_bf16(qa1, sb1, o11, 0, 0, 0); }
                    const int oc = h * 128 + 32 * mw + ln;
                    char* ob0 = (char*)Od + ((unsigned)(SROW0(c) + sgn * 4 * g) * 2048u + 2u * (unsigned)oc); const int ost = sgn * 2048;
#pragma unroll
                    for (int j = 0; j < 4; ++j) { bf16* r0 = (bf16*)(ob0 + j * ost); bf16* r1 = (bf16*)(ob0 + (16 + j) * ost);
                        r0[0] = (bf16)f2bf(o00[j]); r0[16] = (bf16)f2bf(o10[j]); r1[0] = (bf16)f2bf(o01[j]); r1[16] = (bf16)f2bf(o11[j]); }
                }
                { const bf16x8 vn0 = *(const LAS bf16x8*)(vt0 + 16 * g), vn1 = *(const LAS bf16x8*)(vt1 + 16 * g);
#pragma unroll
                  for (int kt = 0; kt < 8; ++kt) { const f4 dd = *(const LAS f4*)(buf + OFF_D + (16 * kt + 4 * g) * 4);
                      const bf16x8 ka = *(const LAS bf16x8*)(klt + (16 * kt + ln) * KT_STRIDE + 16 * g);
                      st[0][kt] = __builtin_amdgcn_mfma_f32_16x16x32_bf16(ka, vn0, st[0][kt] * dd, 0, 0, 0);
                      st[1][kt] = __builtin_amdgcn_mfma_f32_16x16x32_bf16(ka, vn1, st[1][kt] * dd, 0, 0, 0); } }
            }
            asm volatile("s_waitcnt lgkmcnt(0)" ::: "memory"); __builtin_amdgcn_s_barrier(); asm volatile("" ::: "memory");
        }
        __syncthreads();
#undef SROW0
#undef SLOADC
    }
}

__device__ __forceinline__ void scan_combine_phase(Frame& F, int l) {
    const int nrows = (l == 3) ? RL : RT, per = nrows / (F.G * NWAVES), gw = F.vcu * NWAVES + F.wave, lane = F.lane;
    const bf16* OFp = (const bf16*)(F.ws + WS_OF); const bf16* OBp = (const bf16*)(F.ws + WS_OB); const bf16* P = (const bf16*)(F.ws + WS_P); bf16* O = (bf16*)(F.ws + WS_O);
    const float* gn = F.rec_gnorm_g + (size_t)(l >> 1) * 128;
    f32x4 gv[4];
#pragma unroll
    for (int j = 0; j < 4; ++j) gv[j] = *(const f32x4*)(gn + ((256 * j + 4 * lane) & 127));
    v2u na[4], nb[4], ng[4];
#define CLOAD(r) do { _Pragma("unroll") for (int j = 0; j < 4; ++j) { const int col = 256 * j + 4 * lane; na[j] = *(const v2u*)(OFp + (size_t)(r) * 1024 + col); nb[j] = *(const v2u*)(OBp + (size_t)(r) * 1024 + col); ng[j] = *(const v2u*)(P + (size_t)(r) * LD_ODD + 4096 + col); } } while (0)
    CLOAD(gw * per);
    for (int rr = 0; rr < per; ++rr) {
        const int row = gw * per + rr;
        v2u ca[4], cb[4], cg[4];
#pragma unroll
        for (int j = 0; j < 4; ++j) { ca[j] = na[j]; cb[j] = nb[j]; cg[j] = ng[j]; }
        if (rr + 1 < per) CLOAD(row + 1);
        f32x4 v[4]; float ss[4];
#pragma unroll
        for (int j = 0; j < 4; ++j) { const v2u a = ca[j], b2 = cb[j];
            v[j] = (f32x4){bflo(a.x) + bflo(b2.x), bfhi(a.x) + bfhi(b2.x), bflo(a.y) + bflo(b2.y), bfhi(a.y) + bfhi(b2.y)};
            ss[j] = (v[j].x * v[j].x + v[j].y * v[j].y) + (v[j].z * v[j].z + v[j].w * v[j].w); }
#pragma unroll
        for (int o = 1; o < 32; o <<= 1) {
#pragma unroll
            for (int j = 0; j < 4; ++j) ss[j] += __shfl_xor(ss[j], o); }
#pragma unroll
        for (int j = 0; j < 4; ++j) { const int col = 256 * j + 4 * lane; const v2u gg = cg[j];
            const float rstd = 1.0f / sqrtf(ss[j] * (1.0f / 128.0f) + NORM_EPS);
            const f32x4 sg = (f32x4){bflo(gg.x), bfhi(gg.x), bflo(gg.y), bfhi(gg.y)};
            const f32x4 r = v[j] * rstd * gv[j] * sg; v2u w; w.x = pk2(r.x, r.y); w.y = pk2(r.z, r.w);
            *(v2u*)(O + (size_t)row * 1024 + col) = w; }
    }
#undef CLOAD
}
}


constexpr int NPH = 38;
#ifndef DBG_STOP
#define DBG_STOP 37
#endif
#ifndef DBG_FINAL_LP
#define DBG_FINAL_LP 3
#endif
#ifndef DBG_FINAL_XIN
#define DBG_FINAL_XIN 0
#endif
#ifndef REP_P0
#define REP_P0 1
#define REP_INP 1
#define REP_ATT 1
#define REP_SCAN 1
#define REP_N1 1
#define REP_SEL 1
#define XTRA_BAR 0
#define SEL_EXTRA 1
#define REP_G1 1
#define REP_G2 1
#define REP_FIN 1
#endif
#ifndef MK_ONE_LAUNCH
#define MK_ONE_LAUNCH 1
#endif
struct Args { const float* in[21]; float* out; unsigned char* ws; int ph_lo, ph_hi; };
__global__ void __launch_bounds__(NTHR, 2) fwd_kernel(Args args) {
    extern __shared__ __attribute__((aligned(16))) unsigned char lds_raw[];
    Frame F;
    F.lds = (LAS unsigned char*)lds_raw;
    const int wave0 = __builtin_amdgcn_readfirstlane((int)threadIdx.x >> 6);
    F.tid = threadIdx.x; F.lane = F.tid & 63; F.wave = wave0;
    const int G0 = gridDim.x; F.G = G0; const int bx0 = blockIdx.x; const int vcu0 = (F.G % 8 == 0) ? (bx0 % 8) * (F.G / 8) + bx0 / 8 : bx0; F.vcu = vcu0; int bx = bx0, wv = 0;
    F.x_in = (const float*)(GAS const float*)args.in[0]; F.c_in = (const float*)(GAS const float*)args.in[1]; F.ctx_in = (const float*)(GAS const float*)args.in[2]; F.cctx_in = (const float*)(GAS const float*)args.in[3]; F.w_mod = (const float*)(GAS const float*)args.in[4]; F.b_mod = (const float*)(GAS const float*)args.in[5]; F.norm_g = (const float*)(GAS const float*)args.in[6]; F.att_w_in = (const float*)(GAS const float*)args.in[7]; F.att_w_out = (const float*)(GAS const float*)args.in[8];
    F.na_rpb = (const float*)(GAS const float*)args.in[9]; F.diff_lambda = (const float*)(GAS const float*)args.in[10]; F.diff_subln_g = (const float*)(GAS const float*)args.in[11]; F.rec_w_in = (const float*)(GAS const float*)args.in[12]; F.rec_w_out = (const float*)(GAS const float*)args.in[13]; F.rec_lb_logits = (const float*)(GAS const float*)args.in[14]; F.rec_gnorm_g = (const float*)(GAS const float*)args.in[15];
    F.moe_router = (const float*)(GAS const float*)args.in[16]; F.moe_w_gate = (const float*)(GAS const float*)args.in[17]; F.moe_w_up = (const float*)(GAS const float*)args.in[18]; F.moe_w_down = (const float*)(GAS const float*)args.in[19]; F.final_g = (const float*)(GAS const float*)args.in[20];
    F.out = (float*)(GAS float*)args.out; F.ws = (unsigned char*)(GAS unsigned char*)args.ws;
    volatile LAS unsigned* MISC = (volatile LAS unsigned*)(F.lds + MISC_OFF);
    if (F.tid < 32) MISC[F.tid] = 0u;
    __syncthreads();
    const int lo = args.ph_lo, hi = args.ph_hi;
    XcdBarrier bar; bar.bar = (unsigned*)(F.ws + WS_CTL) + CW_BAR; bar.x = 0; bar.st = nullptr;
    if (MK_ONE_LAUNCH || hi - lo > 1) bar = xcd_barrier_post((unsigned*)(F.ws + WS_CTL) + CW_BAR, MISC + 8);
#if MK_ONE_LAUNCH
#define IN(p) true
#else
#define IN(p) (lo <= (p) && (p) < hi)
#endif
#define REFRESH() do { int l_; asm volatile("v_mbcnt_lo_u32_b32 %0, -1, 0\n\tv_mbcnt_hi_u32_b32 %0, -1, %0" : "=v"(l_)); int w_ = wave0, v_ = vcu0, b_ = bx0, g_ = G0; GAS unsigned char* ws_ = (GAS unsigned char*)args.ws; asm volatile("" : "+s"(w_), "+s"(v_), "+s"(b_), "+s"(g_), "+s"(ws_)); \
        F.lane = l_; F.wave = w_; F.tid = w_ * 64 + l_; F.vcu = v_; F.G = g_; F.ws = (unsigned char*)ws_; bx = b_; wv = w_; } while (0)
#define BARRIER() do { unsigned x_ = bar.x; unsigned* b_ = bar.bar; asm volatile("" : "+s"(x_), "+s"(b_)); XcdBarrier bb_; bb_.bar = b_; bb_.x = x_; bb_.st = bar.st; xcd_barrier(bb_); } while (0)
#define SEAM(p) do { if (IN(p) && IN((p) + 1)) { BARRIER(); for (int xb_ = 0; xb_ < XTRA_BAR; ++xb_) BARRIER(); } } while (0)
#define REPEAT(n, ...) do { for (int rep_ = 0; rep_ < (n); ++rep_) { __VA_ARGS__; if (rep_ + 1 < (n)) BARRIER(); } } while (0)
#define H ((bf16*)(F.ws + WS_H))
#define P ((bf16*)(F.ws + WS_P))
#define O ((bf16*)(F.ws + WS_O))
#define X ((bf16*)(F.ws + WS_X))
#define mod ((const float*)(F.ws + WS_MOD))

    if (IN(0)) REPEAT(REP_P0, { REFRESH(); p0_prologue(F); VM_WAIT(); __syncthreads(); });
    SEAM(0);
#pragma unroll 1
    for (int l = 0; l < DEPTH; ++l) {
        const int pb = 1 + 9 * l; const bool odd = (l & 1) != 0; const int ev = l >> 1;
        if (IN(pb + 0)) { REFRESH(); if (l == 0) norm_phase<0>(F, l); else combine_norm_phase<false>(F, l, l - 1); }
        SEAM(pb + 0);
        if (IN(pb + 1)) REPEAT(REP_INP, { REFRESH();
            if (!odd) { pg8::Gemm g{H, (const bf16*)(F.ws + WS_WATT_IN + (size_t)ev * 3072 * 1024 * (IN8E ? 1 : 2)), RT, 3072, IN8E ? 512 : 1024}; pg8::RectOrder S; S.init(144, 12, 0, 0, 0, 0, 0, 0, F.G, bx);
                pg8::EpiEvenIn<IN8E> E{P}; pg8::gemm_phase<pg8::EpiEvenIn<IN8E>, pg8::RectOrder, true, true, IN8E>(F.lds, g, S, E, wv); }
            else {
                { pg8::Gemm g{H, (const bf16*)(F.ws + WS_WREC_IN) + (size_t)ev * 5120 * 1024, RT, 5120, 1024}; pg8::Rect3Order S;
                  if (l == 1) S.init(144, 4, 0, 0, 144, 8, 0, 12, 0, 0, 0, 0, F.G, bx); else S.init(128, 4, 0, 0, 144, 4, 0, 12, 128, 4, 0, 16, F.G, bx);
                  pg8::EpiOddIn<false> E{P, 0}; pg8::gemm_phase<pg8::EpiOddIn<false>, pg8::Rect3Order, true, true>(F.lds, g, S, E, wv); }
                VM_WAIT(); __syncthreads(); REFRESH();
                { pg8::Gemm g{(const bf16*)(F.ws + WS_H8O), (const bf16*)(F.ws + WS_WREC_F8 + (size_t)ev * 2048 * 1024), RT, 2048, 512}; pg8::RectOrder S; S.init(144, 8, 0, 0, 0, 0, 0, 0, F.G, (bx + 128) & 255);
                  pg8::EpiOddIn<true> E{P, 4}; pg8::gemm_phase<pg8::EpiOddIn<true>, pg8::RectOrder, true, true, true>(F.lds, g, S, E, wv); } }
            tail_convert(F, l, 0, bx);
        });
        SEAM(pb + 1);
        if (IN(pb + 2)) REPEAT(odd ? REP_SCAN : REP_ATT, { REFRESH(); if (!odd) { att::attn_phase(F, l); REFRESH(); tail_convert(F, l, 4, F.vcu); } else scan::scan_phase(F, l); });
        SEAM(pb + 2);
        if (IN(pb + 3) && odd) { REFRESH(); scan::scan_combine_phase(F, l); }
        if (odd) SEAM(pb + 3);
        if (IN(pb + 4)) { REFRESH();
            pg8::Gemm g{O, (const bf16*)(F.ws + (odd ? WS_WREC_OUT : WS_WATT_OUT)) + (size_t)ev * 1024 * 1024, RT, 1024, 1024}; pg8::RectOrder S; S.init(l < 3 ? 144 : 128, 4, 0, 0, 0, 0, 0, 0, F.G, bx);
            pg8::EpiOutRes E{F.x_in, F.ctx_in, X, mod + (size_t)l * 17 * 6144 + 2 * 1024, l == 0};
            pg8::gemm_phase<pg8::EpiOutRes, pg8::RectOrder, true, true>(F.lds, g, S, E, wv);
            tail_convert(F, l, 1, bx);
        }
        SEAM(pb + 4);
        if (IN(pb + 5)) REPEAT(REP_N1, { REFRESH(); router_norm_phase(F, l); });
        SEAM(pb + 5);
        if (IN(pb + 6)) REPEAT(REP_SEL, { REFRESH(); tail_convert(F, l, 3, F.vcu); REFRESH(); select_phase(F, l, 1); });
        SEAM(pb + 6);
        if (IN(pb + 7)) REPEAT(REP_G1, { REFRESH();
            pg8::Gemm g{H, (const bf16*)(F.ws + WS_WMOE1 + (size_t)l * 16 * 4096 * 1024), XR, 4096, 512}; pg8::MoeOrder S; S.init(l < 3 ? 18 : 16, 16, F.G, bx);
            pg8::EpiSwiGLU E{(unsigned char*)P}; pg8::gemm_phase<pg8::EpiSwiGLU, pg8::MoeOrder, true, true, true, true>(F.lds, g, S, E, wv, (const unsigned short*)(F.ws + WS_IDX), (LAS unsigned short*)(F.lds + 131072));
        });
        SEAM(pb + 7);
        if (IN(pb + 8)) REPEAT(REP_G2, { REFRESH();
            pg8::Gemm g{P, (const bf16*)(F.ws + WS_WMOE2 + (size_t)l * 16 * 1024 * 2048), XR, 1024, 1024}; pg8::MoeOrder S; S.init(l < 3 ? 18 : 16, 4, F.G, bx);
            pg8::EpiDown E{F.ws + WS_O, (const float*)(F.ws + WS_GATE)}; pg8::gemm_phase<pg8::EpiDown, pg8::MoeOrder, true, true, true>(F.lds, g, S, E, wv);
            tail_convert(F, l, 2, bx);
        });
        SEAM(pb + 8);
    }
    if (IN(37)) REPEAT(REP_FIN, { REFRESH(); combine_norm_phase<true>(F, 0, 3); });
#undef IN
#undef H
#undef P
#undef O
#undef X
#undef mod
#undef REFRESH
#undef SEAM
#undef BARRIER
#undef REPEAT
}

extern "C" void kernel_launch(void* const* d_in, const int* in_sizes, int n_in, void* d_out, int out_size, void* d_ws, size_t ws_size, hipStream_t stream) {
    static int grid = 0;
    if (grid == 0) {
        if (n_in != 21 || in_sizes[0] != RL * 1024 || out_size != RL * 1024 || ws_size < WS_END) { fprintf(stderr, "kernel_launch: unexpected shapes (n_in %d, in0 %d, out %d, ws %zu; need ws >= %zu); nothing launched\n", n_in, n_in > 0 ? in_sizes[0] : -1, out_size, ws_size, (size_t)WS_END); grid = -1; return; }
        int dev = 0, cus = 0, per_cu = 0;
        if (hipGetDevice(&dev) != hipSuccess || hipDeviceGetAttribute(&cus, hipDeviceAttributeMultiprocessorCount, dev) != hipSuccess) { fprintf(stderr, "kernel_launch: device query failed\n"); grid = -1; return; }
        if (hipFuncSetAttribute((const void*)fwd_kernel, hipFuncAttributeMaxDynamicSharedMemorySize, LDS_BYTES) != hipSuccess) { fprintf(stderr, "kernel_launch: hipFuncSetAttribute failed\n"); grid = -1; return; }
        if (hipOccupancyMaxActiveBlocksPerMultiprocessor(&per_cu, (const void*)fwd_kernel, NTHR, LDS_BYTES) != hipSuccess || per_cu < 1) fprintf(stderr, "kernel_launch: note: occupancy query reports %d workgroups per CU\n", per_cu);
        (void)hipGetLastError();
        if (cus != 256) { fprintf(stderr, "kernel_launch: built for a 256-CU device, found %d CUs; nothing launched\n", cus); grid = -1; return; }
        grid = 256;
    }
    if (grid < 0) return;
    if (hipMemsetAsync((char*)d_ws + WS_CTL, 0, CTL_ZERO_BYTES, stream) != hipSuccess) { fprintf(stderr, "kernel_launch: memset failed\n"); return; }
    Args a{};
    for (int i = 0; i < 21; ++i) a.in[i] = (const float*)d_in[i];
    a.out = (float*)d_out; a.ws = (unsigned char*)d_ws;
#if MK_ONE_LAUNCH
    a.ph_lo = 0; a.ph_hi = NPH;
    hipLaunchKernelGGL(fwd_kernel, dim3(grid), dim3(NTHR), LDS_BYTES, stream, a);
#else
    for (int p = 0; p < NPH; ++p) {
        if (p >= DBG_STOP && p != 37) continue;
        if (p >= 1 && p < 37 && ((p - 1) % 9) == 3 && ((((p - 1) / 9) & 1) == 0)) continue;
        a.ph_lo = p; a.ph_hi = p + 1;
        hipLaunchKernelGGL(fwd_kernel, dim3(grid), dim3(NTHR), LDS_BYTES, stream, a);
    }
#endif
    const hipError_t le = hipPeekAtLastError();
    if (le != hipSuccess) fprintf(stderr, "kernel_launch: launch failed: %s\n", hipGetErrorName(le));
}
```

```cpp
#include <hip/hip_runtime.h>
#include <cstdio>
#include <cstdint>

constexpr int DM = 1024, NB = 16, SEQ = 2048, CTXL = 256, DEPTH = 4;
constexpr int RL = NB * SEQ;
constexpr int RC = NB * CTXL;
constexpr int RT = RL + RC;
constexpr int NEXP = 16, FFD = 2048, CAPL = 256, CAPC = 32;
constexpr int XT_E = 18;
constexpr int XR_E = XT_E * 256;
constexpr int XR = NEXP * XR_E;
constexpr int LD_EVEN = 3072, LD_ODD = 5120;
constexpr float NORM_EPS = 1e-6f;
constexpr int NWAVES = 8, NTHR = 512;
#ifndef IN8_EVEN
#define IN8_EVEN 1
#endif
#ifndef IN8_ODD
#define IN8_ODD 0
#endif
constexpr bool IN8E = IN8_EVEN != 0, IN8O = IN8_ODD != 0;

namespace pg8 {
#define PG8_LAS __attribute__((address_space(3)))
typedef unsigned short bf16_t;
typedef short bf16x8 __attribute__((ext_vector_type(8)));
typedef float f32x4 __attribute__((ext_vector_type(4)));
typedef unsigned u32x4 __attribute__((ext_vector_type(4)));
typedef int v4i_t __attribute__((ext_vector_type(4)));
typedef int v8i_t __attribute__((ext_vector_type(8)));
constexpr int BM = 256, BK = 64, HALF = 128, HTB = HALF * BK * 2  , STAGE_BYTES = 8 * HTB, NXCD = 8, WGM = 8;

__host__ __device__ __forceinline__ int lds_byte(int r, int c) { const int st = (r >> 4) * 2 + (c >> 5), rr = r & 15, cc = c & 31, ob = rr * 64 + cc * 2; return st * 1024 + (ob ^ (((ob >> 9) & 1) << 5)); }
__host__ __device__ __forceinline__ void stage_rc(int b, int& R, int& C) { const int st = b / 1024, sb = b % 1024, swz = sb ^ (((sb >> 9) & 1) << 5); R = (st >> 1) * 16 + swz / 64; C = (st & 1) * 32 + (swz % 64) / 2; }
__host__ __device__ __forceinline__ int perm32(int rho) { const int n = rho >> 4, i = rho & 15; return 8 * (i >> 2) + 4 * n + (i & 3); }

struct Unit { int pm, pn; };
struct Gemm { const bf16_t* A; const bf16_t* Bt; int M, N, K; };
typedef __bf16 bf16x2_t __attribute__((ext_vector_type(2)));
typedef float f32x2_t __attribute__((ext_vector_type(2)));
__device__ __forceinline__ unsigned cvt_pk_bf16(float lo, float hi) { const f32x2_t v = {lo, hi}; const bf16x2_t b = __builtin_convertvector(v, bf16x2_t); return __builtin_bit_cast(unsigned, b); }
typedef unsigned u32x2 __attribute__((ext_vector_type(2)));
typedef float f32x2 __attribute__((ext_vector_type(2)));
__device__ __forceinline__ u32x2 pk4(f32x4 v) { u32x2 w; w.x = cvt_pk_bf16(v[0], v[1]); w.y = cvt_pk_bf16(v[2], v[3]); return w; }
__device__ __forceinline__ float silu_f(float x) { return x * __builtin_amdgcn_rcpf(1.0f + __builtin_amdgcn_exp2f(-1.4426950408889634f * x)); }

constexpr float FP8_ACT = 8.0f, FP8_WGT = 64.0f, FP8_UNSCALE = 1.0f / (FP8_ACT * FP8_WGT);
__device__ __forceinline__ float clamp448(float v) { return __builtin_amdgcn_fmed3f(v, -448.0f, 448.0f); }
__device__ __forceinline__ unsigned pack4_fp8(float a, float b, float c, float d) { unsigned v = 0u; v = __builtin_amdgcn_cvt_pk_fp8_f32(clamp448(a), clamp448(b), v, false); v = __builtin_amdgcn_cvt_pk_fp8_f32(clamp448(c), clamp448(d), v, true); return v; }
__device__ __forceinline__ int xcd_remap(int L, int nwg) { const int q = nwg / NXCD, r = nwg % NXCD, xcd = L % NXCD, off = L / NXCD; return (xcd < r ? xcd * (q + 1) : r * (q + 1) + (xcd - r) * q) + off; }
__device__ __forceinline__ void grp8(int wgid, int nM, int nN, int& pm, int& pn) { const int nig = WGM * nN, gid = wgid / nig, fm = gid * WGM, gsz = (nM - fm) < WGM ? (nM - fm) : WGM; pm = fm + ((wgid % nig) % gsz); pn = (wgid % nig) / gsz; }
struct RectOrder {
    int nMA, nNA, pmA, pnA, nA, nMB, nNB, pmB, pnB, nB, G, c;
    __device__ __forceinline__ void init(int nMA_, int nNA_, int pmA_, int pnA_, int nMB_, int nNB_, int pmB_, int pnB_, int G_, int c_) {
        nMA = nMA_; nNA = nNA_; pmA = pmA_; pnA = pnA_; nA = nMA_ * nNA_; nMB = nMB_; nNB = nNB_; pmB = pmB_; pnB = pnB_; nB = nMB_ * nNB_; G = G_; c = c_; }
    __device__ __forceinline__ bool next(int i, Unit& u) const {
        long L = (long)i * G + c; int pm, pn;
        if (L < nA) { grp8(xcd_remap((int)L, nA), nMA, nNA, pm, pn); u.pm = pmA + pm; u.pn = pnA + pn; return true; }
        L -= nA; if (L < nB) { grp8(xcd_remap((int)L, nB), nMB, nNB, pm, pn); u.pm = pmB + pm; u.pn = pnB + pn; return true; }
        return false;
    }
    __device__ __forceinline__ void a_ready(const Unit&) const {}
    __device__ __forceinline__ void done(const Unit&) const {}
};
struct Rect3Order {
    int nM[3], nN[3], pm0[3], pn0[3], n[3], G, c;
    __device__ __forceinline__ void init(int nMA, int nNA, int pmA, int pnA, int nMB, int nNB, int pmB, int pnB, int nMC, int nNC, int pmC, int pnC, int G_, int c_) {
        nM[0] = nMA; nN[0] = nNA; pm0[0] = pmA; pn0[0] = pnA; nM[1] = nMB; nN[1] = nNB; pm0[1] = pmB; pn0[1] = pnB; nM[2] = nMC; nN[2] = nNC; pm0[2] = pmC; pn0[2] = pnC;
        n[0] = nMA * nNA; n[1] = nMB * nNB; n[2] = nMC * nNC; G = G_; c = c_; }
    __device__ __forceinline__ bool next(int i, Unit& u) const {
        long L = (long)i * G + c; int pm, pn;
        if (L < n[0]) { grp8(xcd_remap((int)L, n[0]), nM[0], nN[0], pm, pn); u.pm = pm0[0] + pm; u.pn = pn0[0] + pn; return true; }
        L -= n[0]; if (L < n[1]) { grp8(xcd_remap((int)L, n[1]), nM[1], nN[1], pm, pn); u.pm = pm0[1] + pm; u.pn = pn0[1] + pn; return true; }
        L -= n[1]; if (L < n[2]) { grp8(xcd_remap((int)L, n[2]), nM[2], nN[2], pm, pn); u.pm = pm0[2] + pm; u.pn = pn0[2] + pn; return true; }
        return false;
    }
    __device__ __forceinline__ void a_ready(const Unit&) const {}
    __device__ __forceinline__ void done(const Unit&) const {}
};
struct MoeOrder {
    int nj, npn, per_e, total, G, c;
    __device__ __forceinline__ void init(int nj_, int npn_, int G_, int c_) { nj = nj_; npn = npn_; per_e = nj_ * npn_; total = 16 * per_e; G = G_; c = c_; }
    __device__ __forceinline__ bool next(int i, Unit& u) const {
        const long L = (long)i * G + c; if (L >= total) return false;
        const int wgid = xcd_remap((int)L, total), e = wgid / per_e, r = wgid % per_e; int j, pn; grp8(r, nj, npn, j, pn);
        u.pm = e * 18 + j; u.pn = e * npn + pn; return true;
    }
    __device__ __forceinline__ void a_ready(const Unit&) const {}
    __device__ __forceinline__ void done(const Unit&) const {}
};


template <bool F8> struct EpiEvenIn {
    static constexpr bool PERM = false, AFTER_DRAIN = false; static constexpr float US = F8 ? FP8_UNSCALE : 1.0f;
    bf16_t* P;
    __device__ __forceinline__ void operator()(const f32x4 (&acc)[2][2][4][2], const Unit& u, int wr, int wc, int fr, int fq) const {
        const int pn = u.pn; const bool ropet = (pn == 2) | (pn == 3) | (pn == 8) | (pn == 9); const bool latent = u.pm < 128;
        const int row0 = u.pm * BM + wr * 64 + fr;
        if (!ropet) {
            const int col0 = pn * BM + wc * 32 + 8 * fq;
#pragma unroll
            for (int ai = 0; ai < 2; ++ai)
#pragma unroll
                for (int m = 0; m < 4; ++m) { bf16_t* rowp = P + (size_t)(row0 + ai * HALF + m * 16) * 3072 + col0;
#pragma unroll
                    for (int bj = 0; bj < 2; ++bj) { const u32x2 a = pk4(F8 ? acc[ai][bj][m][0] * US : acc[ai][bj][m][0]), b = pk4(F8 ? acc[ai][bj][m][1] * US : acc[ai][bj][m][1]); *(u32x4*)(rowp + bj * HALF) = (u32x4){a.x, a.y, b.x, b.y}; } }
        } else {
            const int col0 = pn * BM + (wc >> 1) * 64 + (wc & 1) * 16 + 4 * fq;
            float ir[4];
#pragma unroll
            for (int i = 0; i < 4; ++i) ir[i] = __builtin_amdgcn_exp2f(-(float)(4 * fq + i) * 0.8304820237218406f) * 0.15915494309189535f;
#pragma unroll
            for (int ai = 0; ai < 2; ++ai)
#pragma unroll
                for (int m = 0; m < 4; ++m) { const int row = row0 + ai * HALF + m * 16; const int t = row & 2047; const float pos = (float)((wc & 1) ? (t & 63) : (t >> 6));
                    f32x4 cs, sn;
#pragma unroll
                    for (int i = 0; i < 4; ++i) { float rev = pos * ir[i]; rev -= __builtin_rintf(rev); sn[i] = latent ? (F8 ? __builtin_amdgcn_sinf(rev) * US : __builtin_amdgcn_sinf(rev)) : 0.f; cs[i] = latent ? (F8 ? __builtin_amdgcn_cosf(rev) * US : __builtin_amdgcn_cosf(rev)) : US; }
                    bf16_t* rowp = P + (size_t)row * 3072 + col0;
#pragma unroll
                    for (int bj = 0; bj < 2; ++bj) { const f32x4 a1 = acc[ai][bj][m][0], a2 = acc[ai][bj][m][1];
                        *(u32x2*)(rowp + bj * HALF) = pk4(a1 * cs - a2 * sn); *(u32x2*)(rowp + bj * HALF + 32) = pk4(a2 * cs + a1 * sn); } }
        }
    }
};
template <bool F8> struct EpiOddIn {
    static constexpr bool PERM = false, AFTER_DRAIN = false; static constexpr float US = F8 ? FP8_UNSCALE : 1.0f;
    bf16_t* P; int pn_off;
    __device__ __forceinline__ void operator()(const f32x4 (&acc)[2][2][4][2], const Unit& u, int wr, int wc, int fr, int fq) const {
        const int pn = u.pn + pn_off; const int act = ((pn < 4) | (pn >= 16)) ? 1 : (pn < 12 ? 2 : 0);
        const int row0 = u.pm * BM + wr * 64 + fr, col0 = pn * BM + wc * 32 + 8 * fq;
#pragma unroll
        for (int ai = 0; ai < 2; ++ai)
#pragma unroll
            for (int m = 0; m < 4; ++m) { bf16_t* rowp = P + (size_t)(row0 + ai * HALF + m * 16) * 5120 + col0;
#pragma unroll
                for (int bj = 0; bj < 2; ++bj) { f32x4 v0 = acc[ai][bj][m][0], v1 = acc[ai][bj][m][1]; if (F8) { v0 *= US; v1 *= US; }
                    if (act) {
#pragma unroll
                        for (int i = 0; i < 4; ++i) { const float s0 = __builtin_amdgcn_rcpf(1.0f + __builtin_amdgcn_exp2f(-1.4426950408889634f * v0[i])), s1 = __builtin_amdgcn_rcpf(1.0f + __builtin_amdgcn_exp2f(-1.4426950408889634f * v1[i]));
                            v0[i] = (act == 1) ? v0[i] * s0 : s0; v1[i] = (act == 1) ? v1[i] * s1 : s1; } }
                    const u32x2 a = pk4(v0), b = pk4(v1); *(u32x4*)(rowp + bj * HALF) = (u32x4){a.x, a.y, b.x, b.y}; } }
    }
};
struct EpiOutRes {
    static constexpr bool PERM = false, AFTER_DRAIN = false;
    const float* srcL; const float* srcC; bf16_t* X; const float* gmod; bool src32;
    __device__ __forceinline__ void operator()(const f32x4 (&acc)[2][2][4][2], const Unit& u, int wr, int wc, int fr, int fq) const {
        const bool latent = u.pm < 128; const int bidx = latent ? (u.pm >> 3) : 16;
        const int row0 = u.pm * BM + wr * 64 + fr, col0 = u.pn * BM + wc * 32 + 8 * fq;
        const float* src = latent ? srcL : srcC - (size_t)32768 * 1024;
        f32x4 gv[2][2];
#pragma unroll
        for (int bj = 0; bj < 2; ++bj)
#pragma unroll
            for (int n = 0; n < 2; ++n) gv[bj][n] = *(const f32x4*)(gmod + (size_t)bidx * 6144 + col0 + bj * HALF + n * 4);
#pragma unroll
        for (int ai = 0; ai < 2; ++ai)
#pragma unroll
            for (int m = 0; m < 4; ++m) { const size_t off = (size_t)(row0 + ai * HALF + m * 16) * 1024 + col0;
#pragma unroll
                for (int bj = 0; bj < 2; ++bj) { f32x4 s0, s1;
                    if (src32) { s0 = *(const f32x4*)(src + off + bj * HALF); s1 = *(const f32x4*)(src + off + bj * HALF + 4); }
                    else { const u32x4 w = *(const u32x4*)(X + off + bj * HALF); s0 = (f32x4){__builtin_bit_cast(float, w.x << 16), __builtin_bit_cast(float, w.x & 0xffff0000u), __builtin_bit_cast(float, w.y << 16), __builtin_bit_cast(float, w.y & 0xffff0000u)};
                        s1 = (f32x4){__builtin_bit_cast(float, w.z << 16), __builtin_bit_cast(float, w.z & 0xffff0000u), __builtin_bit_cast(float, w.w << 16), __builtin_bit_cast(float, w.w & 0xffff0000u)}; }
                    const u32x2 a = pk4(s0 + gv[bj][0] * acc[ai][bj][m][0]), b = pk4(s1 + gv[bj][1] * acc[ai][bj][m][1]); *(u32x4*)(X + off + bj * HALF) = (u32x4){a.x, a.y, b.x, b.y}; }
                asm volatile("" ::: "memory"); }
    }
};
struct EpiSwiGLU {
    static constexpr bool PERM = false, AFTER_DRAIN = false;
    unsigned char* HID;
    __device__ __forceinline__ void operator()(const f32x4 (&acc)[2][2][4][2], const Unit& u, int wr, int wc, int fr, int fq) const {
        const int pnl = u.pn & 15; const int row0 = u.pm * BM + wr * 64 + fr, col0 = pnl * 128 + wc * 32 + 8 * fq;
        constexpr float KA = -1.4426950408889634f * FP8_UNSCALE, KB = FP8_UNSCALE * FP8_UNSCALE * FP8_ACT;
#pragma unroll
        for (int ai = 0; ai < 2; ++ai)
#pragma unroll
            for (int m = 0; m < 4; ++m) { unsigned w[2];
#pragma unroll
                for (int bj = 0; bj < 2; ++bj) { const f32x4 g = acc[ai][bj][m][0], up = acc[ai][bj][m][1]; float hv[4];
#pragma unroll
                    for (int q = 0; q < 2; ++q) { const f32x2 g2 = {g[2 * q], g[2 * q + 1]}, u2 = {up[2 * q], up[2 * q + 1]}; const f32x2 a2 = g2 * KA;
                        f32x2 e2; e2.x = __builtin_amdgcn_exp2f(a2.x); e2.y = __builtin_amdgcn_exp2f(a2.y); const f32x2 d2 = e2 + 1.0f;
                        f32x2 r2; r2.x = __builtin_amdgcn_rcpf(d2.x); r2.y = __builtin_amdgcn_rcpf(d2.y); const f32x2 h2 = ((g2 * u2) * KB) * r2; hv[2 * q] = h2.x; hv[2 * q + 1] = h2.y; }
                    w[bj] = pack4_fp8(hv[0], hv[1], hv[2], hv[3]); }
                *(u32x2*)(HID + (size_t)(row0 + ai * HALF + m * 16) * 2048 + col0) = (u32x2){w[0], w[1]}; }
    }
};
constexpr float FP8_Y = 64.0f;
struct EpiDown {
    static constexpr bool PERM = false, AFTER_DRAIN = false;
    unsigned char* Y; const float* gate;
    __device__ __forceinline__ void operator()(const f32x4 (&acc)[2][2][4][2], const Unit& u, int wr, int wc, int fr, int fq) const {
        const int pnl = u.pn & 3; const int row0 = u.pm * BM + wr * 64 + fr, col0 = pnl * BM + wc * 32 + 8 * fq;
#pragma unroll
        for (int ai = 0; ai < 2; ++ai)
#pragma unroll
            for (int m = 0; m < 4; ++m) { const int row = row0 + ai * HALF + m * 16; const float gt = gate[row] * (FP8_UNSCALE * FP8_Y); unsigned char* rowp = Y + (size_t)row * 1024 + col0;
#pragma unroll
                for (int bj = 0; bj < 2; ++bj) { const f32x4 a = acc[ai][bj][m][0] * gt, b = acc[ai][bj][m][1] * gt; *(u32x2*)(rowp + bj * HALF) = (u32x2){pack4_fp8(a[0], a[1], a[2], a[3]), pack4_fp8(b[0], b[1], b[2], b[3])}; } }
    }
};

template <class Epi, class Sched, bool ALIGN_EPI = false, bool SP2 = false, bool FP8 = false, bool GATHER = false>
__device__ __forceinline__ void gemm_phase(PG8_LAS unsigned char* lds, const Gemm g, const Sched& S, const Epi& E, int wid_in, const unsigned short* gidx = nullptr, PG8_LAS unsigned short* gtab = nullptr) {
    static_assert(!GATHER || SP2, "the gathered A operand is wired into the SP2 loop only");
    int lane_; asm volatile("v_mbcnt_lo_u32_b32 %0, -1, 0\n\tv_mbcnt_hi_u32_b32 %0, -1, %0" : "=v"(lane_));
    const int lane = lane_, wid = wid_in, tid = wid * 64 + lane, wr = wid >> 2, wc = wid & 3, fr = lane & 15, fq = lane >> 4;
    const int K = g.K, nt = K / BK;
    unsigned voffA[2], voffB[2];
#pragma unroll
    for (int i = 0; i < 2; ++i) { int R, C; stage_rc(tid * 16 + i * 8192, R, C); const int Rb = Epi::PERM ? ((R & ~31) + perm32(R & 31)) : R;
        voffA[i] = (unsigned)(R * K + C) * 2u; voffB[i] = (unsigned)(Rb * K + C) * 2u; }
    unsigned vc[2][2] = {{0u, 0u}, {0u, 0u}};
#define PG8_GV(dst, ui_) do { _Pragma("unroll") for (int _i = 0; _i < 2; ++_i) { int R_, C_; stage_rc(tid * 16 + _i * 8192, R_, C_); _Pragma("unroll") for (int _h = 0; _h < 2; ++_h) \
        dst[_h][_i] = (unsigned)gtab[(ui_) * 256 + _h * HALF + R_] * (unsigned)(K * 2) + (unsigned)(C_ * 2); } } while (0)
#define PG8_STAGE_A(bufoff, ptr, h, usenext) do { if constexpr (GATHER) { PG8_STAGE(bufoff, ptr, vc[h]); } else PG8_STAGE(bufoff, (ptr) + ((h) ? hstep : 0), voffA); } while (0)
    if constexpr (GATHER) { Unit u_; for (int i_ = 0; S.next(i_, u_); ++i_) if (tid < 256) gtab[i_ * 256 + tid] = gidx[(size_t)u_.pm * 256 + tid];
        asm volatile("s_waitcnt vmcnt(0) lgkmcnt(0)" ::: "memory"); __builtin_amdgcn_s_barrier(); asm volatile("" ::: "memory"); }
    const size_t kstep = (size_t)(BK * 2);
    const size_t hstep = (size_t)HALF * K * 2;
    const size_t tstep = 2 * hstep;
    const unsigned ldsw = (unsigned)wid * 1024u;
    const int aoff = lds_byte(wr * 64 + fr, fq * 8), boff = lds_byte(wc * 32 + fr, fq * 8);
#define PG8_SA(b, h) (((b) * 2 + (h)) * HTB)
#define PG8_SB(b, h) ((4 + (b) * 2 + (h)) * HTB)
#define PG8_STAGE(bufoff, gbase, voff) do { _Pragma("unroll") for (int _i = 0; _i < 2; ++_i) \
        __builtin_amdgcn_global_load_lds((const unsigned*)((const char*)(gbase) + (voff)[_i]), (PG8_LAS unsigned*)(lds + (bufoff) + ldsw + _i * 8192), 16, 0, 0); } while (0)
#define PG8_LDA(dst, b, h) do { if constexpr (FP8) { _Pragma("unroll") for (int m = 0; m < 4; ++m) dst##8[m] = __builtin_shufflevector(*(const PG8_LAS v4i_t*)(lds + PG8_SA(b, h) + aoff + m * 2048), *(const PG8_LAS v4i_t*)(lds + PG8_SA(b, h) + aoff + m * 2048 + 1024), 0, 1, 2, 3, 4, 5, 6, 7); } \
        else { _Pragma("unroll") for (int m = 0; m < 4; ++m) _Pragma("unroll") for (int k = 0; k < 2; ++k) dst[m][k] = *(const PG8_LAS bf16x8*)(lds + PG8_SA(b, h) + aoff + m * 2048 + k * 1024); } } while (0)
#define PG8_LDB(dst, b, h) do { if constexpr (FP8) { _Pragma("unroll") for (int n = 0; n < 2; ++n) dst##8[n] = __builtin_shufflevector(*(const PG8_LAS v4i_t*)(lds + PG8_SB(b, h) + boff + n * 2048), *(const PG8_LAS v4i_t*)(lds + PG8_SB(b, h) + boff + n * 2048 + 1024), 0, 1, 2, 3, 4, 5, 6, 7); } \
        else { _Pragma("unroll") for (int n = 0; n < 2; ++n) _Pragma("unroll") for (int k = 0; k < 2; ++k) dst[n][k] = *(const PG8_LAS bf16x8*)(lds + PG8_SB(b, h) + boff + n * 2048 + k * 1024); } } while (0)
#define PG8_MMA(ai, bj, At, Bt) do { __builtin_amdgcn_s_setprio(1); if constexpr (FP8) { _Pragma("unroll") for (int m = 0; m < 4; ++m) _Pragma("unroll") for (int n = 0; n < 2; ++n) \
        asm volatile("v_mfma_f32_16x16x128_f8f6f4 %0, %1, %2, %0" : "+v"(acc[ai][bj][m][n]) : "v"(Bt##8[n]), "v"(At##8[m])); } else { \
        _Pragma("unroll") for (int m = 0; m < 4; ++m) _Pragma("unroll") for (int n = 0; n < 2; ++n) _Pragma("unroll") for (int k = 0; k < 2; ++k) \
        acc[ai][bj][m][n] = __builtin_amdgcn_mfma_f32_16x16x32_bf16(Bt[n][k], At[m][k], acc[ai][bj][m][n], 0, 0, 0); } __builtin_amdgcn_s_setprio(0); } while (0)
#define PG8_WAIT_V(n) asm volatile("s_waitcnt vmcnt(" #n ")" ::: "memory")
#define PG8_WAIT_L(n) asm volatile("s_waitcnt lgkmcnt(" #n ")" ::: "memory")
#define PG8_BAR __builtin_amdgcn_s_barrier()
#define PG8_SCHED __builtin_amdgcn_sched_barrier(0)
    Unit cur, nxt; int ui = 0;
    if (!S.next(0, cur)) return;
    f32x4 acc[2][2][4][2];
#pragma unroll
    for (int a = 0; a < 2; ++a)
#pragma unroll
        for (int b = 0; b < 2; ++b)
#pragma unroll
            for (int m = 0; m < 4; ++m)
#pragma unroll
                for (int n = 0; n < 2; ++n) acc[a][b][m][n] = (f32x4){0.f, 0.f, 0.f, 0.f};
    bf16x8 At[4][2], B0[2][2], B1[2][2]; v8i_t At8[4], B08[2], B18[2];
    const char* cA = (const char*)g.A + (GATHER ? (size_t)0 : (size_t)cur.pm * tstep); const char* cB = (const char*)g.Bt + (size_t)cur.pn * tstep;
    if constexpr (GATHER) { PG8_GV(vc, 0); }
    S.a_ready(cur);
    if constexpr (SP2) {
        PG8_STAGE(PG8_SB(0, 0), cB, voffB); PG8_STAGE(PG8_SB(0, 1), cB + hstep, voffB); PG8_STAGE_A(PG8_SA(0, 0), cA, 0, false); PG8_STAGE_A(PG8_SA(0, 1), cA, 1, false);
        if (wr == 1) PG8_BAR;
        PG8_WAIT_V(2); PG8_BAR;
        PG8_STAGE(PG8_SB(1, 0), cB + kstep, voffB); PG8_STAGE_A(PG8_SA(1, 0), cA + kstep, 0, false); PG8_STAGE(PG8_SB(1, 1), cB + hstep + kstep, voffB);
        PG8_WAIT_V(6); PG8_BAR;
    } else {
        PG8_STAGE(PG8_SB(0, 0), cB, voffB); PG8_STAGE(PG8_SA(0, 0), cA, voffA); PG8_STAGE(PG8_SB(0, 1), cB + hstep, voffB); PG8_STAGE(PG8_SA(0, 1), cA + hstep, voffA);
        if (wr == 1) PG8_BAR;
        PG8_WAIT_V(4); PG8_BAR;
        PG8_STAGE(PG8_SB(1, 0), cB + kstep, voffB); PG8_STAGE(PG8_SA(1, 0), cA + kstep, voffA); PG8_STAGE(PG8_SB(1, 1), cB + hstep + kstep, voffB);
        PG8_WAIT_V(6); PG8_BAR;
    }
    for (;;) {
        const bool has_next = S.next(ui + 1, nxt);
        const char* nA = (has_next && !GATHER) ? (const char*)g.A + (size_t)nxt.pm * tstep : cA; const char* nB = has_next ? (const char*)g.Bt + (size_t)nxt.pn * tstep : cB;
        for (int t = 0; t < nt; t += 2) {
            const bool last = (t == nt - 2);
            const char* a1 = cA + (size_t)(t + 1) * kstep;
            const char* a2 = last ? nA : cA + (size_t)(t + 2) * kstep; const char* b2 = last ? nB : cB + (size_t)(t + 2) * kstep;
            const char* a3 = a2 + kstep; const char* b3 = b2 + kstep;
            if (last && has_next) S.a_ready(nxt);
            if constexpr (SP2) {
            PG8_LDB(B0, 0, 0); PG8_LDB(B1, 0, 1); PG8_SCHED; PG8_LDA(At, 0, 0); PG8_STAGE_A(PG8_SA(1, 1), a1, 1, false);
            if constexpr (GATHER) { if (last && has_next) { PG8_GV(vc, ui + 1); } }
            PG8_WAIT_V(8); PG8_WAIT_L(0); PG8_BAR; PG8_MMA(0, 0, At, B0); PG8_MMA(0, 1, At, B1); PG8_BAR; PG8_SCHED;
            PG8_LDA(At, 0, 1); PG8_STAGE(PG8_SB(0, 0), b2, voffB); PG8_STAGE(PG8_SB(0, 1), b2 + hstep, voffB); PG8_STAGE_A(PG8_SA(0, 0), a2, 0, last);
            PG8_WAIT_V(8); PG8_WAIT_L(0); PG8_BAR; PG8_MMA(1, 0, At, B0); PG8_MMA(1, 1, At, B1); PG8_BAR; PG8_SCHED;
            PG8_LDB(B0, 1, 0); PG8_LDB(B1, 1, 1); PG8_SCHED; PG8_LDA(At, 1, 0); PG8_STAGE_A(PG8_SA(0, 1), a2, 1, last);
            PG8_WAIT_V(8); PG8_WAIT_L(0); PG8_BAR; PG8_MMA(0, 0, At, B0); PG8_MMA(0, 1, At, B1); PG8_BAR; PG8_SCHED;
            PG8_LDA(At, 1, 1); PG8_STAGE(PG8_SB(1, 0), b3, voffB); PG8_STAGE(PG8_SB(1, 1), b3 + hstep, voffB); PG8_STAGE_A(PG8_SA(1, 0), a3, 0, last);
            PG8_WAIT_V(8); PG8_WAIT_L(0); PG8_BAR; PG8_MMA(1, 0, At, B0); PG8_MMA(1, 1, At, B1); PG8_BAR; PG8_SCHED;
            } else {
            PG8_LDB(B0, 0, 0); PG8_SCHED; PG8_LDA(At, 0, 0); PG8_STAGE(PG8_SA(1, 1), a1 + hstep, voffA);
            PG8_WAIT_L(8); PG8_BAR; PG8_WAIT_L(0); PG8_MMA(0, 0, At, B0); PG8_BAR; PG8_SCHED;
            PG8_LDB(B1, 0, 1); PG8_STAGE(PG8_SB(0, 0), b2, voffB);
            PG8_BAR; PG8_WAIT_L(0); PG8_MMA(0, 1, At, B1); PG8_BAR;
            PG8_LDA(At, 0, 1); PG8_STAGE(PG8_SA(0, 0), a2, voffA);
            PG8_BAR; PG8_WAIT_L(0); PG8_MMA(1, 0, At, B0); PG8_BAR; PG8_SCHED;
            PG8_STAGE(PG8_SB(0, 1), b2 + hstep, voffB);
            PG8_WAIT_V(6); PG8_BAR; PG8_MMA(1, 1, At, B1); PG8_BAR;
            PG8_LDB(B0, 1, 0); PG8_SCHED; PG8_LDA(At, 1, 0); PG8_STAGE(PG8_SA(0, 1), a2 + hstep, voffA);
            PG8_WAIT_L(8); PG8_BAR; PG8_WAIT_L(0); PG8_MMA(0, 0, At, B0); PG8_BAR; PG8_SCHED;
            PG8_LDB(B1, 1, 1); PG8_STAGE(PG8_SB(1, 0), b3, voffB);
            PG8_BAR; PG8_WAIT_L(0); PG8_MMA(0, 1, At, B1); PG8_BAR;
            PG8_LDA(At, 1, 1); PG8_STAGE(PG8_SA(1, 0), a3, voffA);
            PG8_BAR; PG8_WAIT_L(0); PG8_MMA(1, 0, At, B0); PG8_BAR; PG8_SCHED;
            PG8_STAGE(PG8_SB(1, 1), b3 + hstep, voffB);
            PG8_WAIT_V(6); PG8_BAR; PG8_MMA(1, 1, At, B1); PG8_BAR;
            }
        }
        if constexpr (FP8) { PG8_SCHED; asm volatile("s_nop 15\n\ts_nop 15\n\ts_nop 15" ::: "memory"); PG8_SCHED; }
        if constexpr (ALIGN_EPI) { if (wr == 0) PG8_BAR; }
        if constexpr (!Epi::AFTER_DRAIN) { E(acc, cur, wr, wc, fr, fq); S.done(cur); }
        if (!has_next) break;
#pragma unroll
        for (int a = 0; a < 2; ++a)
#pragma unroll
            for (int b = 0; b < 2; ++b)
#pragma unroll
                for (int m = 0; m < 4; ++m)
#pragma unroll
                    for (int n = 0; n < 2; ++n) acc[a][b][m][n] = (f32x4){0.f, 0.f, 0.f, 0.f};
        cur = nxt; cA = nA; cB = nB; ++ui;
        if constexpr (ALIGN_EPI) { if (wr == 1) PG8_BAR; }
    }
    PG8_WAIT_V(0);
    if constexpr (!ALIGN_EPI) { if (wr == 0) PG8_BAR; }
    PG8_BAR;
    if constexpr (Epi::AFTER_DRAIN) { E.fused(acc, cur, wr, wc, fr, fq, lds, wid, lane); S.done(cur); }
#undef PG8_SA
#undef PG8_SB
#undef PG8_STAGE
#undef PG8_STAGE_A
#undef PG8_GV
#undef PG8_LDA
#undef PG8_LDB
#undef PG8_MMA
#undef PG8_WAIT_V
#undef PG8_WAIT_L
#undef PG8_BAR
#undef PG8_SCHED
}
}

constexpr size_t MiB = (size_t)1 << 20;
constexpr size_t WS_CTL = 0, CTL_ZERO_BYTES = 32768;
constexpr size_t WS_MOD = 1 * MiB;
constexpr size_t WS_AFF = 4 * MiB;
constexpr size_t WS_GATE = 7 * MiB;
constexpr size_t WS_IDX = 7 * MiB + 512 * 1024;
constexpr size_t WS_INV = 8 * MiB;
constexpr size_t WS_WATT_IN = 10 * MiB, WS_WATT_OUT = 22 * MiB, WS_WREC_IN = 26 * MiB, WS_WREC_OUT = 46 * MiB;
constexpr size_t WS_WMOE1 = 50 * MiB;
constexpr size_t WS_H8O = 320 * MiB;
constexpr size_t WS_WREC_F8 = 360 * MiB;
constexpr size_t WS_WMOE2 = 562 * MiB;
constexpr size_t WS_X = 818 * MiB;
constexpr size_t WS_H = 962 * MiB;
constexpr size_t WS_P = 1034 * MiB;
constexpr size_t WS_O = 1394 * MiB;
constexpr size_t WS_OF = WS_O + 72 * MiB, WS_OB = WS_O + 144 * MiB;
constexpr size_t WS_END = 1610 * MiB;
static_assert((size_t)RT * 1024 * 4 <= 144 * MiB && (size_t)RT * 5120 * 2 <= 360 * MiB && (size_t)XR * 2048 * 2 <= 360 * MiB && (size_t)XR * 1024 * 2 <= 216 * MiB, "ws map");
constexpr int CW_BAR = 4096;

constexpr int LDS_BYTES = 147456;
constexpr int MISC_OFF = LDS_BYTES - 256;

#define GAS __attribute__((address_space(1)))
#define LAS __attribute__((address_space(3)))
typedef unsigned short bf16;
typedef float f32x4 __attribute__((ext_vector_type(4)));
typedef unsigned v4u __attribute__((ext_vector_type(4)));
typedef unsigned v2u __attribute__((ext_vector_type(2)));
typedef short bf16x8 __attribute__((ext_vector_type(8)));
typedef short s16x4 __attribute__((ext_vector_type(4)));
typedef float f32x16 __attribute__((ext_vector_type(16)));
#define LDS_WAIT() asm volatile("s_waitcnt lgkmcnt(0)" ::: "memory")
#define VM_WAIT() asm volatile("s_waitcnt vmcnt(0)" ::: "memory")
__device__ __forceinline__ unsigned f2bf(float f) { const __bf16 b = (__bf16)f; return (unsigned)__builtin_bit_cast(unsigned short, b); }
__device__ __forceinline__ unsigned pk2(float lo, float hi) { return pg8::cvt_pk_bf16(lo, hi); }
__device__ __forceinline__ float bf2f(unsigned short b) { return __builtin_bit_cast(float, (unsigned)b << 16); }
__device__ __forceinline__ float bflo(unsigned w) { return __builtin_bit_cast(float, w << 16); }
__device__ __forceinline__ float bfhi(unsigned w) { return __builtin_bit_cast(float, w & 0xffff0000u); }
template <int CTRL> __device__ __forceinline__ float dppx(float x) { return __builtin_bit_cast(float, __builtin_amdgcn_update_dpp(0, __builtin_bit_cast(int, x), CTRL, 0xF, 0xF, true)); }
__device__ __forceinline__ float lx1(float x) { return dppx<0xB1>(x); }
__device__ __forceinline__ float lx2(float x) { return dppx<0x4E>(x); }
__device__ __forceinline__ float lx4(float x) { return dppx<0x1B>(dppx<0x141>(x)); }
__device__ __forceinline__ float lx8(float x) { return dppx<0x128>(x); }
__device__ __forceinline__ float sw16sum(float a, float b) { auto r = __builtin_amdgcn_permlane16_swap(__float_as_uint(a), __float_as_uint(b), false, false); return __uint_as_float(r[0]) + __uint_as_float(r[1]); }
__device__ __forceinline__ float sw32sum(float a, float b) { auto r = __builtin_amdgcn_permlane32_swap(__float_as_uint(a), __float_as_uint(b), false, false); return __uint_as_float(r[0]) + __uint_as_float(r[1]); }
__device__ __forceinline__ float sw16max(float a) { auto r = __builtin_amdgcn_permlane16_swap(__float_as_uint(a), __float_as_uint(a), false, false); return fmaxf(__uint_as_float(r[0]), __uint_as_float(r[1])); }
__device__ __forceinline__ float sw32max(float a) { auto r = __builtin_amdgcn_permlane32_swap(__float_as_uint(a), __float_as_uint(a), false, false); return fmaxf(__uint_as_float(r[0]), __uint_as_float(r[1])); }
__device__ __forceinline__ float wave_sum_x(float v) { v += lx1(v); v += lx2(v); v += lx4(v); v += lx8(v); v = sw16sum(v, v); v = sw32sum(v, v); return v; }
__device__ __forceinline__ float wave_sum(float v) { return wave_sum_x(v); }
__device__ __forceinline__ int wave_sum_i(int v) {
#pragma unroll
    for (int o = 1; o < 64; o <<= 1) v += __shfl_xor(v, o);
    return v;
}
__device__ __forceinline__ int wave_incl_scan(int v, int lane) {
#pragma unroll
    for (int o = 1; o < 64; o <<= 1) { const int t = __shfl_up(v, o); if (lane >= o) v += t; }
    return v;
}

#define XB_TMO      128
#define XB_XCNT(j)  (256  + 64 * (j))
#define XB_XSUB(j)  (1280 + 64 * (j))
#define XB_XGEN(j)  (2304 + 64 * (j))
#define XB_TOP      3328
#define XB_TOPGEN   3392
#define XCD_BAR_WORDS 3456
#define XB_SPIN_CAP (1u << 18)

__device__ __forceinline__ unsigned xb_ld(unsigned* p)              { return __hip_atomic_load(p, __ATOMIC_RELAXED, __HIP_MEMORY_SCOPE_AGENT); }
__device__ __forceinline__ unsigned xb_add(unsigned* p, unsigned v) { return __hip_atomic_fetch_add(p, v, __ATOMIC_RELAXED, __HIP_MEMORY_SCOPE_AGENT); }
__device__ __forceinline__ unsigned xb_xcc_id() { return (unsigned)__builtin_amdgcn_s_getreg((3 << 11) | 20) & 0xFu; }
#define XB_SPIN(cond, bar) do { unsigned _sp = 0; while (cond) { __builtin_amdgcn_s_sleep(1); \
    if ((++_sp & 255u) == 0u) { if (xb_ld(&(bar)[XB_TMO])) break; if (_sp > XB_SPIN_CAP) { atomicAdd(&(bar)[XB_TMO], 1u); break; } } } } while (0)

struct XcdBarrier {
    unsigned* bar; unsigned x;
    volatile LAS unsigned* st;
};

__device__ __forceinline__ XcdBarrier xcd_barrier_post(unsigned* bar, volatile LAS unsigned* st) {
    XcdBarrier b; b.bar = bar; b.x = xb_xcc_id(); b.st = st;
    if (threadIdx.x == 0) (void)xb_add(&bar[XB_XCNT(b.x)], 1u);
    return b;
}
__device__ __forceinline__ void xcd_barrier_complete(unsigned* bar, unsigned x, unsigned& nloc, unsigned& nx) {
    const unsigned G = gridDim.x * gridDim.y * gridDim.z;
    unsigned sum, cnt, mine, sp = 0u;
    for (;;) {
        sum = 0u; cnt = 0u; mine = 0u;
#pragma unroll
        for (unsigned j = 0; j < 16; ++j) { const unsigned c = xb_ld(&bar[XB_XCNT(j)]); sum += c; cnt += (c > 0u) ? 1u : 0u; mine = (j == x) ? c : mine; }
        if (sum == G) break;
        __builtin_amdgcn_s_sleep(1);
        if ((++sp & 255u) == 0u) { if (xb_ld(&bar[XB_TMO])) break; if (sp > XB_SPIN_CAP) { atomicAdd(&bar[XB_TMO], 1u); break; } }
    }
    nloc = mine > 0u ? mine : 1u; nx = cnt > 0u ? cnt : 1u;
}

__device__ __forceinline__ void xcd_barrier(const XcdBarrier& b) {
    asm volatile("s_waitcnt vmcnt(0)" ::: "memory");
    __syncthreads();
    if (threadIdx.x == 0) {
        unsigned* bar = b.bar;
        __builtin_amdgcn_s_waitcnt(0);
        unsigned nloc = b.st[0], nx = b.st[1];
        if (nloc == 0u) { xcd_barrier_complete(bar, b.x, nloc, nx); b.st[0] = nloc; b.st[1] = nx; }
        const unsigned old = xb_add(&bar[XB_XSUB(b.x)], 1u);
        const unsigned gen = old / nloc;
        if (old + 1u == (gen + 1u) * nloc) {
            __builtin_amdgcn_fence(__ATOMIC_RELEASE, "agent");
            asm volatile("s_waitcnt vmcnt(0)" ::: "memory");
            const unsigned og = xb_add(&bar[XB_TOP], 1u);
            const unsigned tg = og / nx;
            if (og + 1u == (tg + 1u) * nx) xb_add(&bar[XB_TOPGEN], 1u);
            else XB_SPIN(xb_ld(&bar[XB_TOPGEN]) == tg, bar);
            __builtin_amdgcn_fence(__ATOMIC_ACQUIRE, "agent");
            xb_add(&bar[XB_XGEN(b.x)], 1u);
            asm volatile("s_waitcnt vmcnt(0)" ::: "memory");
        } else {
            XB_SPIN(xb_ld(&bar[XB_XGEN(b.x)]) == gen, bar);
            __builtin_amdgcn_fence(__ATOMIC_ACQUIRE, "agent");
            asm volatile("s_waitcnt vmcnt(0)" ::: "memory");
        }
    }
    __syncthreads();
}

struct Frame {
    LAS unsigned char* lds;
    int tid, lane, wave, vcu, G;
    const float *x_in, *c_in, *ctx_in, *cctx_in, *w_mod, *b_mod, *norm_g, *att_w_in, *att_w_out, *na_rpb, *diff_lambda, *diff_subln_g, *rec_w_in, *rec_w_out, *rec_lb_logits, *rec_gnorm_g,
                *moe_router, *moe_w_gate, *moe_w_up, *moe_w_down, *final_g;
    float* out; unsigned char* ws;
};

__device__ __forceinline__ int perm_inv32(int n) { const int c5 = n & 31; return (n & ~31) + 16 * ((c5 >> 2) & 1) + 4 * (c5 >> 3) + (c5 & 3); }
__device__ __forceinline__ int rowmap(int n, int kind) {
    if (kind == 1) { const bool rp = (n >= 512 && n < 1024) || (n >= 2048 && n < 2560); const int d = n & 63; return rp ? ((n & ~63) + 32 * ((d >> 4) & 1) + 16 * (d >> 5) + (d & 15)) : perm_inv32(n); }
    if (kind >= 2) { const int pn = n >> 7, r = n & 127, wc = r >> 5, fq = (r >> 3) & 3, bj = (r >> 2) & 1, i = r & 3; return 256 * pn + 128 * bj + 32 * wc + 16 * (kind - 2) + 4 * fq + i; }
    return perm_inv32(n);
}
__device__ __forceinline__ void transpose_item(const float* W, int K, int N, bf16* WT, int kind, LAS float* scr, int item, int lane) {
    const int nblk = N / 64, kb = item / nblk, nb = item % nblk, k0 = 64 * kb, n0 = 64 * nb;
    { const float* wp = W + (size_t)(k0 + (lane >> 4)) * N + n0 + 4 * (lane & 15); LAS float* sp = scr + (lane >> 4) * 65 + 4 * (lane & 15); f32x4 tv[16];
#pragma unroll
      for (int i = 0; i < 16; ++i) tv[i] = __builtin_nontemporal_load((const f32x4*)(wp + (size_t)(4 * i) * N));
#pragma unroll
      for (int i = 0; i < 16; ++i) { sp[(4 * i) * 65 + 0] = tv[i].x; sp[(4 * i) * 65 + 1] = tv[i].y; sp[(4 * i) * 65 + 2] = tv[i].z; sp[(4 * i) * 65 + 3] = tv[i].w; } }
    LDS_WAIT(); asm volatile("" ::: "memory");
    const int c = lane & 7;
#pragma unroll
    for (int j = 0; j < 8; ++j) { const int n = (lane >> 3) + 8 * j; const LAS float* s = scr + (8 * c) * 65 + n;
        v4u o; o.x = pk2(s[0 * 65], s[1 * 65]); o.y = pk2(s[2 * 65], s[3 * 65]); o.z = pk2(s[4 * 65], s[5 * 65]); o.w = pk2(s[6 * 65], s[7 * 65]);
        __builtin_nontemporal_store(o, (GAS v4u*)(WT + (size_t)rowmap(n0 + n, kind) * K + k0 + 8 * c)); }
    LDS_WAIT(); asm volatile("" ::: "memory");
}
__device__ __forceinline__ void transpose_item8(const float* W, int K, int N, unsigned char* WT, int kind, LAS float* scr, int item, int lane) {
    const int nblk = N / 64, kb = item / nblk, nb = item % nblk, k0 = 64 * kb, n0 = 64 * nb;
    { const float* wp = W + (size_t)(k0 + (lane >> 4)) * N + n0 + 4 * (lane & 15); LAS float* sp = scr + (lane >> 4) * 65 + 4 * (lane & 15); f32x4 tv[16];
#pragma unroll
      for (int i = 0; i < 16; ++i) tv[i] = __builtin_nontemporal_load((const f32x4*)(wp + (size_t)(4 * i) * N));
#pragma unroll
      for (int i = 0; i < 16; ++i) { const f32x4 t = tv[i] * pg8::FP8_WGT; sp[(4 * i) * 65 + 0] = t.x; sp[(4 * i) * 65 + 1] = t.y; sp[(4 * i) * 65 + 2] = t.z; sp[(4 * i) * 65 + 3] = t.w; } }
    LDS_WAIT(); asm volatile("" ::: "memory");
    const int c = lane & 7;
#pragma unroll
    for (int j = 0; j < 8; ++j) { const int n = (lane >> 3) + 8 * j; const LAS float* s = scr + (8 * c) * 65 + n;
        v2u o; o.x = pg8::pack4_fp8(s[0 * 65], s[1 * 65], s[2 * 65], s[3 * 65]); o.y = pg8::pack4_fp8(s[4 * 65], s[5 * 65], s[6 * 65], s[7 * 65]);
        __builtin_nontemporal_store(o, (GAS v2u*)(WT + (size_t)rowmap(n0 + n, kind) * K + k0 + 8 * c)); }
    LDS_WAIT(); asm volatile("" ::: "memory");
}
struct MoeItem { const float* W; unsigned char* WT; int K, N, kind, k0, n0; };
__device__ __forceinline__ MoeItem moe_item_desc(Frame& F, int r) {
    const int le = r / 768, q = r % 768, which = q / 256, item = q % 256; MoeItem d;
    if (which == 0) { d.W = F.moe_w_gate + (size_t)le * 1024 * 2048; d.WT = F.ws + WS_WMOE1 + (size_t)le * 4096 * 1024; d.K = 1024; d.N = 2048; d.kind = 2; }
    else if (which == 1) { d.W = F.moe_w_up + (size_t)le * 1024 * 2048; d.WT = F.ws + WS_WMOE1 + (size_t)le * 4096 * 1024; d.K = 1024; d.N = 2048; d.kind = 3; }
    else { d.W = F.moe_w_down + (size_t)le * 2048 * 1024; d.WT = F.ws + WS_WMOE2 + (size_t)le * 1024 * 2048; d.K = 2048; d.N = 1024; d.kind = 0; }
    const int nblk = d.N / 64; d.k0 = 128 * (item / nblk); d.n0 = 64 * (item % nblk); return d;
}
__device__ __forceinline__ void moe_half_load(const MoeItem& d, int h, int lane, f32x4 (&tv)[16]) {
    const float* wp = d.W + (size_t)(d.k0 + 64 * h + 16 * (lane >> 4)) * d.N + d.n0 + 4 * (lane & 15);
#pragma unroll
    for (int i = 0; i < 16; ++i) tv[i] = __builtin_nontemporal_load((const f32x4*)(wp + (size_t)i * d.N));
}
__device__ __forceinline__ void moe_half_pack(int h, LAS unsigned* scr, int lane, const f32x4 (&tv)[16]) {
    LAS unsigned* sp = scr + (4 * (lane & 15)) * 36 + 16 * h + 4 * (lane >> 4);
#pragma unroll
    for (int g = 0; g < 4; ++g) { const f32x4 t0 = tv[4 * g] * pg8::FP8_WGT, t1 = tv[4 * g + 1] * pg8::FP8_WGT, t2 = tv[4 * g + 2] * pg8::FP8_WGT, t3 = tv[4 * g + 3] * pg8::FP8_WGT;
        sp[0 * 36 + g] = pg8::pack4_fp8(t0.x, t1.x, t2.x, t3.x); sp[1 * 36 + g] = pg8::pack4_fp8(t0.y, t1.y, t2.y, t3.y);
        sp[2 * 36 + g] = pg8::pack4_fp8(t0.z, t1.z, t2.z, t3.z); sp[3 * 36 + g] = pg8::pack4_fp8(t0.w, t1.w, t2.w, t3.w); }
}
__device__ __forceinline__ void moe_item_store(const MoeItem& d, LAS unsigned* scr, int lane) {
    LDS_WAIT(); asm volatile("" ::: "memory");
    const int c = lane & 7;
#pragma unroll
    for (int j = 0; j < 8; ++j) { const int n = (lane >> 3) + 8 * j; const v4u o = *(const LAS v4u*)(scr + n * 36 + 4 * c);
        __builtin_nontemporal_store(o, (GAS v4u*)(d.WT + (size_t)rowmap(d.n0 + n, d.kind) * d.K + d.k0 + 16 * c)); }
    LDS_WAIT(); asm volatile("" ::: "memory");
}
template <class RMap>
__device__ __forceinline__ void moe_items_pipelined(Frame& F, LAS float* scr_f, int j0, int step, int jend, const RMap& rmap) {
    f32x4 ta[16], tb[16]; int j = j0; LAS unsigned* scr = (LAS unsigned*)scr_f;
    if (j >= jend) return;
    MoeItem d = moe_item_desc(F, rmap(j)); moe_half_load(d, 0, F.lane, ta);
    for (;;) {
        moe_half_load(d, 1, F.lane, tb);
        moe_half_pack(0, scr, F.lane, ta);
        const int jn = j + step; const bool more = jn < jend; MoeItem dn = d;
        if (more) { dn = moe_item_desc(F, rmap(jn)); moe_half_load(dn, 0, F.lane, ta); }
        moe_half_pack(1, scr, F.lane, tb);
        moe_item_store(d, scr, F.lane);
        if (!more) break;
        d = dn; j = jn;
    }
}
#ifndef Q_OUT_V
#define Q_OUT_V 1
#define Q_DN_V 2
#define Q_SEL_V 2
#endif
constexpr int LITEMS = 12288, Q_EI = 1, Q_AT = 1, Q_OUT = Q_OUT_V, Q_SEL = Q_SEL_V, Q_DN = Q_DN_V;
constexpr int Z_EI = 64 * 8 * Q_EI, Z_AT = 128 * 8 * Q_AT, Z_OUT = 192 * 8 * Q_OUT, Z_SEL = 256 * 6 * Q_SEL, Z_DN = 128 * 8 * Q_DN, Z_OI1 = 192 * 8 + 64 * 8 * 2, Z_OI3 = Z_OI1;
constexpr int G0I = 0, G0A = G0I + Z_EI, G0O = G0A + Z_AT, G0S = G0O + Z_OUT, G0D = G0S + Z_SEL,
              G1I = G0D + Z_DN, G1O = G1I + Z_OI1, G1S = G1O + Z_OUT, G1D = G1S + Z_SEL,
              G2I = G1D + Z_DN, G2A = G2I + Z_EI, G2O = G2A + Z_AT, G2S = G2O + Z_OUT, G2D = G2S + Z_SEL,
              G3I = G2D + Z_DN, GEND = G3I + Z_OI3;
static_assert(GEND <= 3 * LITEMS, "the slots have no cap check");
constexpr int GD = 3 * LITEMS - GEND;
static_assert(GD + G1D >= LITEMS && GD + G2D >= 2 * LITEMS, "a layer's items must be converted before its expert GEMMs");
__device__ __forceinline__ void tail_convert(Frame& F, int l, int kind  , int bx) {
    int start = -1, rank = -1, nrank = 1, cnt = 0;
    if (kind == 0 && (l & 1)) {
        int r1, r2;
        if (l == 1) { r1 = bx < 128 ? bx : (bx >= 192 ? bx - 64 : -1); r2 = bx >= 192 ? bx - 192 : -1; } else { r1 = bx >= 64 ? bx - 64 : -1; r2 = (bx >= 64 && bx < 128) ? bx - 64 : -1; }
        if (r1 < 0) return;
        const int st = (l == 1) ? G1I : G3I, w1 = r1 * 8 + F.wave, w2 = r2 * 8 + F.wave;
        LAS float* scr = (LAS float*)(F.lds + F.wave * 16640);
        moe_items_pipelined(F, scr, 0, 1, r2 >= 0 ? 3 : 1, [=](int k) { return LITEMS + GD + (k == 0 ? st + w1 : st + 192 * 8 + (k - 1) * 64 * 8 + w2); });
        return; }
    if (kind == 0) { const int rem = 192; rank = (bx - rem) * 8 + F.wave; nrank = (256 - rem) * 8; cnt = Q_EI; if (bx < rem) rank = -1; start = (l == 0) ? G0I : G2I; }
    else if (kind == 1) { rank = (bx - 64) * 8 + F.wave; nrank = 192 * 8; cnt = Q_OUT; if (bx < 64) rank = -1; start = (l == 0) ? G0O : (l == 1) ? G1O : (l == 2) ? G2O : -1; }
    else if (kind == 2) { rank = (bx - 128) * 8 + F.wave; nrank = 128 * 8; cnt = Q_DN; if (bx < 128) rank = -1; start = (l == 0) ? G0D : (l == 1) ? G1D : (l == 2) ? G2D : -1; }
    else if (kind == 3) { rank = bx * 6 + F.wave - 2; nrank = 256 * 6; cnt = Q_SEL; if (F.wave < 2) rank = -1; start = (l == 0) ? G0S : (l == 1) ? G1S : (l == 2) ? G2S : -1; }
    else { rank = (bx - 128) * 8 + F.wave; nrank = 128 * 8; cnt = Q_AT; if (bx < 128) rank = -1; start = (l == 0) ? G0A : (l == 2) ? G2A : -1; }
    if (start < 0 || rank < 0) return;
    LAS float* scr = (LAS float*)(F.lds + F.wave * 16640);
    moe_items_pipelined(F, scr, 0, 1, cnt, [=](int k) { return LITEMS + GD + start + k * nrank + rank; });
}
#ifndef P0_REP_A
#define P0_REP_A 1
#define P0_REP_B 1
#endif
__device__ __forceinline__ void p0_prologue(Frame& F) {
    for (int repa_ = 0; repa_ < P0_REP_A; ++repa_) { if (repa_) __syncthreads();
        LAS float* S = (LAS float*)F.lds;
        LAS float* part = S + 17 * 1024;
        for (int idx = F.tid; idx < 17 * 1024; idx += NTHR) { const int r = idx >> 10, d = idx & 1023; const float v = r < 16 ? F.c_in[r * 1024 + d] : F.cctx_in[d]; S[idx] = v / (1.0f + expf(-v)); }
        __syncthreads();
        float* mod = (float*)(F.ws + WS_MOD);
        for (int item = blockIdx.x; item < 4 * 192; item += F.G) {
            const int l = item / 192, cb = item % 192, col = cb * 32 + (F.lane & 31), d0 = F.wave * 128 + 64 * (F.lane >> 5);
            float acc[17], w[64];
#pragma unroll
            for (int r = 0; r < 17; ++r) acc[r] = 0.f;
            const float* wp = F.w_mod + ((size_t)l * 1024 + d0) * 6144 + col;
#pragma unroll
            for (int i = 0; i < 64; ++i) w[i] = __builtin_nontemporal_load(wp + (size_t)i * 6144);
#pragma unroll
            for (int i = 0; i < 16; ++i) {
#pragma unroll
                for (int r = 0; r < 17; ++r) { const f32x4 s4 = *(const LAS f32x4*)(S + r * 1024 + d0 + 4 * i); acc[r] += (s4.x * w[4 * i] + s4.y * w[4 * i + 1]) + (s4.z * w[4 * i + 2] + s4.w * w[4 * i + 3]); } }
#pragma unroll
            for (int r = 0; r < 17; ++r) part[(F.wave * 17 + r) * 64 + F.lane] = acc[r];
            __syncthreads();
            for (int o = F.tid; o < 17 * 32; o += NTHR) { const int r = o >> 5, ln = o & 31; float s = 0.f;
#pragma unroll
                for (int w8 = 0; w8 < 8; ++w8) s += part[(w8 * 17 + r) * 64 + ln] + part[(w8 * 17 + r) * 64 + 32 + ln];
                mod[((size_t)l * 17 + r) * 6144 + cb * 32 + ln] = s + F.b_mod[l * 6144 + cb * 32 + ln]; }
            __syncthreads();
        }
    }
    for (int repb_ = 0; repb_ < P0_REP_B; ++repb_) { if (repb_) { VM_WAIT(); __syncthreads(); }
        LAS float* scr = (LAS float*)(F.lds + F.wave * 16640);
        const int gw = F.vcu * NWAVES + F.wave, NGW = F.G * NWAVES;
        constexpr int I_AIN = 16 * 48, I_SQ = 16 * 16, I_RIN = 16 * 80, I_MOE = 256;
        constexpr int T0 = 2 * I_AIN, T1 = T0 + 2 * I_SQ, T2 = T1 + 2 * I_RIN, T3 = T2 + 2 * I_SQ, NM = LITEMS + GD;
        static_assert(3 * I_MOE == 768 && 16 * 768 == LITEMS, "item arithmetic");
        bf16* wao = (bf16*)(F.ws + WS_WATT_OUT); bf16* wro = (bf16*)(F.ws + WS_WREC_OUT);
        for (int it = gw; it < T3; it += NGW) {
            int r = it;
            if (r < T0) { const int e = r / I_AIN; if (IN8E) transpose_item8(F.att_w_in + (size_t)e * 1024 * 3072, 1024, 3072, F.ws + WS_WATT_IN + (size_t)e * 3072 * 1024, 1, scr, r % I_AIN, F.lane);
                else transpose_item(F.att_w_in + (size_t)e * 1024 * 3072, 1024, 3072, (bf16*)(F.ws + WS_WATT_IN) + (size_t)e * 3072 * 1024, 1, scr, r % I_AIN, F.lane); continue; }
            if (r < T1) { r -= T0; const int e = r / I_SQ; transpose_item(F.att_w_out + (size_t)e * 1024 * 1024, 1024, 1024, wao + (size_t)e * 1024 * 1024, 0, scr, r % I_SQ, F.lane); continue; }
            if (r < T2) { r -= T1; const int e = r / I_RIN, it = r % I_RIN, nb = it % 80;
                if (nb >= 16 && nb < 48) transpose_item8(F.rec_w_in + (size_t)e * 1024 * 5120 + 1024, 1024, 5120, F.ws + WS_WREC_F8 + (size_t)e * 2048 * 1024, 0, scr, it - 16, F.lane);
                else transpose_item(F.rec_w_in + (size_t)e * 1024 * 5120, 1024, 5120, (bf16*)(F.ws + WS_WREC_IN) + (size_t)e * 5120 * 1024, 0, scr, it, F.lane); continue; }
            r -= T2; { const int e = r / I_SQ; transpose_item(F.rec_w_out + (size_t)e * 1024 * 1024, 1024, 1024, wro + (size_t)e * 1024 * 1024, 0, scr, r % I_SQ, F.lane); }
        }
        moe_items_pipelined(F, scr, (gw + NGW / 2) % NGW, NGW, NM, [](int r) { return r; });
    }
}

template <int MODE>
__device__ __forceinline__ void norm_phase(Frame& F, int l, int dbg_src_in = 0) {
    const float* mod = (const float*)(F.ws + WS_MOD);
    bf16* X = (bf16*)(F.ws + WS_X); bf16* H = (bf16*)(F.ws + WS_H);
    const int nrows = (MODE == 2 || (MODE == 1 && l == 3)) ? RL : RT;
    const int per = nrows / (F.G * NWAVES);
    const int gw = F.vcu * NWAVES + F.wave, lane = F.lane;
    LAS float* Wt = (LAS float*)F.lds;
    if (MODE == 1) {
        for (int idx = F.tid; idx < 4096; idx += NTHR) { const int d = idx >> 2, eg = idx & 3; const f32x4 w = *(const f32x4*)(F.moe_router + ((size_t)l * 1024 + d) * 16 + eg * 4);
#pragma unroll
            for (int i = 0; i < 4; ++i) Wt[(eg * 4 + i) * 1024 + d] = w[i]; }
        __syncthreads();
    }
    int cur_b = -1; f32x4 av[4], bv[4];
    const int kind_sh = (MODE == 0) ? 0 : 3, kind_sc = (MODE == 0) ? 1 : 4;
    const bool src_in = (MODE == 0 && l == 0) || (MODE == 2 && dbg_src_in);
    const bool comb = (MODE == 0 && l > 0) || (MODE == 2 && l >= 0);
#define XROW(r) ((r) < RL ? F.x_in + (size_t)(r) * 1024 : F.ctx_in + (size_t)((r) - RL) * 1024)
#define XLOAD(dst, r) do { if (src_in) { const float* xr_ = XROW(r); _Pragma("unroll") for (int j = 0; j < 4; ++j) dst[j] = *(const f32x4*)(xr_ + 256 * j + 4 * lane); } \
        else { const bf16* xr_ = X + (size_t)(r) * 1024; _Pragma("unroll") for (int j = 0; j < 4; ++j) { const v2u w_ = *(const v2u*)(xr_ + 256 * j + 4 * lane); dst[j] = (f32x4){bflo(w_.x), bfhi(w_.x), bflo(w_.y), bfhi(w_.y)}; } } } while (0)
    f32x4 nx[4]; v4u ni0 = {0u, 0u, 0u, 0u}, ni1 = {0u, 0u, 0u, 0u};
    { const int row = gw * per;
      XLOAD(nx, row);
      if (comb) { ni0 = *(const v4u*)(F.ws + WS_INV + (size_t)row * 32); ni1 = *(const v4u*)(F.ws + WS_INV + (size_t)row * 32 + 16); } }
    for (int rr = 0; rr < per; ++rr) {
        const int row = gw * per + rr; const bool latent = row < RL; const int bidx = latent ? (row >> 11) : 16;
        if (MODE != 2 && bidx != cur_b) { cur_b = bidx;
            const float* gq = F.norm_g + ((size_t)l * 2 + (MODE == 0 ? 0 : 1)) * 1024; const float* sc = mod + ((size_t)l * 17 + bidx) * 6144 + kind_sc * 1024; const float* sh = mod + ((size_t)l * 17 + bidx) * 6144 + kind_sh * 1024;
#pragma unroll
            for (int j = 0; j < 4; ++j) { const f32x4 g4 = *(const f32x4*)(gq + 256 * j + 4 * lane), s4 = *(const f32x4*)(sc + 256 * j + 4 * lane); av[j] = g4 * (s4 + 1.0f); bv[j] = *(const f32x4*)(sh + 256 * j + 4 * lane); } }
        f32x4 v[4];
#pragma unroll
        for (int j = 0; j < 4; ++j) v[j] = nx[j];
        const v4u i0 = ni0, i1 = ni1;
        if (rr + 1 < per) { const int rn = row + 1;
            XLOAD(nx, rn);
            if (comb) { ni0 = *(const v4u*)(F.ws + WS_INV + (size_t)rn * 32); ni1 = *(const v4u*)(F.ws + WS_INV + (size_t)rn * 32 + 16); } }
        if (comb) {
            const int lp = (MODE == 2) ? l : l - 1;
            const unsigned iw[8] = {i0.x, i0.y, i0.z, i0.w, i1.x, i1.y, i1.z, i1.w};
            const bf16* Y = (const bf16*)(F.ws + WS_O);
            const int xb = latent ? (row >> 11) * 256 : 4096 + ((row - RL) >> 8) * 32;
            f32x4 a[4];
#pragma unroll
            for (int j = 0; j < 4; ++j) a[j] = (f32x4){0.f, 0.f, 0.f, 0.f};
#pragma unroll
            for (int e = 0; e < 16; ++e) { const unsigned slot = (unsigned)__builtin_amdgcn_readfirstlane((int)((iw[e >> 1] >> (16 * (e & 1))) & 0xffffu));
                if (slot != 0xffffu) { const bf16* yr = Y + (size_t)(e * XR_E + xb + (int)slot) * 1024;
#pragma unroll
                    for (int j = 0; j < 4; ++j) { const v2u w = *(const v2u*)(yr + 256 * j + 4 * lane); a[j] += (f32x4){bflo(w.x), bfhi(w.x), bflo(w.y), bfhi(w.y)}; } } }
            const float* g2 = mod + ((size_t)lp * 17 + bidx) * 6144 + 5 * 1024;
#pragma unroll
            for (int j = 0; j < 4; ++j) { v[j] += *(const f32x4*)(g2 + 256 * j + 4 * lane) * a[j]; if (MODE == 0) { v2u w; w.x = pk2(v[j].x, v[j].y); w.y = pk2(v[j].z, v[j].w); *(v2u*)(X + (size_t)row * 1024 + 256 * j + 4 * lane) = w; } }
        }
        float ss = 0.f;
#pragma unroll
        for (int j = 0; j < 4; ++j) ss += (v[j].x * v[j].x + v[j].y * v[j].y) + (v[j].z * v[j].z + v[j].w * v[j].w);
        const float rstd = 1.0f / sqrtf(wave_sum(ss) * (1.0f / 1024.0f) + NORM_EPS);
        if (MODE == 2) {
#pragma unroll
            for (int j = 0; j < 4; ++j) *(f32x4*)(F.out + (size_t)row * 1024 + 256 * j + 4 * lane) = v[j] * rstd * *(const f32x4*)(F.final_g + 256 * j + 4 * lane);
            continue;
        }
        f32x4 hv[4];
#pragma unroll
        for (int j = 0; j < 4; ++j) { hv[j] = v[j] * rstd * av[j] + bv[j];
            if (MODE == 1 || (MODE == 0 && IN8E)) *(unsigned*)((unsigned char*)H + (size_t)row * 1024 + 256 * j + 4 * lane) = pg8::pack4_fp8(hv[j].x * pg8::FP8_ACT, hv[j].y * pg8::FP8_ACT, hv[j].z * pg8::FP8_ACT, hv[j].w * pg8::FP8_ACT);
            else { v2u w; w.x = pk2(hv[j].x, hv[j].y); w.y = pk2(hv[j].z, hv[j].w); *(v2u*)(H + (size_t)row * 1024 + 256 * j + 4 * lane) = w; } }
        if (MODE == 1) {
            float sp[16];
#pragma unroll
            for (int e = 0; e < 16; ++e) { float s = 0.f;
#pragma unroll
                for (int j = 0; j < 4; ++j) { const f32x4 w = *(const LAS f32x4*)(Wt + e * 1024 + 256 * j + 4 * lane); s += (hv[j].x * w.x + hv[j].y * w.y) + (hv[j].z * w.z + hv[j].w * w.w); }
                sp[e] = s; if ((e & 3) == 3) __builtin_amdgcn_sched_barrier(0); }
            { const bool b5 = (lane & 32) != 0, b4 = (lane & 16) != 0, b3 = (lane & 8) != 0, b2 = (lane & 4) != 0;
#pragma unroll
              for (int i = 0; i < 8; ++i) { const float mn = b5 ? sp[8 + i] : sp[i], ot = b5 ? sp[i] : sp[8 + i]; sp[i] = mn + __shfl_xor(ot, 32); }
#pragma unroll
              for (int i = 0; i < 4; ++i) { const float mn = b4 ? sp[4 + i] : sp[i], ot = b4 ? sp[i] : sp[4 + i]; sp[i] = mn + __shfl_xor(ot, 16); }
#pragma unroll
              for (int i = 0; i < 2; ++i) { const float mn = b3 ? sp[2 + i] : sp[i], ot = b3 ? sp[i] : sp[2 + i]; sp[i] = mn + __shfl_xor(ot, 8); }
              { const float mn = b2 ? sp[1] : sp[0], ot = b2 ? sp[0] : sp[1]; sp[0] = mn + __shfl_xor(ot, 4); }
              sp[0] += __shfl_xor(sp[0], 2); sp[0] += __shfl_xor(sp[0], 1); }
            float mine = sp[0], mx = mine;
#pragma unroll
            for (int o = 4; o < 64; o <<= 1) mx = fmaxf(mx, __shfl_xor(mx, o));
            const float ex = expf(mine - mx); float sum = ex;
#pragma unroll
            for (int o = 4; o < 64; o <<= 1) sum += __shfl_xor(sum, o);
            mine = ex / sum;
            const int eo = ((lane >> 5) & 1) * 8 + ((lane >> 4) & 1) * 4 + ((lane >> 3) & 1) * 2 + ((lane >> 2) & 1);
            if ((lane & 3) == 0) { float* aff = (float*)(F.ws + WS_AFF);
                if (latent) aff[((size_t)(row >> 11) * 16 + eo) * 2048 + (row & 2047)] = mine;
                else { const int rc = row - RL; aff[(size_t)524288 + ((size_t)(rc >> 8) * 16 + eo) * 256 + (rc & 255)] = mine; } }
        }
    }
    if (MODE == 1) __syncthreads();
#undef XROW
#undef XLOAD
}

__device__ __forceinline__ void router_norm_phase(Frame& F, int l) {
    const float* mod = (const float*)(F.ws + WS_MOD);
    const bf16* X = (const bf16*)(F.ws + WS_X); unsigned char* H8 = F.ws + WS_H;
    const int nrows = (l == 3) ? RL : RT, per = nrows / (F.G * NWAVES), gw = F.vcu * NWAVES + F.wave, lane = F.lane;
    LAS float* Wt = (LAS float*)F.lds;
    { f32x4 wv_[8];
#pragma unroll
      for (int k_ = 0; k_ < 8; ++k_) { const int idx = F.tid + k_ * NTHR; wv_[k_] = *(const f32x4*)(F.moe_router + ((size_t)l * 1024 + (idx >> 2)) * 16 + (idx & 3) * 4); }
#pragma unroll
      for (int k_ = 0; k_ < 8; ++k_) { const int idx = F.tid + k_ * NTHR, d = idx >> 2, eg = idx & 3;
#pragma unroll
          for (int i = 0; i < 4; ++i) Wt[(eg * 4 + i) * 1024 + d] = wv_[k_][i]; } }
    __syncthreads();
    int cur_b = -1; f32x4 av[4], bv[4];
    v2u nxa[4], nxb[4];
#ifndef N1_REP
#define N1_REP 1
#endif
#pragma unroll 1
    for (int n1rep_ = 0; n1rep_ < N1_REP; ++n1rep_) {
    { const bf16* xr = X + (size_t)(gw * per) * 1024;
#pragma unroll
      for (int j = 0; j < 4; ++j) { nxa[j] = *(const v2u*)(xr + 256 * j + 4 * lane); nxb[j] = *(const v2u*)(xr + 1024 + 256 * j + 4 * lane); } }
    const bool b5 = (lane & 32) != 0, b4 = (lane & 16) != 0, b3 = (lane & 8) != 0, b2 = (lane & 4) != 0;
    const int eo = ((lane >> 5) & 1) * 8 + ((lane >> 4) & 1) * 4 + ((lane >> 3) & 1) * 2 + ((lane >> 2) & 1);
    for (int rr = 0; rr < per; rr += 2) {
        const int row = gw * per + rr; const bool latent = row < RL; const int bidx = latent ? (row >> 11) : 16;
        if (bidx != cur_b) { cur_b = bidx;
            const float* gq = F.norm_g + ((size_t)l * 2 + 1) * 1024; const float* sc = mod + ((size_t)l * 17 + bidx) * 6144 + 4 * 1024; const float* sh = mod + ((size_t)l * 17 + bidx) * 6144 + 3 * 1024;
#pragma unroll
            for (int j = 0; j < 4; ++j) { const f32x4 g4 = *(const f32x4*)(gq + 256 * j + 4 * lane), s4 = *(const f32x4*)(sc + 256 * j + 4 * lane); av[j] = g4 * (s4 + 1.0f); bv[j] = *(const f32x4*)(sh + 256 * j + 4 * lane); } }
        f32x4 va[4], vb[4];
#pragma unroll
        for (int j = 0; j < 4; ++j) { va[j] = (f32x4){bflo(nxa[j].x), bfhi(nxa[j].x), bflo(nxa[j].y), bfhi(nxa[j].y)}; vb[j] = (f32x4){bflo(nxb[j].x), bfhi(nxb[j].x), bflo(nxb[j].y), bfhi(nxb[j].y)}; }
        if (rr + 2 < per) { const bf16* xr = X + (size_t)(row + 2) * 1024;
#pragma unroll
            for (int j = 0; j < 4; ++j) { nxa[j] = *(const v2u*)(xr + 256 * j + 4 * lane); nxb[j] = *(const v2u*)(xr + 1024 + 256 * j + 4 * lane); } }
        float ssa = 0.f, ssb = 0.f;
#pragma unroll
        for (int j = 0; j < 4; ++j) { ssa += (va[j].x * va[j].x + va[j].y * va[j].y) + (va[j].z * va[j].z + va[j].w * va[j].w); ssb += (vb[j].x * vb[j].x + vb[j].y * vb[j].y) + (vb[j].z * vb[j].z + vb[j].w * vb[j].w); }
        ssa = wave_sum_x(ssa); ssb = wave_sum_x(ssb);
        const float rsa = 1.0f / sqrtf(ssa * (1.0f / 1024.0f) + NORM_EPS), rsb = 1.0f / sqrtf(ssb * (1.0f / 1024.0f) + NORM_EPS);
#pragma unroll
        for (int j = 0; j < 4; ++j) { va[j] = va[j] * rsa * av[j] + bv[j]; vb[j] = vb[j] * rsb * av[j] + bv[j];
            *(unsigned*)(H8 + (size_t)row * 1024 + 256 * j + 4 * lane) = pg8::pack4_fp8(va[j].x * pg8::FP8_ACT, va[j].y * pg8::FP8_ACT, va[j].z * pg8::FP8_ACT, va[j].w * pg8::FP8_ACT);
            *(unsigned*)(H8 + (size_t)(row + 1) * 1024 + 256 * j + 4 * lane) = pg8::pack4_fp8(vb[j].x * pg8::FP8_ACT, vb[j].y * pg8::FP8_ACT, vb[j].z * pg8::FP8_ACT, vb[j].w * pg8::FP8_ACT); }
        float spa[16], spb[16];
        pg8::f32x2 h2[16];
#pragma unroll
        for (int j = 0; j < 4; ++j) { h2[4 * j] = (pg8::f32x2){va[j].x, vb[j].x}; h2[4 * j + 1] = (pg8::f32x2){va[j].y, vb[j].y}; h2[4 * j + 2] = (pg8::f32x2){va[j].z, vb[j].z}; h2[4 * j + 3] = (pg8::f32x2){va[j].w, vb[j].w}; }
#pragma unroll
        for (int e = 0; e < 16; ++e) { pg8::f32x2 s0 = {0.f, 0.f}, s1 = {0.f, 0.f};
#pragma unroll
            for (int j = 0; j < 4; ++j) { const f32x4 w = *(const LAS f32x4*)(Wt + e * 1024 + 256 * j + 4 * lane);
                s0 = __builtin_elementwise_fma(h2[4 * j], (pg8::f32x2){w.x, w.x}, s0); s1 = __builtin_elementwise_fma(h2[4 * j + 1], (pg8::f32x2){w.y, w.y}, s1);
                s0 = __builtin_elementwise_fma(h2[4 * j + 2], (pg8::f32x2){w.z, w.z}, s0); s1 = __builtin_elementwise_fma(h2[4 * j + 3], (pg8::f32x2){w.w, w.w}, s1); }
            const pg8::f32x2 st = s0 + s1; spa[e] = st.x; spb[e] = st.y; if ((e & 3) == 3) __builtin_amdgcn_sched_barrier(0); }
#pragma unroll
        for (int i = 0; i < 8; ++i) { spa[i] = sw32sum(spa[i], spa[8 + i]); spb[i] = sw32sum(spb[i], spb[8 + i]); }
#pragma unroll
        for (int i = 0; i < 4; ++i) { spa[i] = sw16sum(spa[i], spa[4 + i]); spb[i] = sw16sum(spb[i], spb[4 + i]); }
#pragma unroll
        for (int i = 0; i < 2; ++i) { const float ma = b3 ? spa[2 + i] : spa[i], oa = b3 ? spa[i] : spa[2 + i], mb = b3 ? spb[2 + i] : spb[i], ob = b3 ? spb[i] : spb[2 + i]; spa[i] = ma + lx8(oa); spb[i] = mb + lx8(ob); }
        { const float ma = b2 ? spa[1] : spa[0], oa = b2 ? spa[0] : spa[1], mb = b2 ? spb[1] : spb[0], ob = b2 ? spb[0] : spb[1]; spa[0] = ma + lx4(oa); spb[0] = mb + lx4(ob); }
        spa[0] += lx2(spa[0]); spb[0] += lx2(spb[0]); spa[0] += lx1(spa[0]); spb[0] += lx1(spb[0]);
        float mxa = spa[0], mxb = spb[0];
        mxa = fmaxf(mxa, lx4(mxa)); mxb = fmaxf(mxb, lx4(mxb)); mxa = fmaxf(mxa, lx8(mxa)); mxb = fmaxf(mxb, lx8(mxb)); mxa = sw16max(mxa); mxb = sw16max(mxb); mxa = sw32max(mxa); mxb = sw32max(mxb);
        const float exa = expf(spa[0] - mxa), exb = expf(spb[0] - mxb); float sma = exa, smb = exb;
        sma += lx4(sma); smb += lx4(smb); sma += lx8(sma); smb += lx8(smb); sma = sw16sum(sma, sma); smb = sw16sum(smb, smb); sma = sw32sum(sma, sma); smb = sw32sum(smb, smb);
        const float pa = exa / sma, pb = exb / smb;
        if ((lane & 3) == 0) { float* aff = (float*)(F.ws + WS_AFF);
            if (latent) { float* ap = aff + ((size_t)(row >> 11) * 16 + eo) * 2048 + (row & 2047); ap[0] = pa; ap[1] = pb; }
            else { const int rc = row - RL; float* ap = aff + (size_t)524288 + ((size_t)(rc >> 8) * 16 + eo) * 256 + (rc & 255); ap[0] = pa; ap[1] = pb; } }
    }
    }
    __syncthreads();
}

template <bool FINAL>
__device__ __forceinline__ void combine_norm_phase(Frame& F, int l, int lp) {
    const float* mod = (const float*)(F.ws + WS_MOD);
    bf16* X = (bf16*)(F.ws + WS_X); bf16* H = (bf16*)(F.ws + WS_H); const unsigned char* Y = F.ws + WS_O;
    const int nrows = FINAL ? RL : RT, per = nrows / (F.G * NWAVES), gw = F.vcu * NWAVES + F.wave, lane = F.lane, row0 = gw * per, rowend = row0 + per;
    struct XRow { v2u x[4]; };
    struct YBuf { unsigned y[4][4]; };
#define Y4F(w_) ({ const unsigned w__ = (w_); const pg8::f32x2 lo__ = __builtin_amdgcn_cvt_pk_f32_fp8((int)w__, false), hi__ = __builtin_amdgcn_cvt_pk_f32_fp8((int)w__, true); (f32x4){lo__.x, lo__.y, hi__.x, hi__.y}; })
    auto load_x = [&](XRow& R, int row) { if (row < rowend) {
#pragma unroll
        for (int j = 0; j < 4; ++j) R.x[j] = *(const v2u*)(X + (size_t)row * 1024 + 256 * j + 4 * lane); } };
    auto load_inv = [&](int row) -> unsigned { return (row < rowend) ? *(const unsigned*)(F.ws + WS_INV + (size_t)row * 32 + 4 * (lane & 7)) : 0xffffffffu; };
    auto mask_of = [&](unsigned inv) -> unsigned { unsigned m = 0u;
#pragma unroll
        for (int q = 0; q < 8; ++q) { const unsigned w = (unsigned)__builtin_amdgcn_readlane((int)inv, q); m |= ((w & 0xffffu) != 0xffffu ? 1u : 0u) << (2 * q); m |= ((w >> 16) != 0xffffu ? 1u : 0u) << (2 * q + 1); }
        return m; };
    auto slot_of = [&](unsigned inv, int e) -> int { unsigned w = 0u;
#pragma unroll
        for (int q = 0; q < 8; ++q) { const unsigned wq = (unsigned)__builtin_amdgcn_readlane((int)inv, q); w = ((e >> 1) == q) ? wq : w; }
        return (int)((w >> (16 * (e & 1))) & 0xffffu); };
    auto yrow = [&](int row, int e, int slot) -> const unsigned char* { const int xb = row < RL ? (row >> 11) * 256 : 4096 + ((row - RL) >> 8) * 32; return Y + (size_t)(e * XR_E + xb + slot) * 1024; };
    auto prefetch_y = [&](YBuf& B, unsigned inv, int row) { unsigned m = mask_of(inv);
#pragma unroll
        for (int k = 0; k < 4; ++k) { if (m) { const int e = __builtin_ctz(m); m &= m - 1u; const unsigned char* yr = yrow(row, e, slot_of(inv, e));
#pragma unroll
            for (int j = 0; j < 4; ++j) B.y[k][j] = *(const unsigned*)(yr + 256 * j + 4 * lane); } } };
    int cur_b = -1; f32x4 av[4], bv[4], g2v[4];
    const bool h8 = (l & 1) ? IN8O : IN8E;
    auto do_row = [&](const XRow& R, unsigned inv, const YBuf& B, int row) {
        const bool latent = row < RL; const int bidx = latent ? (row >> 11) : 16;
        if (bidx != cur_b) { cur_b = bidx;
            const float* g2 = mod + ((size_t)lp * 17 + bidx) * 6144 + 5 * 1024;
            const float* gq = FINAL ? F.final_g : F.norm_g + ((size_t)l * 2) * 1024; const float* sc = mod + ((size_t)l * 17 + bidx) * 6144 + 1 * 1024; const float* sh = mod + ((size_t)l * 17 + bidx) * 6144;
#pragma unroll
            for (int j = 0; j < 4; ++j) { g2v[j] = *(const f32x4*)(g2 + 256 * j + 4 * lane) * (1.0f / pg8::FP8_Y); const f32x4 g4 = *(const f32x4*)(gq + 256 * j + 4 * lane);
                if (FINAL) { av[j] = g4; bv[j] = (f32x4){0.f, 0.f, 0.f, 0.f}; } else { av[j] = g4 * (*(const f32x4*)(sc + 256 * j + 4 * lane) + 1.0f); bv[j] = *(const f32x4*)(sh + 256 * j + 4 * lane); } } }
        f32x4 a[4];
#pragma unroll
        for (int j = 0; j < 4; ++j) a[j] = (f32x4){0.f, 0.f, 0.f, 0.f};
        unsigned m = mask_of(inv);
#pragma unroll
        for (int k = 0; k < 4; ++k) { if (m) { m &= m - 1u;
#pragma unroll
            for (int j = 0; j < 4; ++j) a[j] += Y4F(B.y[k][j]); } }
        while (m) { const int e = __builtin_ctz(m); m &= m - 1u; const unsigned char* yr = yrow(row, e, slot_of(inv, e));
#pragma unroll
            for (int j = 0; j < 4; ++j) a[j] += Y4F(*(const unsigned*)(yr + 256 * j + 4 * lane)); }
        f32x4 v[4]; float ss = 0.f;
#pragma unroll
        for (int j = 0; j < 4; ++j) { v[j] = (f32x4){bflo(R.x[j].x), bfhi(R.x[j].x), bflo(R.x[j].y), bfhi(R.x[j].y)} + g2v[j] * a[j];
            if (!FINAL) { v2u w; w.x = pk2(v[j].x, v[j].y); w.y = pk2(v[j].z, v[j].w); *(v2u*)(X + (size_t)row * 1024 + 256 * j + 4 * lane) = w; } ss += (v[j].x * v[j].x + v[j].y * v[j].y) + (v[j].z * v[j].z + v[j].w * v[j].w); }
        const float rstd = 1.0f / sqrtf(wave_sum(ss) * (1.0f / 1024.0f) + NORM_EPS);
#pragma unroll
        for (int j = 0; j < 4; ++j) { const f32x4 hv = v[j] * rstd * av[j] + bv[j];
            if (FINAL) *(f32x4*)(F.out + (size_t)row * 1024 + 256 * j + 4 * lane) = hv;
            else if (h8) *(unsigned*)((unsigned char*)H + (size_t)row * 1024 + 256 * j + 4 * lane) = pg8::pack4_fp8(hv.x * pg8::FP8_ACT, hv.y * pg8::FP8_ACT, hv.z * pg8::FP8_ACT, hv.w * pg8::FP8_ACT);
            else { v2u w; w.x = pk2(hv.x, hv.y); w.y = pk2(hv.z, hv.w); *(v2u*)(H + (size_t)row * 1024 + 256 * j + 4 * lane) = w;
                if (l & 1) *(unsigned*)(F.ws + WS_H8O + (size_t)row * 1024 + 256 * j + 4 * lane) = pg8::pack4_fp8(hv.x * pg8::FP8_ACT, hv.y * pg8::FP8_ACT, hv.z * pg8::FP8_ACT, hv.w * pg8::FP8_ACT); } } };
    XRow XA, XB, XC, XD; YBuf YA, YB, YC, YD;
    unsigned iA = load_inv(row0), iB = load_inv(row0 + 1), iC = load_inv(row0 + 2), iD = load_inv(row0 + 3);
    load_x(XA, row0); load_x(XB, row0 + 1);
    prefetch_y(YA, iA, row0); prefetch_y(YB, iB, row0 + 1);
    for (int rr = 0; rr < per; rr += 2) {
        const int row = row0 + rr;
        load_x(XC, row + 2); load_x(XD, row + 3);
        const unsigned iE = load_inv(row + 4), iF = load_inv(row + 5);
        if (rr + 2 < per) { prefetch_y(YC, iC, row + 2); prefetch_y(YD, iD, row + 3); }
        do_row(XA, iA, YA, row);
        do_row(XB, iB, YB, row + 1);
        XA = XC; XB = XD; YA = YC; YB = YD; iA = iC; iB = iD; iC = iE; iD = iF;
    }
}

template <int NPL>
__device__ __forceinline__ void select_wave(const float* aff, int cap, int lane, LAS unsigned short* idx_lds, float* gate, unsigned short* inv, unsigned short* gidx, int rowbase) {
    unsigned v[NPL];
#pragma unroll
    for (int q = 0; q < NPL / 4; ++q) { const v4u w = *(const v4u*)(aff + lane * NPL + 4 * q); v[4 * q] = w.x; v[4 * q + 1] = w.y; v[4 * q + 2] = w.z; v[4 * q + 3] = w.w; }
    unsigned T = 0;
    for (int bit = 30; bit >= 0; --bit) { const unsigned cand = T | (1u << bit); int cnt = 0;
#pragma unroll
        for (int k = 0; k < NPL; ++k) cnt += __popcll(__ballot(v[k] >= cand));
        if (cnt >= cap) T = cand; }
    int cg = 0, ce = 0;
#pragma unroll
    for (int k = 0; k < NPL; ++k) { cg += (v[k] > T) ? 1 : 0; ce += (v[k] == T) ? 1 : 0; }
    const int need = cap - wave_sum_i(cg);
    int er = wave_incl_scan(ce, lane) - ce; int cs = 0; unsigned selmask = 0;
#pragma unroll
    for (int k = 0; k < NPL; ++k) { bool sel = v[k] > T; if (v[k] == T) { sel = er < need; ++er; } selmask |= (sel ? 1u : 0u) << k; cs += sel ? 1 : 0; }
    int slot = wave_incl_scan(cs, lane) - cs;
#pragma unroll
    for (int k = 0; k < NPL; ++k) { const int t = lane * NPL + k;
        if ((selmask >> k) & 1u) { idx_lds[slot] = (unsigned short)t; gidx[slot] = (unsigned short)(rowbase + t); gate[slot] = __builtin_bit_cast(float, v[k]); inv[(size_t)t * 16] = (unsigned short)slot; ++slot; }
        else inv[(size_t)t * 16] = (unsigned short)0xffffu; }
}
__device__ __forceinline__ void select_phase(Frame& F, int l, int parts = 3) {
    LAS unsigned short* idxL = (LAS unsigned short*)F.lds;
    LAS unsigned short* idxC = idxL + 256;
    const float* aff = (const float*)(F.ws + WS_AFF); float* gate = (float*)(F.ws + WS_GATE); unsigned short* inv = (unsigned short*)(F.ws + WS_INV);
    const unsigned char* H8 = F.ws + WS_H; unsigned char* XS = F.ws + WS_O;
    unsigned short* gix = (unsigned short*)(F.ws + WS_IDX);
    const bool with_ctx = l < 3;
    for (int u = F.vcu; u < 256; u += F.G) {
        const int b = u >> 4, e = u & 15;
        if ((parts & 1) && F.wave == 0) select_wave<32>(aff + ((size_t)b * 16 + e) * 2048, CAPL, F.lane, idxL, gate + (size_t)e * XR_E + b * 256, inv + (size_t)(b * 2048) * 16 + e, gix + (size_t)e * XR_E + b * 256, b * 2048);
        if ((parts & 1) && F.wave == 1 && with_ctx) select_wave<4>(aff + 524288 + ((size_t)b * 16 + e) * 256, CAPC, F.lane, idxC, gate + (size_t)e * XR_E + 4096 + b * 32, inv + (size_t)(RL + b * 256) * 16 + e, gix + (size_t)e * XR_E + 4096 + b * 32, RL + b * 256);
        __syncthreads();
        if (parts & 2) {
#pragma unroll 1
        for (int r0 = F.wave * 32; r0 < F.wave * 32 + 32; r0 += 8) { v4u tmp[8];
#pragma unroll
            for (int q = 0; q < 8; ++q) tmp[q] = ((const v4u*)(H8 + (size_t)(b * 2048 + (int)idxL[r0 + q]) * 1024))[F.lane];
#pragma unroll
            for (int q = 0; q < 8; ++q) ((v4u*)(XS + (size_t)(e * XR_E + b * 256 + r0 + q) * 1024))[F.lane] = tmp[q]; }
        if (with_ctx) { v4u tmp[4];
#pragma unroll
            for (int q = 0; q < 4; ++q) tmp[q] = ((const v4u*)(H8 + (size_t)(RL + b * 256 + (int)idxC[F.wave * 4 + q]) * 1024))[F.lane];
#pragma unroll
            for (int q = 0; q < 4; ++q) ((v4u*)(XS + (size_t)(e * XR_E + 4096 + b * 32 + F.wave * 4 + q) * 1024))[F.lane] = tmp[q]; }
        }
        __syncthreads();
    }
}


namespace att {
constexpr int SHM_V = 64 * 128 * 2, SHM_K = 64 * 128 * 2;
constexpr int OFF_V = 0, OFF_K = 2 * SHM_V, OFF_WS = OFF_K + 2 * SHM_K, OFF_RPB = OFF_WS + 8 * 1024, OFF_Q = OFF_RPB, OFF_END = OFF_Q + 8 * 8192;
#define KSWZ(row, colB) ((row) * 256 + ((colB) ^ (((row) & 7) << 4)))
#define SBAR() __builtin_amdgcn_sched_barrier(0)
__device__ __forceinline__ int crow(int r, int hi) { return (r & 3) + 8 * (r >> 2) + 4 * hi; }
__device__ __forceinline__ unsigned cvtpk(float lo, float hi) { return pg8::cvt_pk_bf16(lo, hi); }
__device__ __forceinline__ int v_st(int k, int c) { const int kk = (k & ~0xC) | ((k & 4) << 1) | ((k & 8) >> 1); return ((kk >> 3) * 4 + (c >> 5)) * 512 + ((kk & 7) * 32 + (c & 31)) * 2; }
__device__ __forceinline__ int v_rd_base(int lane) { return ((lane & 3) << 3) | (((lane >> 2) & 3) << 6) | (((lane >> 4) & 1) << 5) | (((lane >> 5) & 1) << 8); }
constexpr int v_rd_off(int d0, int ks, int half) { return d0 * 512 + ks * 4096 + half * 2048; }
template <int OFF> __device__ __forceinline__ s16x4 tr_read(int vb) { s16x4 r; asm volatile("ds_read_b64_tr_b16 %0, %1 offset:%2" : "=&v"(r) : "v"(vb), "i"(OFF) : "memory"); return r; }
template <int D0> __device__ __forceinline__ void pv_one(f32x16& od, int vb, bf16x8 pa0, bf16x8 pa1, bf16x8 pa2, bf16x8 pa3) {
    const s16x4 l0 = tr_read<v_rd_off(D0, 0, 0)>(vb), h0 = tr_read<v_rd_off(D0, 0, 1)>(vb), l1 = tr_read<v_rd_off(D0, 1, 0)>(vb), h1 = tr_read<v_rd_off(D0, 1, 1)>(vb);
    const s16x4 l2 = tr_read<v_rd_off(D0, 2, 0)>(vb), h2 = tr_read<v_rd_off(D0, 2, 1)>(vb), l3 = tr_read<v_rd_off(D0, 3, 0)>(vb), h3 = tr_read<v_rd_off(D0, 3, 1)>(vb);
    asm volatile("s_waitcnt lgkmcnt(0)" ::: "memory"); SBAR();
#define PKV(L, H) (bf16x8){L[0], L[1], L[2], L[3], H[0], H[1], H[2], H[3]}
    __builtin_amdgcn_s_setprio(1);
    od = __builtin_amdgcn_mfma_f32_32x32x16_bf16(pa0, PKV(l0, h0), od, 0, 0, 0);
    od = __builtin_amdgcn_mfma_f32_32x32x16_bf16(pa1, PKV(l1, h1), od, 0, 0, 0);
    od = __builtin_amdgcn_mfma_f32_32x32x16_bf16(pa2, PKV(l2, h2), od, 0, 0, 0);
    od = __builtin_amdgcn_mfma_f32_32x32x16_bf16(pa3, PKV(l3, h3), od, 0, 0, 0);
    __builtin_amdgcn_s_setprio(0);
#undef PKV
}
template <int MAP, bool QLDS> __device__ __forceinline__ void qkt_map(f32x16& p0, f32x16& p1, const LAS char* Ks, const bf16x8* qr, const LAS char* ql, int r32, int hi) {
    p0 = f32x16{}; p1 = f32x16{};
#pragma unroll
    for (int d0 = 4 * MAP; d0 < 4 * MAP + 4; ++d0) { const int cb = (d0 * 16 + hi * 8) * 2;
        const bf16x8 b0 = *(const LAS bf16x8*)(Ks + KSWZ(r32, cb));
        const bf16x8 b1 = *(const LAS bf16x8*)(Ks + KSWZ(32 + r32, cb));
        const bf16x8 q = QLDS ? *(const LAS bf16x8*)(ql + d0 * 1024) : qr[QLDS ? 0 : d0];
        p0 = __builtin_amdgcn_mfma_f32_32x32x16_bf16(b0, q, p0, 0, 0, 0);
        p1 = __builtin_amdgcn_mfma_f32_32x32x16_bf16(b1, q, p1, 0, 0, 0); }
}
template <bool RAW>
__device__ __forceinline__ void sm_step(f32x16& p0, f32x16& p1, float& m, float& l, float& alpha, bf16x8& pa0, bf16x8& pa1, bf16x8& pa2, bf16x8& pa3) {
    constexpr float C = 0.125f * 1.4426950408889634f;
    float pmax = p0[0];
#pragma unroll
    for (int r = 1; r < 16; ++r) pmax = fmaxf(pmax, p0[r]);
#pragma unroll
    for (int r = 0; r < 16; ++r) pmax = fmaxf(pmax, p1[r]);
    { auto rr = __builtin_amdgcn_permlane32_swap(__float_as_uint(pmax), __float_as_uint(pmax), false, false); pmax = fmaxf(__uint_as_float(rr[0]), __uint_as_float(rr[1])); }
    float mn;
    if (__builtin_expect(__all(pmax - m <= (RAW ? 64.0f : 11.5416f)), 1)) { mn = m; alpha = 1.f; }
    else { mn = fmaxf(m, pmax); alpha = __builtin_amdgcn_exp2f(RAW ? (m - mn) * C : (m - mn)); m = mn; }
    const float mnc = RAW ? -mn * C : -mn;
    typedef float f2v __attribute__((ext_vector_type(2)));
    f2v psv = {0.f, 0.f}; const f2v cv = {C, C}, mv = {mnc, mnc};
#pragma unroll
    for (int r = 0; r < 16; r += 2) { f2v t = {p0[r], p0[r + 1]}; t = RAW ? __builtin_elementwise_fma(t, cv, mv) : t + mv; t.x = __builtin_amdgcn_exp2f(t.x); t.y = __builtin_amdgcn_exp2f(t.y); p0[r] = t.x; p0[r + 1] = t.y; psv += t; }
#pragma unroll
    for (int r = 0; r < 16; r += 2) { f2v t = {p1[r], p1[r + 1]}; t = RAW ? __builtin_elementwise_fma(t, cv, mv) : t + mv; t.x = __builtin_amdgcn_exp2f(t.x); t.y = __builtin_amdgcn_exp2f(t.y); p1[r] = t.x; p1[r + 1] = t.y; psv += t; }
    float ps = psv.x + psv.y;
    { auto rr = __builtin_amdgcn_permlane32_swap(__float_as_uint(ps), __float_as_uint(ps), false, false); ps = __uint_as_float(rr[0]) + __uint_as_float(rr[1]); }
    l = l * alpha + ps;
#define PK4(P, BASE, OUT) do { unsigned a0 = cvtpk(P[BASE + 0], P[BASE + 1]), a1 = cvtpk(P[BASE + 2], P[BASE + 3]);   \
    unsigned b0 = cvtpk(P[BASE + 4], P[BASE + 5]), b1 = cvtpk(P[BASE + 6], P[BASE + 7]);                              \
    auto r0 = __builtin_amdgcn_permlane32_swap(a0, b0, false, false); auto r1 = __builtin_amdgcn_permlane32_swap(a1, b1, false, false); \
    v4u w = {r0[0], r1[0], r0[1], r1[1]}; OUT = __builtin_bit_cast(bf16x8, w); } while (0)
    PK4(p0, 0, pa0); PK4(p0, 8, pa1); PK4(p1, 0, pa2); PK4(p1, 8, pa3);
#undef PK4
}

struct UnitDesc {
    int qrow0;
    int qcol, kcol, vcol, ocol;
    int nloc, loc_row0, ctx_row0;
    int na_local;
    int qr0, kr0;
    int rpb_off;
};

template <bool DIFF>
__device__ __forceinline__ void attn_unit(LAS unsigned char* lds, const bf16* __restrict__ P, bf16* __restrict__ Out, const UnitDesc U, const float* __restrict__ rpb,
                                          float lam, float oscale, const float* __restrict__ subln_g, int wid_in) {
    int lane_; asm volatile("v_mbcnt_lo_u32_b32 %0, -1, 0\n\tv_mbcnt_hi_u32_b32 %0, -1, %0" : "=v"(lane_));
    const int lane = lane_, wid = wid_in, tid = wid * 64 + lane, r32 = lane & 31, hi = lane >> 5;
    constexpr float L2E = 1.4426950408889634f, C = 0.125f * L2E;
    LAS char* V_lds = (LAS char*)lds + OFF_V; LAS char* K_lds = (LAS char*)lds + OFF_K;
    LAS float* wsc = (LAS float*)(lds + OFF_WS) + wid * 256;
    LAS float* rpbx = (LAS float*)(lds + OFF_RPB);
    if (!DIFF && U.na_local) {
        float tv_[8];
#pragma unroll
        for (int k_ = 0; k_ < 8; ++k_) { const int idx = tid + k_ * NTHR; const int hd = idx / 1920, rem = idx % 1920, dr = rem >> 7, x = rem & 127;
            tv_[k_] = (idx < 2 * 15 * 128 && x >= 48 && x <= 78) ? rpb[U.rpb_off + hd * 465 + dr * 31 + (x - 48)] * L2E : 0.f; }
#pragma unroll
        for (int k_ = 0; k_ < 8; ++k_) { const int idx = tid + k_ * NTHR; if (idx < 2 * 15 * 128) rpbx[idx] = tv_[k_]; }
    }
    bf16x8 qr[DIFF ? 1 : 8];
    const LAS char* ql = (const LAS char*)lds + OFF_Q + wid * 8192 + lane * 16;
    { const bf16* Qw = P + (size_t)(U.qrow0 + wid * 32 + r32) * LD_EVEN + U.qcol + hi * 8;
#pragma unroll
      for (int d0 = 0; d0 < 8; ++d0) { const bf16x8 q = *(const bf16x8*)(Qw + d0 * 16); if (DIFF) *(LAS bf16x8*)((LAS char*)lds + OFF_Q + wid * 8192 + lane * 16 + d0 * 1024) = q; else qr[DIFF ? 0 : d0] = q; } }
    unsigned gK[2], gV[2];
#pragma unroll
    for (int p = 0; p < 2; ++p) { const int o = (2 * wid + p) * 1024 + 16 * lane;
        { const int row = o >> 8, cb = (o & 255) ^ ((row & 7) << 4); gK[p] = (unsigned)(row * LD_EVEN + (cb >> 1)); }
        { const int sub = o >> 9, w = (o & 511) >> 1, kk = (sub >> 2) * 8 + (w >> 5), c = (sub & 3) * 32 + (w & 31), k = (kk & ~0xC) | ((kk & 4) << 1) | ((kk & 8) >> 1); gV[p] = (unsigned)(k * LD_EVEN + c); } }
    const int vb0 = (int)(uintptr_t)V_lds + v_rd_base(lane);
    const int ntiles = U.nloc + 4;
    const int qrw = U.qr0 + (wid >> 1), qc = 32 * (wid & 1) + r32;
    const int cst = min(max(qc - 8, 0), 48), rsw = min(max(qrw - 4, 0), 24);
    float m0 = -1e30f, l0 = 0.f, m1 = -1e30f, l1 = 0.f;
    f32x16 oa[4] = {}, ob[DIFF ? 4 : 1] = {};
#define TILE_ROW(j) ((j) < U.nloc ? U.loc_row0 + 64 * (j) : U.ctx_row0 + 64 * ((j) - U.nloc))
#define SDMA(j, b) do { const bf16* base = P + (size_t)TILE_ROW(j) * LD_EVEN; _Pragma("unroll") for (int p = 0; p < 2; ++p) { \
        __builtin_amdgcn_global_load_lds((const unsigned*)(base + U.kcol + gK[p]), (LAS unsigned*)(K_lds + (b) * SHM_K + (2 * wid + p) * 1024), 16, 0, 0); \
        __builtin_amdgcn_global_load_lds((const unsigned*)(base + U.vcol + gV[p]), (LAS unsigned*)(V_lds + (b) * SHM_V + (2 * wid + p) * 1024), 16, 0, 0); } } while (0)
#define RESC(acc, n0, n1, a, slot) do { if (__any((a) < 1.f)) { if (hi == 0) wsc[(slot) * 32 + r32] = (a); asm volatile("s_waitcnt lgkmcnt(0)" ::: "memory"); \
        _Pragma("unroll") for (int r = 0; r < 16; ++r) { const float al = wsc[(slot) * 32 + crow(r, hi)]; _Pragma("unroll") for (int d = (n0); d < (n1); ++d) acc[d][r] *= al; } } } while (0)
    SDMA(0, 0); VM_WAIT(); __syncthreads();
    for (int j = 0; j < ntiles; ++j) {
        const int buf = j & 1;
        if (j + 1 < ntiles) SDMA(j + 1, buf ^ 1);
        const bool local = j < U.nloc;
        bool active = true; int kr = 0;
        if (!DIFF && U.na_local && local) { kr = U.kr0 + j; active = (kr >= rsw) && (kr < rsw + 8); }
        if (active) {
            const LAS char* Kb = K_lds + buf * SHM_K; const int vb = vb0 + buf * SHM_V;
            f32x16 p0, p1; bf16x8 pa0, pa1, pa2, pa3; float alpha;
            qkt_map<0, DIFF>(p0, p1, Kb, qr, ql, r32, hi);
            if (!DIFF && U.na_local && local) {
                const LAS float* bp = rpbx + (kr - qrw + 7) * 128 + (63 - qc + 4 * hi); const int vbs = 4 * hi - cst;
#pragma unroll
                for (int r = 0; r < 16; ++r) { const int kc0 = (r & 3) + 8 * (r >> 2);
                    p0[r] = ((unsigned)(vbs + kc0) < 16u) ? fmaf(p0[r], C, bp[kc0]) : -1e30f;
                    p1[r] = ((unsigned)(vbs + kc0 + 32) < 16u) ? fmaf(p1[r], C, bp[kc0 + 32]) : -1e30f; }
            } else if (!DIFF) {
#pragma unroll
                for (int r = 0; r < 16; ++r) { p0[r] *= C; p1[r] *= C; }
            }
            sm_step<DIFF>(p0, p1, m0, l0, alpha, pa0, pa1, pa2, pa3);
            if (DIFF) { RESC(oa, 0, 4, alpha, 0); pv_one<0>(oa[0], vb, pa0, pa1, pa2, pa3); pv_one<1>(oa[1], vb, pa0, pa1, pa2, pa3); pv_one<2>(oa[2], vb, pa0, pa1, pa2, pa3); pv_one<3>(oa[3], vb, pa0, pa1, pa2, pa3); }
            else      { RESC(oa, 0, 2, alpha, 0); pv_one<0>(oa[0], vb, pa0, pa1, pa2, pa3); pv_one<1>(oa[1], vb, pa0, pa1, pa2, pa3); }
            qkt_map<1, DIFF>(p0, p1, Kb, qr, ql, r32, hi);
            if (!DIFF && U.na_local && local) {
                const LAS float* bp = rpbx + 1920 + (kr - qrw + 7) * 128 + (63 - qc + 4 * hi); const int vbs = 4 * hi - cst;
#pragma unroll
                for (int r = 0; r < 16; ++r) { const int kc0 = (r & 3) + 8 * (r >> 2);
                    p0[r] = ((unsigned)(vbs + kc0) < 16u) ? fmaf(p0[r], C, bp[kc0]) : -1e30f;
                    p1[r] = ((unsigned)(vbs + kc0 + 32) < 16u) ? fmaf(p1[r], C, bp[kc0 + 32]) : -1e30f; }
            } else if (!DIFF) {
#pragma unroll
                for (int r = 0; r < 16; ++r) { p0[r] *= C; p1[r] *= C; }
            }
            sm_step<DIFF>(p0, p1, m1, l1, alpha, pa0, pa1, pa2, pa3);
            if (DIFF) { RESC(ob, 0, 4, alpha, 1); pv_one<0>(ob[0], vb, pa0, pa1, pa2, pa3); pv_one<1>(ob[1], vb, pa0, pa1, pa2, pa3); pv_one<2>(ob[2], vb, pa0, pa1, pa2, pa3); pv_one<3>(ob[3], vb, pa0, pa1, pa2, pa3); }
            else      { RESC(oa, 2, 4, alpha, 1); pv_one<2>(oa[2], vb, pa0, pa1, pa2, pa3); pv_one<3>(oa[3], vb, pa0, pa1, pa2, pa3); }
        }
        VM_WAIT(); __syncthreads();
    }
    if (hi == 0) { wsc[r32] = 1.0f / l0; wsc[32 + r32] = 1.0f / l1; }
    asm volatile("s_waitcnt lgkmcnt(0)" ::: "memory");
    bf16* Ow = Out + (size_t)(U.qrow0 + wid * 32) * 1024 + U.ocol;
    if (DIFF) {
        float gl[4];
#pragma unroll
        for (int d0 = 0; d0 < 4; ++d0) gl[d0] = subln_g[d0 * 32 + r32] * oscale;
#pragma unroll
        for (int r = 0; r < 16; ++r) { const int q = crow(r, hi); const float ra = wsc[q], rb = wsc[32 + q] * lam; float v[4], ss = 0.f;
#pragma unroll
            for (int d0 = 0; d0 < 4; ++d0) { v[d0] = oa[d0][r] * ra - ob[d0][r] * rb; ss += v[d0] * v[d0]; }
#pragma unroll
            for (int o = 1; o < 32; o <<= 1) ss += __shfl_xor(ss, o);
            const float rstd = 1.0f / sqrtf(ss * (1.0f / 128.0f) + NORM_EPS);
#pragma unroll
            for (int d0 = 0; d0 < 4; ++d0) Ow[(size_t)q * 1024 + d0 * 32 + r32] = (bf16)f2bf(v[d0] * rstd * gl[d0]); }
    } else {
#pragma unroll
        for (int r = 0; r < 16; ++r) { const int q = crow(r, hi); const float ra = wsc[q], rb = wsc[32 + q];
            Ow[(size_t)q * 1024 + r32] = (bf16)f2bf(oa[0][r] * ra); Ow[(size_t)q * 1024 + 32 + r32] = (bf16)f2bf(oa[1][r] * ra);
            Ow[(size_t)q * 1024 + 64 + r32] = (bf16)f2bf(oa[2][r] * rb); Ow[(size_t)q * 1024 + 96 + r32] = (bf16)f2bf(oa[3][r] * rb); }
    }
    __syncthreads();
#undef TILE_ROW
#undef SDMA
#undef RESC
}

__device__ __forceinline__ void attn_phase(Frame& F, int l) {
    const int ev = l >> 1;
    const bf16* P = (const bf16*)(F.ws + WS_P); bf16* O = (bf16*)(F.ws + WS_O);
    const float lam_init = 0.8f - 0.6f * expf(-0.3f * (float)l);
    const float* lv = F.diff_lambda + ev * 256;
    const float s01 = wave_sum(lv[F.lane] * lv[64 + F.lane]), s23 = wave_sum(lv[128 + F.lane] * lv[192 + F.lane]);
    const float lam = expf(s01) - expf(s23) + lam_init;
    const float* subln = F.diff_subln_g + ev * 128;
    const float* rpb = F.na_rpb + (size_t)ev * 8 * 465;
#pragma unroll 1
    for (int i = 0; i < 3; ++i) {
        UnitDesc U; U.na_local = 0; U.qr0 = 0; U.kr0 = 0; U.rpb_off = 0;
        if (i < 2) { const int u = F.vcu + 256 * i; if (u >= 512) break; const int b = u >> 5, h = (u >> 3) & 3, qb = u & 7;
            U.qrow0 = b * 2048 + qb * 256; U.nloc = 32; U.loc_row0 = b * 2048; U.ctx_row0 = RL + b * 256; U.qcol = 512 + h * 128; U.kcol = 2048 + h * 128; U.vcol = 2560 + h * 128; U.ocol = 512 + h * 128; }
        else { const int u = F.vcu; if (u >= 64) break; const int b = u >> 2, h = u & 3;
            U.qrow0 = RL + b * 256; U.nloc = 0; U.loc_row0 = 0; U.ctx_row0 = RL + b * 256; U.qcol = 512 + h * 128; U.kcol = 2048 + h * 128; U.vcol = 2560 + h * 128; U.ocol = 512 + h * 128; }
        attn_unit<true>(F.lds, P, O, U, rpb, lam, 1.0f - lam_init, subln, F.wave);
    }
#pragma unroll 1
    for (int i = 0; i < 3; ++i) {
        UnitDesc U;
        if (i < 2) { const int u = F.vcu + 256 * i; if (u >= 512) break; const int b = u >> 5, hp = (u >> 3) & 3, g = u & 7;
            const int krlo = min(max(4 * g - 4, 0), 24), krhi = min(max(4 * g + 3 - 4, 0), 24) + 7;
            U.qrow0 = b * 2048 + g * 256; U.nloc = krhi - krlo + 1; U.loc_row0 = b * 2048 + krlo * 64; U.ctx_row0 = RL + b * 256; U.qcol = hp * 128; U.kcol = 1024 + hp * 128; U.vcol = 1536 + hp * 128; U.ocol = hp * 128;
            U.na_local = 1; U.qr0 = 4 * g; U.kr0 = krlo; U.rpb_off = hp * 2 * 465; }
        else { const int u = F.vcu - 64; if (u < 0 || u >= 64) break; const int b = u >> 2, hp = u & 3;
            U.qrow0 = RL + b * 256; U.nloc = 0; U.loc_row0 = 0; U.ctx_row0 = RL + b * 256; U.qcol = hp * 128; U.kcol = 1024 + hp * 128; U.vcol = 1536 + hp * 128; U.ocol = hp * 128;
            U.na_local = 0; U.qr0 = 0; U.kr0 = 0; U.rpb_off = 0; }
        attn_unit<false>(F.lds, P, O, U, rpb, 0.f, 1.f, subln, F.wave);
    }
}
}


namespace scan {
typedef float f4 __attribute__((ext_vector_type(4)));
constexpr int QD_STRIDE = 272, KT_STRIDE = 80;
constexpr int OFF_QD = 0, OFF_KD = OFF_QD + 32 * QD_STRIDE, OFF_KLT = OFF_KD + 32 * QD_STRIDE, OFF_VT = OFF_KLT + 128 * KT_STRIDE, OFF_D = OFF_VT + 128 * KT_STRIDE, OFF_PT = OFF_D + 512, BUF_BYTES = OFF_PT + 2048;
__device__ __forceinline__ bf16x8 pack8(f4 a, f4 b) { v4u w; w.x = pg8::cvt_pk_bf16(a[0], a[1]); w.y = pg8::cvt_pk_bf16(a[2], a[3]); w.z = pg8::cvt_pk_bf16(b[0], b[1]); w.w = pg8::cvt_pk_bf16(b[2], b[3]); return __builtin_bit_cast(bf16x8, w); }
__device__ __forceinline__ bf16x8 ld2x8(const LAS char* p0, const LAS char* p1) { const v2u a = *(const LAS v2u*)p0, b = *(const LAS v2u*)p1; v4u w = {a.x, a.y, b.x, b.y}; return __builtin_bit_cast(bf16x8, w); }

__device__ __forceinline__ void scan_phase(Frame& F, int l) {
    const bf16* P = (const bf16*)(F.ws + WS_P);
    const int lane = F.lane, wid = F.wave, ln = lane & 15, g = lane >> 4;
    const bool prep = wid < 4; const int mw = wid - 4;
    const int d0 = 32 * (wid & 3) + 2 * (lane & 15), tg = lane >> 4;
    for (int u = F.vcu; u < 256; u += F.G) {
        const int b = u >> 4, h = (u >> 1) & 7, dir = u & 1, sgn = dir ? -1 : 1;
        bf16* Od = (bf16*)(F.ws + (dir ? WS_OB : WS_OF));
        float lbv[2];
#pragma unroll
        for (int cc = 0; cc < 2; ++cc) { const float* lg = F.rec_lb_logits + (size_t)dir * 4 * 1024 + h * 128 + d0 + cc; const float a0 = lg[0], a1 = lg[1024], a2 = lg[2048], a3 = lg[3072];
          const float mx = fmaxf(fmaxf(a0, a1), fmaxf(a2, a3)); const float e0 = expf(a0 - mx), e1 = expf(a1 - mx), e2 = expf(a2 - mx), e3 = expf(a3 - mx); const float inv = 1.0f / (e0 + e1 + e2 + e3);
          lbv[cc] = (l == 1) ? e1 * inv : (e1 + e2 + e3) * inv; }
        const float lb0 = lbv[0], lb1 = lbv[1], om0 = 1.0f - lb0, om1 = 1.0f - lb1;
        const int qcol = h * 128 + d0, fcol = (dir ? 2048 : 1024) + h * 128 + d0, vcol = 3072 + h * 128 + d0;
        f4 st[2][8];
#pragma unroll
        for (int s2 = 0; s2 < 2; ++s2)
#pragma unroll
            for (int k = 0; k < 8; ++k) st[s2][k] = (f4){0.f, 0.f, 0.f, 0.f};
        const int nchunks = 8 + 64;
        unsigned rq[8], rf[8], rv[8];
#define SROW0(c) ((c) < 8 ? (RL + b * 256 + (dir ? 255 - 32 * (c) : 32 * (c))) : (b * 2048 + (dir ? 2047 - 32 * ((c) - 8) : 32 * ((c) - 8))))
#define SLOADC(c) do { const unsigned rb_ = (unsigned)(SROW0(c) + sgn * 8 * tg) * (unsigned)(LD_ODD * 2); const unsigned rs_ = (unsigned)(sgn * LD_ODD * 2);     \
            _Pragma("unroll") for (int k = 0; k < 8; ++k) { const unsigned ro = rb_ + (unsigned)k * rs_; \
            rq[k] = *(const unsigned*)((const char*)P + (ro + 2u * (unsigned)qcol)); rf[k] = *(const unsigned*)((const char*)P + (ro + 2u * (unsigned)fcol)); rv[k] = *(const unsigned*)((const char*)P + (ro + 2u * (unsigned)vcol)); } } while (0)
        if (prep) SLOADC(0);
        for (int it = 0; it <= nchunks; ++it) {
            if (prep) {
                if (it < nchunks) {
                    const int c = it; LAS char* buf = (LAS char*)F.lds + (c & 1) * BUF_BYTES;
                    float kk0[8], kk1[8], lp0[8], lp1[8]; unsigned qp[8], vp[8];
                    { float run0 = 1.0f, run1 = 1.0f;
#pragma unroll
                      for (int k = 0; k < 8; ++k) { const float sg0 = bflo(rf[k]), sg1 = bfhi(rf[k]);
                          kk0[k] = om0 * (1.0f - sg0); kk1[k] = om1 * (1.0f - sg1); run0 *= lb0 + om0 * sg0; run1 *= lb1 + om1 * sg1; lp0[k] = run0; lp1[k] = run1; qp[k] = rq[k]; vp[k] = rv[k]; } }
                    if (c + 1 < nchunks) SLOADC(c + 1);
                    const float ta0 = __shfl_xor(lp0[7], 16), ta1 = __shfl_xor(lp1[7], 16); const float pp0 = lp0[7] * ta0, pp1 = lp1[7] * ta1;
                    const float pq0 = __shfl_xor(pp0, 32), pq1 = __shfl_xor(pp1, 32); const float plast0 = pp0 * pq0, plast1 = pp1 * pq1;
                    const float po0 = ((tg & 2) ? pq0 : 1.0f) * ((tg & 1) ? ta0 : 1.0f), po1 = ((tg & 2) ? pq1 : 1.0f) * ((tg & 1) ? ta1 : 1.0f);
                    float kl0[8], kl1[8];
#pragma unroll
                    for (int k = 0; k < 8; ++k) { const float p0 = po0 * lp0[k], p1 = po1 * lp1[k]; const float kd0 = kk0[k] * __builtin_amdgcn_rcpf(p0), kd1 = kk1[k] * __builtin_amdgcn_rcpf(p1);
                        kl0[k] = kd0 * plast0; kl1[k] = kd1 * plast1;
                        *(LAS unsigned*)(buf + OFF_QD + (8 * tg + k) * QD_STRIDE + 2 * d0) = pk2(bflo(qp[k]) * p0, bfhi(qp[k]) * p1);
                        *(LAS unsigned*)(buf + OFF_KD + (8 * tg + k) * QD_STRIDE + 2 * d0) = pk2(kd0, kd1); }
                    *(LAS v4u*)(buf + OFF_KLT + d0 * KT_STRIDE + 16 * tg) = (v4u){pk2(kl0[0], kl0[1]), pk2(kl0[2], kl0[3]), pk2(kl0[4], kl0[5]), pk2(kl0[6], kl0[7])};
                    *(LAS v4u*)(buf + OFF_KLT + (d0 + 1) * KT_STRIDE + 16 * tg) = (v4u){pk2(kl1[0], kl1[1]), pk2(kl1[2], kl1[3]), pk2(kl1[4], kl1[5]), pk2(kl1[6], kl1[7])};
                    *(LAS v4u*)(buf + OFF_VT + d0 * KT_STRIDE + 16 * tg) = (v4u){(vp[0] & 0xffffu) | (vp[1] << 16), (vp[2] & 0xffffu) | (vp[3] << 16), (vp[4] & 0xffffu) | (vp[5] << 16), (vp[6] & 0xffffu) | (vp[7] << 16)};
                    *(LAS v4u*)(buf + OFF_VT + (d0 + 1) * KT_STRIDE + 16 * tg) = (v4u){(vp[0] >> 16) | (vp[1] & 0xffff0000u), (vp[2] >> 16) | (vp[3] & 0xffff0000u), (vp[4] >> 16) | (vp[5] & 0xffff0000u), (vp[6] >> 16) | (vp[7] & 0xffff0000u)};
                    if (tg == 0) *(LAS v2u*)(buf + OFF_D + 4 * d0) = (v2u){__float_as_uint(plast0), __float_as_uint(plast1)};
                }
            } else if (it >= 1) {
                const int c = it - 1; const LAS char* buf = (const LAS char*)F.lds + (c & 1) * BUF_BYTES;
                const bool has_q = (c >= 8) || (l == 1);
                const LAS char* qd = buf + OFF_QD; const LAS char* kdp = buf + OFF_KD; const LAS char* klt = buf + OFF_KLT;
                const LAS char* vt0 = buf + OFF_VT + (32 * mw + ln) * KT_STRIDE; const LAS char* vt1 = vt0 + 16 * KT_STRIDE;
                if (has_q) {
                    f4 at00 = {0.f, 0.f, 0.f, 0.f}, at01 = at00, at11 = at00;
#pragma unroll
                    for (int ks = 0; ks < 4; ++ks) {
                        const bf16x8 kd0 = *(const LAS bf16x8*)(kdp + ln * QD_STRIDE + (32 * ks + 8 * g) * 2), kd1 = *(const LAS bf16x8*)(kdp + (16 + ln) * QD_STRIDE + (32 * ks + 8 * g) * 2);
                        const bf16x8 q0 = *(const LAS bf16x8*)(qd + ln * QD_STRIDE + (32 * ks + 8 * g) * 2), q1 = *(const LAS bf16x8*)(qd + (16 + ln) * QD_STRIDE + (32 * ks + 8 * g) * 2);
                        at00 = __builtin_amdgcn_mfma_f32_16x16x32_bf16(kd0, q0, at00, 0, 0, 0);
                        at01 = __builtin_amdgcn_mfma_f32_16x16x32_bf16(kd0, q1, at01, 0, 0, 0);
                        at11 = __builtin_amdgcn_mfma_f32_16x16x32_bf16(kd1, q1, at11, 0, 0, 0); }
#pragma unroll
                    for (int j = 0; j < 4; ++j) { const bool keep = (4 * g + j) <= ln; at00[j] = keep ? at00[j] : 0.f; at11[j] = keep ? at11[j] : 0.f; }
                    const bf16x8 a0p = pack8(at00, (f4){0.f, 0.f, 0.f, 0.f}), a1p = pack8(at01, at11);
                    const bf16x8 vp0 = ld2x8(vt0 + 8 * g, vt0 + 32 + 8 * g), vp1 = ld2x8(vt1 + 8 * g, vt1 + 32 + 8 * g);
                    f4 o00 = {0.f, 0.f, 0.f, 0.f}, o01 = o00, o10 = o00, o11 = o00;
                    o00 = __builtin_amdgcn_mfma_f32_16x16x32_bf16(a0p, vp0, o00, 0, 0, 0); o01 = __builtin_amdgcn_mfma_f32_16x16x32_bf16(a1p, vp0, o01, 0, 0, 0);
                    o10 = __builtin_amdgcn_mfma_f32_16x16x32_bf16(a0p, vp1, o10, 0, 0, 0); o11 = __builtin_amdgcn_mfma_f32_16x16x32_bf16(a1p, vp1, o11, 0, 0, 0);
#pragma unroll
                    for (int ks = 0; ks < 4; ++ks) {
                        const bf16x8 qa0 = ld2x8(qd + ln * QD_STRIDE + (32 * ks + 4 * g) * 2, qd + ln * QD_STRIDE + (32 * ks + 16 + 4 * g) * 2);
                        const bf16x8 qa1 = ld2x8(qd + (16 + ln) * QD_STRIDE + (32 * ks + 4 * g) * 2, qd + (16 + ln) * QD_STRIDE + (32 * ks + 16 + 4 * g) * 2);
                        const bf16x8 sb0 = pack8(st[0][2 * ks], st[0][2 * ks + 1]), sb1 = pack8(st[1][2 * ks], st[1][2 * ks + 1]);
                        o00 = __builtin_amdgcn_mfma_f32_16x16x32_bf16(qa0, sb0, o00, 0, 0, 0); o01 = __builtin_amdgcn_mfma_f32_16x16x32_bf16(qa1, sb0, o01, 0, 0, 0);
                        o10 = __builtin_amdgcn_mfma_f32_16x16x32_bf16(qa0, sb1, o10, 0, 0, 0); o11 = __builtin_amdgcn_mfma_f32_16x16x32_bf16(qa1, sb1, o11, 0, 0, 0); }
                    const int oc = h * 128 + 32 * mw + ln;
                    char* ob0 = (char*)Od + ((unsigned)(SROW0(c) + sgn * 4 * g) * 2048u + 2u * (unsigned)oc); const int ost = sgn * 2048;
#pragma unroll
                    for (int j = 0; j < 4; ++j) { bf16* r0 = (bf16*)(ob0 + j * ost); bf16* r1 = (bf16*)(ob0 + (16 + j) * ost);
                        r0[0] = (bf16)f2bf(o00[j]); r0[16] = (bf16)f2bf(o10[j]); r1[0] = (bf16)f2bf(o01[j]); r1[16] = (bf16)f2bf(o11[j]); }
                }
                { const bf16x8 vn0 = *(const LAS bf16x8*)(vt0 + 16 * g), vn1 = *(const LAS bf16x8*)(vt1 + 16 * g);
#pragma unroll
                  for (int kt = 0; kt < 8; ++kt) { const f4 dd = *(const LAS f4*)(buf + OFF_D + (16 * kt + 4 * g) * 4);
                      const bf16x8 ka = *(const LAS bf16x8*)(klt + (16 * kt + ln) * KT_STRIDE + 16 * g);
                      st[0][kt] = __builtin_amdgcn_mfma_f32_16x16x32_bf16(ka, vn0, st[0][kt] * dd, 0, 0, 0);
                      st[1][kt] = __builtin_amdgcn_mfma_f32_16x16x32_bf16(ka, vn1, st[1][kt] * dd, 0, 0, 0); } }
            }
            asm volatile("s_waitcnt lgkmcnt(0)" ::: "memory"); __builtin_amdgcn_s_barrier(); asm volatile("" ::: "memory");
        }
        __syncthreads();
#undef SROW0
#undef SLOADC
    }
}

__device__ __forceinline__ void scan_combine_phase(Frame& F, int l) {
    const int nrows = (l == 3) ? RL : RT, per = nrows / (F.G * NWAVES), gw = F.vcu * NWAVES + F.wave, lane = F.lane;
    const bf16* OFp = (const bf16*)(F.ws + WS_OF); const bf16* OBp = (const bf16*)(F.ws + WS_OB); const bf16* P = (const bf16*)(F.ws + WS_P); bf16* O = (bf16*)(F.ws + WS_O);
    const float* gn = F.rec_gnorm_g + (size_t)(l >> 1) * 128;
    f32x4 gv[4];
#pragma unroll
    for (int j = 0; j < 4; ++j) gv[j] = *(const f32x4*)(gn + ((256 * j + 4 * lane) & 127));
    v2u na[4], nb[4], ng[4];
#define CLOAD(r) do { _Pragma("unroll") for (int j = 0; j < 4; ++j) { const int col = 256 * j + 4 * lane; na[j] = *(const v2u*)(OFp + (size_t)(r) * 1024 + col); nb[j] = *(const v2u*)(OBp + (size_t)(r) * 1024 + col); ng[j] = *(const v2u*)(P + (size_t)(r) * LD_ODD + 4096 + col); } } while (0)
    CLOAD(gw * per);
    for (int rr = 0; rr < per; ++rr) {
        const int row = gw * per + rr;
        v2u ca[4], cb[4], cg[4];
#pragma unroll
        for (int j = 0; j < 4; ++j) { ca[j] = na[j]; cb[j] = nb[j]; cg[j] = ng[j]; }
        if (rr + 1 < per) CLOAD(row + 1);
        f32x4 v[4]; float ss[4];
#pragma unroll
        for (int j = 0; j < 4; ++j) { const v2u a = ca[j], b2 = cb[j];
            v[j] = (f32x4){bflo(a.x) + bflo(b2.x), bfhi(a.x) + bfhi(b2.x), bflo(a.y) + bflo(b2.y), bfhi(a.y) + bfhi(b2.y)};
            ss[j] = (v[j].x * v[j].x + v[j].y * v[j].y) + (v[j].z * v[j].z + v[j].w * v[j].w); }
#pragma unroll
        for (int j = 0; j < 4; ++j) ss[j] += lx1(ss[j]);
#pragma unroll
        for (int j = 0; j < 4; ++j) ss[j] += lx2(ss[j]);
#pragma unroll
        for (int j = 0; j < 4; ++j) ss[j] += lx4(ss[j]);
#pragma unroll
        for (int j = 0; j < 4; ++j) ss[j] += lx8(ss[j]);
#pragma unroll
        for (int j = 0; j < 4; ++j) ss[j] = sw16sum(ss[j], ss[j]);
#pragma unroll
        for (int j = 0; j < 4; ++j) { const int col = 256 * j + 4 * lane; const v2u gg = cg[j];
            const float rstd = 1.0f / sqrtf(ss[j] * (1.0f / 128.0f) + NORM_EPS);
            const f32x4 sg = (f32x4){bflo(gg.x), bfhi(gg.x), bflo(gg.y), bfhi(gg.y)};
            const f32x4 r = v[j] * rstd * gv[j] * sg; v2u w; w.x = pk2(r.x, r.y); w.y = pk2(r.z, r.w);
            *(v2u*)(O + (size_t)row * 1024 + col) = w; }
    }
#undef CLOAD
}
}


constexpr int NPH = 38;
#ifndef DBG_STOP
#define DBG_STOP 37
#endif
#ifndef DBG_FINAL_LP
#define DBG_FINAL_LP 3
#endif
#ifndef DBG_FINAL_XIN
#define DBG_FINAL_XIN 0
#endif
#ifndef REP_P0
#define REP_P0 1
#define REP_INP 1
#define REP_ATT 1
#define REP_SCAN 1
#define REP_N1 1
#define REP_SEL 1
#define XTRA_BAR 0
#define SEL_EXTRA 1
#define REP_G1 1
#define REP_G2 1
#define REP_FIN 1
#endif
#ifndef MK_ONE_LAUNCH
#define MK_ONE_LAUNCH 1
#endif
struct Args { const float* in[21]; float* out; unsigned char* ws; int ph_lo, ph_hi; };
__global__ void __launch_bounds__(NTHR, 2) fwd_kernel(Args args) {
    extern __shared__ __attribute__((aligned(16))) unsigned char lds_raw[];
    Frame F;
    F.lds = (LAS unsigned char*)lds_raw;
    const int wave0 = __builtin_amdgcn_readfirstlane((int)threadIdx.x >> 6);
    F.tid = threadIdx.x; F.lane = F.tid & 63; F.wave = wave0;
    const int G0 = gridDim.x; F.G = G0; const int bx0 = blockIdx.x; const int vcu0 = (F.G % 8 == 0) ? (bx0 % 8) * (F.G / 8) + bx0 / 8 : bx0; F.vcu = vcu0; int bx = bx0, wv = 0;
    F.x_in = (const float*)(GAS const float*)args.in[0]; F.c_in = (const float*)(GAS const float*)args.in[1]; F.ctx_in = (const float*)(GAS const float*)args.in[2]; F.cctx_in = (const float*)(GAS const float*)args.in[3]; F.w_mod = (const float*)(GAS const float*)args.in[4]; F.b_mod = (const float*)(GAS const float*)args.in[5]; F.norm_g = (const float*)(GAS const float*)args.in[6]; F.att_w_in = (const float*)(GAS const float*)args.in[7]; F.att_w_out = (const float*)(GAS const float*)args.in[8];
    F.na_rpb = (const float*)(GAS const float*)args.in[9]; F.diff_lambda = (const float*)(GAS const float*)args.in[10]; F.diff_subln_g = (const float*)(GAS const float*)args.in[11]; F.rec_w_in = (const float*)(GAS const float*)args.in[12]; F.rec_w_out = (const float*)(GAS const float*)args.in[13]; F.rec_lb_logits = (const float*)(GAS const float*)args.in[14]; F.rec_gnorm_g = (const float*)(GAS const float*)args.in[15];
    F.moe_router = (const float*)(GAS const float*)args.in[16]; F.moe_w_gate = (const float*)(GAS const float*)args.in[17]; F.moe_w_up = (const float*)(GAS const float*)args.in[18]; F.moe_w_down = (const float*)(GAS const float*)args.in[19]; F.final_g = (const float*)(GAS const float*)args.in[20];
    F.out = (float*)(GAS float*)args.out; F.ws = (unsigned char*)(GAS unsigned char*)args.ws;
    volatile LAS unsigned* MISC = (volatile LAS unsigned*)(F.lds + MISC_OFF);
    if (F.tid < 32) MISC[F.tid] = 0u;
    __syncthreads();
    const int lo = args.ph_lo, hi = args.ph_hi;
    XcdBarrier bar; bar.bar = (unsigned*)(F.ws + WS_CTL) + CW_BAR; bar.x = 0; bar.st = nullptr;
    if (MK_ONE_LAUNCH || hi - lo > 1) bar = xcd_barrier_post((unsigned*)(F.ws + WS_CTL) + CW_BAR, MISC + 8);
#if MK_ONE_LAUNCH
#define IN(p) true
#else
#define IN(p) (lo <= (p) && (p) < hi)
#endif
#define REFRESH() do { int l_; asm volatile("v_mbcnt_lo_u32_b32 %0, -1, 0\n\tv_mbcnt_hi_u32_b32 %0, -1, %0" : "=v"(l_)); int w_ = wave0, v_ = vcu0, b_ = bx0, g_ = G0; GAS unsigned char* ws_ = (GAS unsigned char*)args.ws; asm volatile("" : "+s"(w_), "+s"(v_), "+s"(b_), "+s"(g_), "+s"(ws_)); \
        F.lane = l_; F.wave = w_; F.tid = w_ * 64 + l_; F.vcu = v_; F.G = g_; F.ws = (unsigned char*)ws_; bx = b_; wv = w_; } while (0)
#define BARRIER() do { unsigned x_ = bar.x; unsigned* b_ = bar.bar; asm volatile("" : "+s"(x_), "+s"(b_)); XcdBarrier bb_; bb_.bar = b_; bb_.x = x_; bb_.st = bar.st; xcd_barrier(bb_); } while (0)
#define SEAM(p) do { if (IN(p) && IN((p) + 1)) { BARRIER(); for (int xb_ = 0; xb_ < XTRA_BAR; ++xb_) BARRIER(); } } while (0)
#define REPEAT(n, ...) do { for (int rep_ = 0; rep_ < (n); ++rep_) { __VA_ARGS__; if (rep_ + 1 < (n)) BARRIER(); } } while (0)
#define H ((bf16*)(F.ws + WS_H))
#define P ((bf16*)(F.ws + WS_P))
#define O ((bf16*)(F.ws + WS_O))
#define X ((bf16*)(F.ws + WS_X))
#define mod ((const float*)(F.ws + WS_MOD))

    if (IN(0)) REPEAT(REP_P0, { REFRESH(); p0_prologue(F); VM_WAIT(); __syncthreads(); });
    SEAM(0);
#pragma unroll 1
    for (int l = 0; l < DEPTH; ++l) {
        const int pb = 1 + 9 * l; const bool odd = (l & 1) != 0; const int ev = l >> 1;
        if (IN(pb + 0)) { REFRESH(); if (l == 0) norm_phase<0>(F, l); else combine_norm_phase<false>(F, l, l - 1); }
        SEAM(pb + 0);
        if (IN(pb + 1)) REPEAT(REP_INP, { REFRESH();
            if (!odd) { pg8::Gemm g{H, (const bf16*)(F.ws + WS_WATT_IN + (size_t)ev * 3072 * 1024 * (IN8E ? 1 : 2)), RT, 3072, IN8E ? 512 : 1024}; pg8::RectOrder S; S.init(144, 12, 0, 0, 0, 0, 0, 0, F.G, bx);
                pg8::EpiEvenIn<IN8E> E{P}; pg8::gemm_phase<pg8::EpiEvenIn<IN8E>, pg8::RectOrder, true, true, IN8E>(F.lds, g, S, E, wv); }
            else {
                { pg8::Gemm g{H, (const bf16*)(F.ws + WS_WREC_IN) + (size_t)ev * 5120 * 1024, RT, 5120, 1024}; pg8::Rect3Order S;
                  if (l == 1) S.init(144, 4, 0, 0, 144, 8, 0, 12, 0, 0, 0, 0, F.G, bx); else S.init(128, 4, 0, 0, 144, 4, 0, 12, 128, 4, 0, 16, F.G, bx);
                  pg8::EpiOddIn<false> E{P, 0}; pg8::gemm_phase<pg8::EpiOddIn<false>, pg8::Rect3Order, true, true>(F.lds, g, S, E, wv); }
                VM_WAIT(); __syncthreads(); REFRESH();
                { pg8::Gemm g{(const bf16*)(F.ws + WS_H8O), (const bf16*)(F.ws + WS_WREC_F8 + (size_t)ev * 2048 * 1024), RT, 2048, 512}; pg8::RectOrder S; S.init(144, 8, 0, 0, 0, 0, 0, 0, F.G, (bx + 128) & 255);
                  pg8::EpiOddIn<true> E{P, 4}; pg8::gemm_phase<pg8::EpiOddIn<true>, pg8::RectOrder, true, true, true>(F.lds, g, S, E, wv); } }
            tail_convert(F, l, 0, bx);
        });
        SEAM(pb + 1);
        if (IN(pb + 2)) REPEAT(odd ? REP_SCAN : REP_ATT, { REFRESH(); if (!odd) { att::attn_phase(F, l); REFRESH(); tail_convert(F, l, 4, F.vcu); } else scan::scan_phase(F, l); });
        SEAM(pb + 2);
        if (IN(pb + 3) && odd) { REFRESH(); scan::scan_combine_phase(F, l); }
        if (odd) SEAM(pb + 3);
        if (IN(pb + 4)) { REFRESH();
            pg8::Gemm g{O, (const bf16*)(F.ws + (odd ? WS_WREC_OUT : WS_WATT_OUT)) + (size_t)ev * 1024 * 1024, RT, 1024, 1024}; pg8::RectOrder S; S.init(l < 3 ? 144 : 128, 4, 0, 0, 0, 0, 0, 0, F.G, bx);
            pg8::EpiOutRes E{F.x_in, F.ctx_in, X, mod + (size_t)l * 17 * 6144 + 2 * 1024, l == 0};
            pg8::gemm_phase<pg8::EpiOutRes, pg8::RectOrder, true, true>(F.lds, g, S, E, wv);
            tail_convert(F, l, 1, bx);
        }
        SEAM(pb + 4);
        if (IN(pb + 5)) REPEAT(REP_N1, { REFRESH(); router_norm_phase(F, l); });
        SEAM(pb + 5);
        if (IN(pb + 6)) REPEAT(REP_SEL, { REFRESH(); tail_convert(F, l, 3, F.vcu); REFRESH(); select_phase(F, l, 1); });
        SEAM(pb + 6);
        if (IN(pb + 7)) REPEAT(REP_G1, { REFRESH();
            pg8::Gemm g{H, (const bf16*)(F.ws + WS_WMOE1 + (size_t)l * 16 * 4096 * 1024), XR, 4096, 512}; pg8::MoeOrder S; S.init(l < 3 ? 18 : 16, 16, F.G, bx);
            pg8::EpiSwiGLU E{(unsigned char*)P}; pg8::gemm_phase<pg8::EpiSwiGLU, pg8::MoeOrder, true, true, true, true>(F.lds, g, S, E, wv, (const unsigned short*)(F.ws + WS_IDX), (LAS unsigned short*)(F.lds + 131072));
        });
        SEAM(pb + 7);
        if (IN(pb + 8)) REPEAT(REP_G2, { REFRESH();
            pg8::Gemm g{P, (const bf16*)(F.ws + WS_WMOE2 + (size_t)l * 16 * 1024 * 2048), XR, 1024, 1024}; pg8::MoeOrder S; S.init(l < 3 ? 18 : 16, 4, F.G, bx);
            pg8::EpiDown E{F.ws + WS_O, (const float*)(F.ws + WS_GATE)}; pg8::gemm_phase<pg8::EpiDown, pg8::MoeOrder, true, true, true>(F.lds, g, S, E, wv);
            tail_convert(F, l, 2, bx);
        });
        SEAM(pb + 8);
    }
    if (IN(37)) REPEAT(REP_FIN, { REFRESH(); combine_norm_phase<true>(F, 0, 3); });
#undef IN
#undef H
#undef P
#undef O
#undef X
#undef mod
#undef REFRESH
#undef SEAM
#undef BARRIER
#undef REPEAT
}

extern "C" void kernel_launch(void* const* d_in, const int* in_sizes, int n_in, void* d_out, int out_size, void* d_ws, size_t ws_size, hipStream_t stream) {
    static int grid = 0;
    if (grid == 0) {
        if (n_in != 21 || in_sizes[0] != RL * 1024 || out_size != RL * 1024 || ws_size < WS_END) { fprintf(stderr, "kernel_launch: unexpected shapes (n_in %d, in0 %d, out %d, ws %zu; need ws >= %zu); nothing launched\n", n_in, n_in > 0 ? in_sizes[0] : -1, out_size, ws_size, (size_t)WS_END); grid = -1; return; }
        int dev = 0, cus = 0, per_cu = 0;
        if (hipGetDevice(&dev) != hipSuccess || hipDeviceGetAttribute(&cus, hipDeviceAttributeMultiprocessorCount, dev) != hipSuccess) { fprintf(stderr, "kernel_launch: device query failed\n"); grid = -1; return; }
        if (hipFuncSetAttribute((const void*)fwd_kernel, hipFuncAttributeMaxDynamicSharedMemorySize, LDS_BYTES) != hipSuccess) { fprintf(stderr, "kernel_launch: hipFuncSetAttribute failed\n"); grid = -1; return; }
        if (hipOccupancyMaxActiveBlocksPerMultiprocessor(&per_cu, (const void*)fwd_kernel, NTHR, LDS_BYTES) != hipSuccess || per_cu < 1) fprintf(stderr, "kernel_launch: note: occupancy query reports %d workgroups per CU\n", per_cu);
        (void)hipGetLastError();
        if (cus != 256) { fprintf(stderr, "kernel_launch: built for a 256-CU device, found %d CUs; nothing launched\n", cus); grid = -1; return; }
        grid = 256;
    }
    if (grid < 0) return;
    if (hipMemsetAsync((char*)d_ws + WS_CTL, 0, CTL_ZERO_BYTES, stream) != hipSuccess) { fprintf(stderr, "kernel_launch: memset failed\n"); return; }
    Args a{};
    for (int i = 0; i < 21; ++i) a.in[i] = (const float*)d_in[i];
    a.out = (float*)d_out; a.ws = (unsigned char*)d_ws;
#if MK_ONE_LAUNCH
    a.ph_lo = 0; a.ph_hi = NPH;
    hipLaunchKernelGGL(fwd_kernel, dim3(grid), dim3(NTHR), LDS_BYTES, stream, a);
#else
    for (int p = 0; p < NPH; ++p) {
        if (p >= DBG_STOP && p != 37) continue;
        if (p >= 1 && p < 37 && ((p - 1) % 9) == 3 && ((((p - 1) / 9) & 1) == 0)) continue;
        a.ph_lo = p; a.ph_hi = p + 1;
        hipLaunchKernelGGL(fwd_kernel, dim3(grid), dim3(NTHR), LDS_BYTES, stream, a);
    }
#endif
    const hipError_t le = hipPeekAtLastError();
    if (le != hipSuccess) fprintf(stderr, "kernel_launch: launch failed: %s\n", hipGetErrorName(le));
}
```

```cpp
#include <hip/hip_runtime.h>
#include <cstdio>
#include <cstdint>

constexpr int DM = 1024, NB = 16, SEQ = 2048, CTXL = 256, DEPTH = 4;
constexpr int RL = NB * SEQ;
constexpr int RC = NB * CTXL;
constexpr int RT = RL + RC;
constexpr int NEXP = 16, FFD = 2048, CAPL = 256, CAPC = 32;
constexpr int XT_E = 18;
constexpr int XR_E = XT_E * 256;
constexpr int XR = NEXP * XR_E;
constexpr int LD_EVEN = 3072, LD_ODD = 5120;
constexpr float NORM_EPS = 1e-6f;
constexpr int NWAVES = 8, NTHR = 512;
#ifndef IN8_EVEN
#define IN8_EVEN 1
#endif
#ifndef IN8_ODD
#define IN8_ODD 0
#endif
constexpr bool IN8E = IN8_EVEN != 0, IN8O = IN8_ODD != 0;

namespace pg8 {
#define PG8_LAS __attribute__((address_space(3)))
typedef unsigned short bf16_t;
typedef short bf16x8 __attribute__((ext_vector_type(8)));
typedef float f32x4 __attribute__((ext_vector_type(4)));
typedef unsigned u32x4 __attribute__((ext_vector_type(4)));
typedef int v4i_t __attribute__((ext_vector_type(4)));
typedef int v8i_t __attribute__((ext_vector_type(8)));
constexpr int BM = 256, BK = 64, HALF = 128, HTB = HALF * BK * 2  , STAGE_BYTES = 8 * HTB, NXCD = 8, WGM = 8;

__host__ __device__ __forceinline__ int lds_byte(int r, int c) { const int st = (r >> 4) * 2 + (c >> 5), rr = r & 15, cc = c & 31, ob = rr * 64 + cc * 2; return st * 1024 + (ob ^ (((ob >> 9) & 1) << 5)); }
__host__ __device__ __forceinline__ void stage_rc(int b, int& R, int& C) { const int st = b / 1024, sb = b % 1024, swz = sb ^ (((sb >> 9) & 1) << 5); R = (st >> 1) * 16 + swz / 64; C = (st & 1) * 32 + (swz % 64) / 2; }
__host__ __device__ __forceinline__ int perm32(int rho) { const int n = rho >> 4, i = rho & 15; return 8 * (i >> 2) + 4 * n + (i & 3); }

struct Unit { int pm, pn; };
struct Gemm { const bf16_t* A; const bf16_t* Bt; int M, N, K; };
typedef __bf16 bf16x2_t __attribute__((ext_vector_type(2)));
typedef float f32x2_t __attribute__((ext_vector_type(2)));
__device__ __forceinline__ unsigned cvt_pk_bf16(float lo, float hi) { const f32x2_t v = {lo, hi}; const bf16x2_t b = __builtin_convertvector(v, bf16x2_t); return __builtin_bit_cast(unsigned, b); }
typedef unsigned u32x2 __attribute__((ext_vector_type(2)));
typedef float f32x2 __attribute__((ext_vector_type(2)));
__device__ __forceinline__ u32x2 pk4(f32x4 v) { u32x2 w; w.x = cvt_pk_bf16(v[0], v[1]); w.y = cvt_pk_bf16(v[2], v[3]); return w; }
__device__ __forceinline__ float silu_f(float x) { return x * __builtin_amdgcn_rcpf(1.0f + __builtin_amdgcn_exp2f(-1.4426950408889634f * x)); }

constexpr float FP8_ACT = 8.0f, FP8_WGT = 64.0f, FP8_UNSCALE = 1.0f / (FP8_ACT * FP8_WGT);
__device__ __forceinline__ float clamp448(float v) { return __builtin_amdgcn_fmed3f(v, -448.0f, 448.0f); }
__device__ __forceinline__ unsigned pack4_fp8(float a, float b, float c, float d) { unsigned v = 0u; v = __builtin_amdgcn_cvt_pk_fp8_f32(clamp448(a), clamp448(b), v, false); v = __builtin_amdgcn_cvt_pk_fp8_f32(clamp448(c), clamp448(d), v, true); return v; }
__device__ __forceinline__ int xcd_remap(int L, int nwg) { const int q = nwg / NXCD, r = nwg % NXCD, xcd = L % NXCD, off = L / NXCD; return (xcd < r ? xcd * (q + 1) : r * (q + 1) + (xcd - r) * q) + off; }
__device__ __forceinline__ void grp8(int wgid, int nM, int nN, int& pm, int& pn) { const int nig = WGM * nN, gid = wgid / nig, fm = gid * WGM, gsz = (nM - fm) < WGM ? (nM - fm) : WGM; pm = fm + ((wgid % nig) % gsz); pn = (wgid % nig) / gsz; }
struct RectOrder {
    int nMA, nNA, pmA, pnA, nA, nMB, nNB, pmB, pnB, nB, G, c;
    __device__ __forceinline__ void init(int nMA_, int nNA_, int pmA_, int pnA_, int nMB_, int nNB_, int pmB_, int pnB_, int G_, int c_) {
        nMA = nMA_; nNA = nNA_; pmA = pmA_; pnA = pnA_; nA = nMA_ * nNA_; nMB = nMB_; nNB = nNB_; pmB = pmB_; pnB = pnB_; nB = nMB_ * nNB_; G = G_; c = c_; }
    __device__ __forceinline__ bool next(int i, Unit& u) const {
        long L = (long)i * G + c; int pm, pn;
        if (L < nA) { grp8(xcd_remap((int)L, nA), nMA, nNA, pm, pn); u.pm = pmA + pm; u.pn = pnA + pn; return true; }
        L -= nA; if (L < nB) { grp8(xcd_remap((int)L, nB), nMB, nNB, pm, pn); u.pm = pmB + pm; u.pn = pnB + pn; return true; }
        return false;
    }
    __device__ __forceinline__ void a_ready(const Unit&) const {}
    __device__ __forceinline__ void done(const Unit&) const {}
};
struct Rect3Order {
    int nM[3], nN[3], pm0[3], pn0[3], n[3], G, c;
    __device__ __forceinline__ void init(int nMA, int nNA, int pmA, int pnA, int nMB, int nNB, int pmB, int pnB, int nMC, int nNC, int pmC, int pnC, int G_, int c_) {
        nM[0] = nMA; nN[0] = nNA; pm0[0] = pmA; pn0[0] = pnA; nM[1] = nMB; nN[1] = nNB; pm0[1] = pmB; pn0[1] = pnB; nM[2] = nMC; nN[2] = nNC; pm0[2] = pmC; pn0[2] = pnC;
        n[0] = nMA * nNA; n[1] = nMB * nNB; n[2] = nMC * nNC; G = G_; c = c_; }
    __device__ __forceinline__ bool next(int i, Unit& u) const {
        long L = (long)i * G + c; int pm, pn;
        if (L < n[0]) { grp8(xcd_remap((int)L, n[0]), nM[0], nN[0], pm, pn); u.pm = pm0[0] + pm; u.pn = pn0[0] + pn; return true; }
        L -= n[0]; if (L < n[1]) { grp8(xcd_remap((int)L, n[1]), nM[1], nN[1], pm, pn); u.pm = pm0[1] + pm; u.pn = pn0[1] + pn; return true; }
        L -= n[1]; if (L < n[2]) { grp8(xcd_remap((int)L, n[2]), nM[2], nN[2], pm, pn); u.pm = pm0[2] + pm; u.pn = pn0[2] + pn; return true; }
        return false;
    }
    __device__ __forceinline__ void a_ready(const Unit&) const {}
    __device__ __forceinline__ void done(const Unit&) const {}
};
struct MoeOrder {
    int nj, npn, per_e, total, G, c;
    __device__ __forceinline__ void init(int nj_, int npn_, int G_, int c_) { nj = nj_; npn = npn_; per_e = nj_ * npn_; total = 16 * per_e; G = G_; c = c_; }
    __device__ __forceinline__ bool next(int i, Unit& u) const {
        const long L = (long)i * G + c; if (L >= total) return false;
        const int wgid = xcd_remap((int)L, total), e = wgid / per_e, r = wgid % per_e; int j, pn; grp8(r, nj, npn, j, pn);
        u.pm = e * 18 + j; u.pn = e * npn + pn; return true;
    }
    __device__ __forceinline__ void a_ready(const Unit&) const {}
    __device__ __forceinline__ void done(const Unit&) const {}
};


template <bool F8> struct EpiEvenIn {
    static constexpr bool PERM = false, AFTER_DRAIN = false; static constexpr float US = F8 ? FP8_UNSCALE : 1.0f;
    bf16_t* P;
    __device__ __forceinline__ void operator()(const f32x4 (&acc)[2][2][4][2], const Unit& u, int wr, int wc, int fr, int fq) const {
        const int pn = u.pn; const bool ropet = (pn == 2) | (pn == 3) | (pn == 8) | (pn == 9); const bool latent = u.pm < 128;
        const int row0 = u.pm * BM + wr * 64 + fr;
        if (!ropet) {
            const int col0 = pn * BM + wc * 32 + 8 * fq;
#pragma unroll
            for (int ai = 0; ai < 2; ++ai)
#pragma unroll
                for (int m = 0; m < 4; ++m) { bf16_t* rowp = P + (size_t)(row0 + ai * HALF + m * 16) * 3072 + col0;
#pragma unroll
                    for (int bj = 0; bj < 2; ++bj) { const u32x2 a = pk4(F8 ? acc[ai][bj][m][0] * US : acc[ai][bj][m][0]), b = pk4(F8 ? acc[ai][bj][m][1] * US : acc[ai][bj][m][1]); *(u32x4*)(rowp + bj * HALF) = (u32x4){a.x, a.y, b.x, b.y}; } }
        } else {
            const int col0 = pn * BM + (wc >> 1) * 64 + (wc & 1) * 16 + 4 * fq;
            float ir[4];
#pragma unroll
            for (int i = 0; i < 4; ++i) ir[i] = __builtin_amdgcn_exp2f(-(float)(4 * fq + i) * 0.8304820237218406f) * 0.15915494309189535f;
#pragma unroll
            for (int ai = 0; ai < 2; ++ai)
#pragma unroll
                for (int m = 0; m < 4; ++m) { const int row = row0 + ai * HALF + m * 16; const int t = row & 2047; const float pos = (float)((wc & 1) ? (t & 63) : (t >> 6));
                    f32x4 cs, sn;
#pragma unroll
                    for (int i = 0; i < 4; ++i) { float rev = pos * ir[i]; rev -= __builtin_rintf(rev); sn[i] = latent ? (F8 ? __builtin_amdgcn_sinf(rev) * US : __builtin_amdgcn_sinf(rev)) : 0.f; cs[i] = latent ? (F8 ? __builtin_amdgcn_cosf(rev) * US : __builtin_amdgcn_cosf(rev)) : US; }
                    bf16_t* rowp = P + (size_t)row * 3072 + col0;
#pragma unroll
                    for (int bj = 0; bj < 2; ++bj) { const f32x4 a1 = acc[ai][bj][m][0], a2 = acc[ai][bj][m][1];
                        *(u32x2*)(rowp + bj * HALF) = pk4(a1 * cs - a2 * sn); *(u32x2*)(rowp + bj * HALF + 32) = pk4(a2 * cs + a1 * sn); } }
        }
    }
};
template <bool F8> struct EpiOddIn {
    static constexpr bool PERM = false, AFTER_DRAIN = false; static constexpr float US = F8 ? FP8_UNSCALE : 1.0f;
    bf16_t* P; int pn_off;
    __device__ __forceinline__ void operator()(const f32x4 (&acc)[2][2][4][2], const Unit& u, int wr, int wc, int fr, int fq) const {
        const int pn = u.pn + pn_off; const int act = ((pn < 4) | (pn >= 16)) ? 1 : (pn < 12 ? 2 : 0);
        const int row0 = u.pm * BM + wr * 64 + fr, col0 = pn * BM + wc * 32 + 8 * fq;
#pragma unroll
        for (int ai = 0; ai < 2; ++ai)
#pragma unroll
            for (int m = 0; m < 4; ++m) { bf16_t* rowp = P + (size_t)(row0 + ai * HALF + m * 16) * 5120 + col0;
#pragma unroll
                for (int bj = 0; bj < 2; ++bj) { f32x4 v0 = acc[ai][bj][m][0], v1 = acc[ai][bj][m][1]; if (F8) { v0 *= US; v1 *= US; }
                    if (act) {
#pragma unroll
                        for (int i = 0; i < 4; ++i) { const float s0 = __builtin_amdgcn_rcpf(1.0f + __builtin_amdgcn_exp2f(-1.4426950408889634f * v0[i])), s1 = __builtin_amdgcn_rcpf(1.0f + __builtin_amdgcn_exp2f(-1.4426950408889634f * v1[i]));
                            v0[i] = (act == 1) ? v0[i] * s0 : s0; v1[i] = (act == 1) ? v1[i] * s1 : s1; } }
                    const u32x2 a = pk4(v0), b = pk4(v1); *(u32x4*)(rowp + bj * HALF) = (u32x4){a.x, a.y, b.x, b.y}; } }
    }
};
struct EpiOutRes {
    static constexpr bool PERM = false, AFTER_DRAIN = false;
    const float* srcL; const float* srcC; bf16_t* X; const float* gmod; bool src32;
    __device__ __forceinline__ void operator()(const f32x4 (&acc)[2][2][4][2], const Unit& u, int wr, int wc, int fr, int fq) const {
        const bool latent = u.pm < 128; const int bidx = latent ? (u.pm >> 3) : 16;
        const int row0 = u.pm * BM + wr * 64 + fr, col0 = u.pn * BM + wc * 32 + 8 * fq;
        const float* src = latent ? srcL : srcC - (size_t)32768 * 1024;
        f32x4 gv[2][2];
#pragma unroll
        for (int bj = 0; bj < 2; ++bj)
#pragma unroll
            for (int n = 0; n < 2; ++n) gv[bj][n] = *(const f32x4*)(gmod + (size_t)bidx * 6144 + col0 + bj * HALF + n * 4);
#pragma unroll
        for (int ai = 0; ai < 2; ++ai)
#pragma unroll
            for (int m = 0; m < 4; ++m) { const size_t off = (size_t)(row0 + ai * HALF + m * 16) * 1024 + col0;
#pragma unroll
                for (int bj = 0; bj < 2; ++bj) { f32x4 s0, s1;
                    if (src32) { s0 = *(const f32x4*)(src + off + bj * HALF); s1 = *(const f32x4*)(src + off + bj * HALF + 4); }
                    else { const u32x4 w = *(const u32x4*)(X + off + bj * HALF); s0 = (f32x4){__builtin_bit_cast(float, w.x << 16), __builtin_bit_cast(float, w.x & 0xffff0000u), __builtin_bit_cast(float, w.y << 16), __builtin_bit_cast(float, w.y & 0xffff0000u)};
                        s1 = (f32x4){__builtin_bit_cast(float, w.z << 16), __builtin_bit_cast(float, w.z & 0xffff0000u), __builtin_bit_cast(float, w.w << 16), __builtin_bit_cast(float, w.w & 0xffff0000u)}; }
                    const u32x2 a = pk4(s0 + gv[bj][0] * acc[ai][bj][m][0]), b = pk4(s1 + gv[bj][1] * acc[ai][bj][m][1]); *(u32x4*)(X + off + bj * HALF) = (u32x4){a.x, a.y, b.x, b.y}; }
                asm volatile("" ::: "memory"); }
    }
};
struct EpiSwiGLU {
    static constexpr bool PERM = false, AFTER_DRAIN = false;
    unsigned char* HID;
    __device__ __forceinline__ void operator()(const f32x4 (&acc)[2][2][4][2], const Unit& u, int wr, int wc, int fr, int fq) const {
        const int pnl = u.pn & 15; const int row0 = u.pm * BM + wr * 64 + fr, col0 = pnl * 128 + wc * 32 + 8 * fq;
        constexpr float KA = -1.4426950408889634f * FP8_UNSCALE, KB = FP8_UNSCALE * FP8_UNSCALE * FP8_ACT;
#pragma unroll
        for (int ai = 0; ai < 2; ++ai)
#pragma unroll
            for (int m = 0; m < 4; ++m) { unsigned w[2];
#pragma unroll
                for (int bj = 0; bj < 2; ++bj) { const f32x4 g = acc[ai][bj][m][0], up = acc[ai][bj][m][1]; float hv[4];
#pragma unroll
                    for (int q = 0; q < 2; ++q) { const f32x2 g2 = {g[2 * q], g[2 * q + 1]}, u2 = {up[2 * q], up[2 * q + 1]}; const f32x2 a2 = g2 * KA;
                        f32x2 e2; e2.x = __builtin_amdgcn_exp2f(a2.x); e2.y = __builtin_amdgcn_exp2f(a2.y); const f32x2 d2 = e2 + 1.0f;
                        f32x2 r2; r2.x = __builtin_amdgcn_rcpf(d2.x); r2.y = __builtin_amdgcn_rcpf(d2.y); const f32x2 h2 = ((g2 * u2) * KB) * r2; hv[2 * q] = h2.x; hv[2 * q + 1] = h2.y; }
                    w[bj] = pack4_fp8(hv[0], hv[1], hv[2], hv[3]); }
                *(u32x2*)(HID + (size_t)(row0 + ai * HALF + m * 16) * 2048 + col0) = (u32x2){w[0], w[1]}; }
    }
};
constexpr float FP8_Y = 64.0f;
struct EpiDown {
    static constexpr bool PERM = false, AFTER_DRAIN = false;
    unsigned char* Y; const float* gate;
    __device__ __forceinline__ void operator()(const f32x4 (&acc)[2][2][4][2], const Unit& u, int wr, int wc, int fr, int fq) const {
        const int pnl = u.pn & 3; const int row0 = u.pm * BM + wr * 64 + fr, col0 = pnl * BM + wc * 32 + 8 * fq;
#pragma unroll
        for (int ai = 0; ai < 2; ++ai)
#pragma unroll
            for (int m = 0; m < 4; ++m) { const int row = row0 + ai * HALF + m * 16; const float gt = gate[row] * (FP8_UNSCALE * FP8_Y); unsigned char* rowp = Y + (size_t)row * 1024 + col0;
#pragma unroll
                for (int bj = 0; bj < 2; ++bj) { const f32x4 a = acc[ai][bj][m][0] * gt, b = acc[ai][bj][m][1] * gt; *(u32x2*)(rowp + bj * HALF) = (u32x2){pack4_fp8(a[0], a[1], a[2], a[3]), pack4_fp8(b[0], b[1], b[2], b[3])}; } }
    }
};

template <class Epi, class Sched, bool ALIGN_EPI = false, bool SP2 = false, bool FP8 = false, bool GATHER = false>
__device__ __forceinline__ void gemm_phase(PG8_LAS unsigned char* lds, const Gemm g, const Sched& S, const Epi& E, int wid_in, const unsigned short* gidx = nullptr, PG8_LAS unsigned short* gtab = nullptr) {
    static_assert(!GATHER || SP2, "the gathered A operand is wired into the SP2 loop only");
    int lane_; asm volatile("v_mbcnt_lo_u32_b32 %0, -1, 0\n\tv_mbcnt_hi_u32_b32 %0, -1, %0" : "=v"(lane_));
    const int lane = lane_, wid = wid_in, tid = wid * 64 + lane, wr = wid >> 2, wc = wid & 3, fr = lane & 15, fq = lane >> 4;
    const int K = g.K, nt = K / BK;
    unsigned voffA[2], voffB[2];
#pragma unroll
    for (int i = 0; i < 2; ++i) { int R, C; stage_rc(tid * 16 + i * 8192, R, C); const int Rb = Epi::PERM ? ((R & ~31) + perm32(R & 31)) : R;
        voffA[i] = (unsigned)(R * K + C) * 2u; voffB[i] = (unsigned)(Rb * K + C) * 2u; }
    unsigned vc[2][2] = {{0u, 0u}, {0u, 0u}};
#define PG8_GV(dst, ui_) do { _Pragma("unroll") for (int _i = 0; _i < 2; ++_i) { int R_, C_; stage_rc(tid * 16 + _i * 8192, R_, C_); _Pragma("unroll") for (int _h = 0; _h < 2; ++_h) \
        dst[_h][_i] = (unsigned)gtab[(ui_) * 256 + _h * HALF + R_] * (unsigned)(K * 2) + (unsigned)(C_ * 2); } } while (0)
#define PG8_STAGE_A(bufoff, ptr, h, usenext) do { if constexpr (GATHER) { PG8_STAGE(bufoff, ptr, vc[h]); } else PG8_STAGE(bufoff, (ptr) + ((h) ? hstep : 0), voffA); } while (0)
    if constexpr (GATHER) { Unit u_; for (int i_ = 0; S.next(i_, u_); ++i_) if (tid < 256) gtab[i_ * 256 + tid] = gidx[(size_t)u_.pm * 256 + tid];
        asm volatile("s_waitcnt vmcnt(0) lgkmcnt(0)" ::: "memory"); __builtin_amdgcn_s_barrier(); asm volatile("" ::: "memory"); }
    const size_t kstep = (size_t)(BK * 2);
    const size_t hstep = (size_t)HALF * K * 2;
    const size_t tstep = 2 * hstep;
    const unsigned ldsw = (unsigned)wid * 1024u;
    const int aoff = lds_byte(wr * 64 + fr, fq * 8), boff = lds_byte(wc * 32 + fr, fq * 8);
#define PG8_SA(b, h) (((b) * 2 + (h)) * HTB)
#define PG8_SB(b, h) ((4 + (b) * 2 + (h)) * HTB)
#define PG8_STAGE(bufoff, gbase, voff) do { _Pragma("unroll") for (int _i = 0; _i < 2; ++_i) \
        __builtin_amdgcn_global_load_lds((const unsigned*)((const char*)(gbase) + (voff)[_i]), (PG8_LAS unsigned*)(lds + (bufoff) + ldsw + _i * 8192), 16, 0, 0); } while (0)
#define PG8_LDA(dst, b, h) do { if constexpr (FP8) { _Pragma("unroll") for (int m = 0; m < 4; ++m) dst##8[m] = __builtin_shufflevector(*(const PG8_LAS v4i_t*)(lds + PG8_SA(b, h) + aoff + m * 2048), *(const PG8_LAS v4i_t*)(lds + PG8_SA(b, h) + aoff + m * 2048 + 1024), 0, 1, 2, 3, 4, 5, 6, 7); } \
        else { _Pragma("unroll") for (int m = 0; m < 4; ++m) _Pragma("unroll") for (int k = 0; k < 2; ++k) dst[m][k] = *(const PG8_LAS bf16x8*)(lds + PG8_SA(b, h) + aoff + m * 2048 + k * 1024); } } while (0)
#define PG8_LDB(dst, b, h) do { if constexpr (FP8) { _Pragma("unroll") for (int n = 0; n < 2; ++n) dst##8[n] = __builtin_shufflevector(*(const PG8_LAS v4i_t*)(lds + PG8_SB(b, h) + boff + n * 2048), *(const PG8_LAS v4i_t*)(lds + PG8_SB(b, h) + boff + n * 2048 + 1024), 0, 1, 2, 3, 4, 5, 6, 7); } \
        else { _Pragma("unroll") for (int n = 0; n < 2; ++n) _Pragma("unroll") for (int k = 0; k < 2; ++k) dst[n][k] = *(const PG8_LAS bf16x8*)(lds + PG8_SB(b, h) + boff + n * 2048 + k * 1024); } } while (0)
#define PG8_MMA(ai, bj, At, Bt) do { __builtin_amdgcn_s_setprio(1); if constexpr (FP8) { _Pragma("unroll") for (int m = 0; m < 4; ++m) _Pragma("unroll") for (int n = 0; n < 2; ++n) \
        asm volatile("v_mfma_f32_16x16x128_f8f6f4 %0, %1, %2, %0" : "+v"(acc[ai][bj][m][n]) : "v"(Bt##8[n]), "v"(At##8[m])); } else { \
        _Pragma("unroll") for (int m = 0; m < 4; ++m) _Pragma("unroll") for (int n = 0; n < 2; ++n) _Pragma("unroll") for (int k = 0; k < 2; ++k) \
        acc[ai][bj][m][n] = __builtin_amdgcn_mfma_f32_16x16x32_bf16(Bt[n][k], At[m][k], acc[ai][bj][m][n], 0, 0, 0); } __builtin_amdgcn_s_setprio(0); } while (0)
#define PG8_WAIT_V(n) asm volatile("s_waitcnt vmcnt(" #n ")" ::: "memory")
#define PG8_WAIT_L(n) asm volatile("s_waitcnt lgkmcnt(" #n ")" ::: "memory")
#define PG8_BAR __builtin_amdgcn_s_barrier()
#define PG8_SCHED __builtin_amdgcn_sched_barrier(0)
    Unit cur, nxt; int ui = 0;
    if (!S.next(0, cur)) return;
    f32x4 acc[2][2][4][2];
#pragma unroll
    for (int a = 0; a < 2; ++a)
#pragma unroll
        for (int b = 0; b < 2; ++b)
#pragma unroll
            for (int m = 0; m < 4; ++m)
#pragma unroll
                for (int n = 0; n < 2; ++n) acc[a][b][m][n] = (f32x4){0.f, 0.f, 0.f, 0.f};
    bf16x8 At[4][2], B0[2][2], B1[2][2]; v8i_t At8[4], B08[2], B18[2];
    const char* cA = (const char*)g.A + (GATHER ? (size_t)0 : (size_t)cur.pm * tstep); const char* cB = (const char*)g.Bt + (size_t)cur.pn * tstep;
    if constexpr (GATHER) { PG8_GV(vc, 0); }
    S.a_ready(cur);
    if constexpr (SP2) {
        PG8_STAGE(PG8_SB(0, 0), cB, voffB); PG8_STAGE(PG8_SB(0, 1), cB + hstep, voffB); PG8_STAGE_A(PG8_SA(0, 0), cA, 0, false); PG8_STAGE_A(PG8_SA(0, 1), cA, 1, false);
        if (wr == 1) PG8_BAR;
        PG8_WAIT_V(2); PG8_BAR;
        PG8_STAGE(PG8_SB(1, 0), cB + kstep, voffB); PG8_STAGE_A(PG8_SA(1, 0), cA + kstep, 0, false); PG8_STAGE(PG8_SB(1, 1), cB + hstep + kstep, voffB);
        PG8_WAIT_V(6); PG8_BAR;
    } else {
        PG8_STAGE(PG8_SB(0, 0), cB, voffB); PG8_STAGE(PG8_SA(0, 0), cA, voffA); PG8_STAGE(PG8_SB(0, 1), cB + hstep, voffB); PG8_STAGE(PG8_SA(0, 1), cA + hstep, voffA);
        if (wr == 1) PG8_BAR;
        PG8_WAIT_V(4); PG8_BAR;
        PG8_STAGE(PG8_SB(1, 0), cB + kstep, voffB); PG8_STAGE(PG8_SA(1, 0), cA + kstep, voffA); PG8_STAGE(PG8_SB(1, 1), cB + hstep + kstep, voffB);
        PG8_WAIT_V(6); PG8_BAR;
    }
    for (;;) {
        const bool has_next = S.next(ui + 1, nxt);
        const char* nA = (has_next && !GATHER) ? (const char*)g.A + (size_t)nxt.pm * tstep : cA; const char* nB = has_next ? (const char*)g.Bt + (size_t)nxt.pn * tstep : cB;
        for (int t = 0; t < nt; t += 2) {
            const bool last = (t == nt - 2);
            const char* a1 = cA + (size_t)(t + 1) * kstep;
            const char* a2 = last ? nA : cA + (size_t)(t + 2) * kstep; const char* b2 = last ? nB : cB + (size_t)(t + 2) * kstep;
            const char* a3 = a2 + kstep; const char* b3 = b2 + kstep;
            if (last && has_next) S.a_ready(nxt);
            if constexpr (SP2) {
            PG8_LDB(B0, 0, 0); PG8_LDB(B1, 0, 1); PG8_SCHED; PG8_LDA(At, 0, 0); PG8_STAGE_A(PG8_SA(1, 1), a1, 1, false);
            if constexpr (GATHER) { if (last && has_next) { PG8_GV(vc, ui + 1); } }
            PG8_WAIT_V(8); PG8_WAIT_L(0); PG8_BAR; PG8_MMA(0, 0, At, B0); PG8_MMA(0, 1, At, B1); PG8_BAR; PG8_SCHED;
            PG8_LDA(At, 0, 1); PG8_STAGE(PG8_SB(0, 0), b2, voffB); PG8_STAGE(PG8_SB(0, 1), b2 + hstep, voffB); PG8_STAGE_A(PG8_SA(0, 0), a2, 0, last);
            PG8_WAIT_V(8); PG8_WAIT_L(0); PG8_BAR; PG8_MMA(1, 0, At, B0); PG8_MMA(1, 1, At, B1); PG8_BAR; PG8_SCHED;
            PG8_LDB(B0, 1, 0); PG8_LDB(B1, 1, 1); PG8_SCHED; PG8_LDA(At, 1, 0); PG8_STAGE_A(PG8_SA(0, 1), a2, 1, last);
            PG8_WAIT_V(8); PG8_WAIT_L(0); PG8_BAR; PG8_MMA(0, 0, At, B0); PG8_MMA(0, 1, At, B1); PG8_BAR; PG8_SCHED;
            PG8_LDA(At, 1, 1); PG8_STAGE(PG8_SB(1, 0), b3, voffB); PG8_STAGE(PG8_SB(1, 1), b3 + hstep, voffB); PG8_STAGE_A(PG8_SA(1, 0), a3, 0, last);
            PG8_WAIT_V(8); PG8_WAIT_L(0); PG8_BAR; PG8_MMA(1, 0, At, B0); PG8_MMA(1, 1, At, B1); PG8_BAR; PG8_SCHED;
            } else {
            PG8_LDB(B0, 0, 0); PG8_SCHED; PG8_LDA(At, 0, 0); PG8_STAGE(PG8_SA(1, 1), a1 + hstep, voffA);
            PG8_WAIT_L(8); PG8_BAR; PG8_WAIT_L(0); PG8_MMA(0, 0, At, B0); PG8_BAR; PG8_SCHED;
            PG8_LDB(B1, 0, 1); PG8_STAGE(PG8_SB(0, 0), b2, voffB);
            PG8_BAR; PG8_WAIT_L(0); PG8_MMA(0, 1, At, B1); PG8_BAR;
            PG8_LDA(At, 0, 1); PG8_STAGE(PG8_SA(0, 0), a2, voffA);
            PG8_BAR; PG8_WAIT_L(0); PG8_MMA(1, 0, At, B0); PG8_BAR; PG8_SCHED;
            PG8_STAGE(PG8_SB(0, 1), b2 + hstep, voffB);
            PG8_WAIT_V(6); PG8_BAR; PG8_MMA(1, 1, At, B1); PG8_BAR;
            PG8_LDB(B0, 1, 0); PG8_SCHED; PG8_LDA(At, 1, 0); PG8_STAGE(PG8_SA(0, 1), a2 + hstep, voffA);
            PG8_WAIT_L(8); PG8_BAR; PG8_WAIT_L(0); PG8_MMA(0, 0, At, B0); PG8_BAR; PG8_SCHED;
            PG8_LDB(B1, 1, 1); PG8_STAGE(PG8_SB(1, 0), b3, voffB);
            PG8_BAR; PG8_WAIT_L(0); PG8_MMA(0, 1, At, B1); PG8_BAR;
            PG8_LDA(At, 1, 1); PG8_STAGE(PG8_SA(1, 0), a3, voffA);
            PG8_BAR; PG8_WAIT_L(0); PG8_MMA(1, 0, At, B0); PG8_BAR; PG8_SCHED;
            PG8_STAGE(PG8_SB(1, 1), b3 + hstep, voffB);
            PG8_WAIT_V(6); PG8_BAR; PG8_MMA(1, 1, At, B1); PG8_BAR;
            }
        }
        if constexpr (FP8) { PG8_SCHED; asm volatile("s_nop 15\n\ts_nop 15\n\ts_nop 15" ::: "memory"); PG8_SCHED; }
        if constexpr (ALIGN_EPI) { if (wr == 0) PG8_BAR; }
        if constexpr (!Epi::AFTER_DRAIN) { E(acc, cur, wr, wc, fr, fq); S.done(cur); }
        if (!has_next) break;
#pragma unroll
        for (int a = 0; a < 2; ++a)
#pragma unroll
            for (int b = 0; b < 2; ++b)
#pragma unroll
                for (int m = 0; m < 4; ++m)
#pragma unroll
                    for (int n = 0; n < 2; ++n) acc[a][b][m][n] = (f32x4){0.f, 0.f, 0.f, 0.f};
        cur = nxt; cA = nA; cB = nB; ++ui;
        if constexpr (ALIGN_EPI) { if (wr == 1) PG8_BAR; }
    }
    PG8_WAIT_V(0);
    if constexpr (!ALIGN_EPI) { if (wr == 0) PG8_BAR; }
    PG8_BAR;
    if constexpr (Epi::AFTER_DRAIN) { E.fused(acc, cur, wr, wc, fr, fq, lds, wid, lane); S.done(cur); }
#undef PG8_SA
#undef PG8_SB
#undef PG8_STAGE
#undef PG8_STAGE_A
#undef PG8_GV
#undef PG8_LDA
#undef PG8_LDB
#undef PG8_MMA
#undef PG8_WAIT_V
#undef PG8_WAIT_L
#undef PG8_BAR
#undef PG8_SCHED
}
}

constexpr size_t MiB = (size_t)1 << 20;
constexpr size_t WS_CTL = 0, CTL_ZERO_BYTES = 32768;
constexpr size_t WS_MOD = 1 * MiB;
constexpr size_t WS_AFF = 4 * MiB;
constexpr size_t WS_GATE = 7 * MiB;
constexpr size_t WS_IDX = 7 * MiB + 512 * 1024;
constexpr size_t WS_INV = 8 * MiB;
constexpr size_t WS_WATT_IN = 10 * MiB, WS_WATT_OUT = 22 * MiB, WS_WREC_IN = 26 * MiB, WS_WREC_OUT = 46 * MiB;
constexpr size_t WS_WMOE1 = 50 * MiB;
constexpr size_t WS_H8O = 320 * MiB;
constexpr size_t WS_WREC_F8 = 360 * MiB;
constexpr size_t WS_WMOE2 = 562 * MiB;
constexpr size_t WS_X = 818 * MiB;
constexpr size_t WS_H = 962 * MiB;
constexpr size_t WS_P = 1034 * MiB;
constexpr size_t WS_O = 1394 * MiB;
constexpr size_t WS_OF = WS_O + 72 * MiB, WS_OB = WS_O + 144 * MiB;
constexpr size_t WS_END = 1610 * MiB;
static_assert((size_t)RT * 1024 * 4 <= 144 * MiB && (size_t)RT * 5120 * 2 <= 360 * MiB && (size_t)XR * 2048 * 2 <= 360 * MiB && (size_t)XR * 1024 * 2 <= 216 * MiB, "ws map");
constexpr int CW_BAR = 4096;

constexpr int LDS_BYTES = 147456;
constexpr int MISC_OFF = LDS_BYTES - 256;

#define GAS __attribute__((address_space(1)))
#define LAS __attribute__((address_space(3)))
typedef unsigned short bf16;
typedef float f32x4 __attribute__((ext_vector_type(4)));
typedef unsigned v4u __attribute__((ext_vector_type(4)));
typedef unsigned v2u __attribute__((ext_vector_type(2)));
typedef short bf16x8 __attribute__((ext_vector_type(8)));
typedef short s16x4 __attribute__((ext_vector_type(4)));
typedef float f32x16 __attribute__((ext_vector_type(16)));
#define LDS_WAIT() asm volatile("s_waitcnt lgkmcnt(0)" ::: "memory")
#define VM_WAIT() asm volatile("s_waitcnt vmcnt(0)" ::: "memory")
__device__ __forceinline__ unsigned f2bf(float f) { const __bf16 b = (__bf16)f; return (unsigned)__builtin_bit_cast(unsigned short, b); }
__device__ __forceinline__ unsigned pk2(float lo, float hi) { return pg8::cvt_pk_bf16(lo, hi); }
__device__ __forceinline__ float bf2f(unsigned short b) { return __builtin_bit_cast(float, (unsigned)b << 16); }
__device__ __forceinline__ float bflo(unsigned w) { return __builtin_bit_cast(float, w << 16); }
__device__ __forceinline__ float bfhi(unsigned w) { return __builtin_bit_cast(float, w & 0xffff0000u); }
template <int CTRL> __device__ __forceinline__ float dppx(float x) { return __builtin_bit_cast(float, __builtin_amdgcn_update_dpp(0, __builtin_bit_cast(int, x), CTRL, 0xF, 0xF, true)); }
__device__ __forceinline__ float lx1(float x) { return dppx<0xB1>(x); }
__device__ __forceinline__ float lx2(float x) { return dppx<0x4E>(x); }
__device__ __forceinline__ float lx4(float x) { return dppx<0x1B>(dppx<0x141>(x)); }
__device__ __forceinline__ float lx8(float x) { return dppx<0x128>(x); }
__device__ __forceinline__ float sw16sum(float a, float b) { auto r = __builtin_amdgcn_permlane16_swap(__float_as_uint(a), __float_as_uint(b), false, false); return __uint_as_float(r[0]) + __uint_as_float(r[1]); }
__device__ __forceinline__ float sw32sum(float a, float b) { auto r = __builtin_amdgcn_permlane32_swap(__float_as_uint(a), __float_as_uint(b), false, false); return __uint_as_float(r[0]) + __uint_as_float(r[1]); }
__device__ __forceinline__ float sw16max(float a) { auto r = __builtin_amdgcn_permlane16_swap(__float_as_uint(a), __float_as_uint(a), false, false); return fmaxf(__uint_as_float(r[0]), __uint_as_float(r[1])); }
__device__ __forceinline__ float sw32max(float a) { auto r = __builtin_amdgcn_permlane32_swap(__float_as_uint(a), __float_as_uint(a), false, false); return fmaxf(__uint_as_float(r[0]), __uint_as_float(r[1])); }
__device__ __forceinline__ float px16(float a, bool bit4) { auto r = __builtin_amdgcn_permlane16_swap(__float_as_uint(a), __float_as_uint(a), false, false); return bit4 ? __uint_as_float(r[0]) : __uint_as_float(r[1]); }
__device__ __forceinline__ float px32(float a, bool bit5) { auto r = __builtin_amdgcn_permlane32_swap(__float_as_uint(a), __float_as_uint(a), false, false); return bit5 ? __uint_as_float(r[0]) : __uint_as_float(r[1]); }
__device__ __forceinline__ float wave_sum_x(float v) { v += lx1(v); v += lx2(v); v += lx4(v); v += lx8(v); v = sw16sum(v, v); v = sw32sum(v, v); return v; }
__device__ __forceinline__ float wave_sum(float v) { return wave_sum_x(v); }
__device__ __forceinline__ int wave_sum_i(int v) {
#pragma unroll
    for (int o = 1; o < 64; o <<= 1) v += __shfl_xor(v, o);
    return v;
}
__device__ __forceinline__ int wave_incl_scan(int v, int lane) {
#pragma unroll
    for (int o = 1; o < 64; o <<= 1) { const int t = __shfl_up(v, o); if (lane >= o) v += t; }
    return v;
}

#define XB_TMO      128
#define XB_XCNT(j)  (256  + 64 * (j))
#define XB_XSUB(j)  (1280 + 64 * (j))
#define XB_XGEN(j)  (2304 + 64 * (j))
#define XB_TOP      3328
#define XB_TOPGEN   3392
#define XCD_BAR_WORDS 3456
#define XB_SPIN_CAP (1u << 18)

__device__ __forceinline__ unsigned xb_ld(unsigned* p)              { return __hip_atomic_load(p, __ATOMIC_RELAXED, __HIP_MEMORY_SCOPE_AGENT); }
__device__ __forceinline__ unsigned xb_add(unsigned* p, unsigned v) { return __hip_atomic_fetch_add(p, v, __ATOMIC_RELAXED, __HIP_MEMORY_SCOPE_AGENT); }
__device__ __forceinline__ unsigned xb_xcc_id() { return (unsigned)__builtin_amdgcn_s_getreg((3 << 11) | 20) & 0xFu; }
#define XB_SPIN(cond, bar) do { unsigned _sp = 0; while (cond) { __builtin_amdgcn_s_sleep(1); \
    if ((++_sp & 255u) == 0u) { if (xb_ld(&(bar)[XB_TMO])) break; if (_sp > XB_SPIN_CAP) { atomicAdd(&(bar)[XB_TMO], 1u); break; } } } } while (0)

struct XcdBarrier {
    unsigned* bar; unsigned x;
    volatile LAS unsigned* st;
};

__device__ __forceinline__ XcdBarrier xcd_barrier_post(unsigned* bar, volatile LAS unsigned* st) {
    XcdBarrier b; b.bar = bar; b.x = xb_xcc_id(); b.st = st;
    if (threadIdx.x == 0) (void)xb_add(&bar[XB_XCNT(b.x)], 1u);
    return b;
}
__device__ __forceinline__ void xcd_barrier_complete(unsigned* bar, unsigned x, unsigned& nloc, unsigned& nx) {
    const unsigned G = gridDim.x * gridDim.y * gridDim.z;
    unsigned sum, cnt, mine, sp = 0u;
    for (;;) {
        sum = 0u; cnt = 0u; mine = 0u;
#pragma unroll
        for (unsigned j = 0; j < 16; ++j) { const unsigned c = xb_ld(&bar[XB_XCNT(j)]); sum += c; cnt += (c > 0u) ? 1u : 0u; mine = (j == x) ? c : mine; }
        if (sum == G) break;
        __builtin_amdgcn_s_sleep(1);
        if ((++sp & 255u) == 0u) { if (xb_ld(&bar[XB_TMO])) break; if (sp > XB_SPIN_CAP) { atomicAdd(&bar[XB_TMO], 1u); break; } }
    }
    nloc = mine > 0u ? mine : 1u; nx = cnt > 0u ? cnt : 1u;
}

__device__ __forceinline__ void xcd_barrier(const XcdBarrier& b) {
    asm volatile("s_waitcnt vmcnt(0)" ::: "memory");
    __syncthreads();
    if (threadIdx.x == 0) {
        unsigned* bar = b.bar;
        __builtin_amdgcn_s_waitcnt(0);
        unsigned nloc = b.st[0], nx = b.st[1];
        if (nloc == 0u) { xcd_barrier_complete(bar, b.x, nloc, nx); b.st[0] = nloc; b.st[1] = nx; }
        const unsigned old = xb_add(&bar[XB_XSUB(b.x)], 1u);
        const unsigned gen = old / nloc;
        if (old + 1u == (gen + 1u) * nloc) {
            __builtin_amdgcn_fence(__ATOMIC_RELEASE, "agent");
            asm volatile("s_waitcnt vmcnt(0)" ::: "memory");
            const unsigned og = xb_add(&bar[XB_TOP], 1u);
            const unsigned tg = og / nx;
            if (og + 1u == (tg + 1u) * nx) xb_add(&bar[XB_TOPGEN], 1u);
            else XB_SPIN(xb_ld(&bar[XB_TOPGEN]) == tg, bar);
            __builtin_amdgcn_fence(__ATOMIC_ACQUIRE, "agent");
            xb_add(&bar[XB_XGEN(b.x)], 1u);
            asm volatile("s_waitcnt vmcnt(0)" ::: "memory");
        } else {
            XB_SPIN(xb_ld(&bar[XB_XGEN(b.x)]) == gen, bar);
            __builtin_amdgcn_fence(__ATOMIC_ACQUIRE, "agent");
            asm volatile("s_waitcnt vmcnt(0)" ::: "memory");
        }
    }
    __syncthreads();
}

struct Frame {
    LAS unsigned char* lds;
    int tid, lane, wave, vcu, G;
    const float *x_in, *c_in, *ctx_in, *cctx_in, *w_mod, *b_mod, *norm_g, *att_w_in, *att_w_out, *na_rpb, *diff_lambda, *diff_subln_g, *rec_w_in, *rec_w_out, *rec_lb_logits, *rec_gnorm_g,
                *moe_router, *moe_w_gate, *moe_w_up, *moe_w_down, *final_g;
    float* out; unsigned char* ws;
};

__device__ __forceinline__ int perm_inv32(int n) { const int c5 = n & 31; return (n & ~31) + 16 * ((c5 >> 2) & 1) + 4 * (c5 >> 3) + (c5 & 3); }
__device__ __forceinline__ int rowmap(int n, int kind) {
    if (kind == 1) { const bool rp = (n >= 512 && n < 1024) || (n >= 2048 && n < 2560); const int d = n & 63; return rp ? ((n & ~63) + 32 * ((d >> 4) & 1) + 16 * (d >> 5) + (d & 15)) : perm_inv32(n); }
    if (kind >= 2) { const int pn = n >> 7, r = n & 127, wc = r >> 5, fq = (r >> 3) & 3, bj = (r >> 2) & 1, i = r & 3; return 256 * pn + 128 * bj + 32 * wc + 16 * (kind - 2) + 4 * fq + i; }
    return perm_inv32(n);
}
__device__ __forceinline__ void transpose_item(const float* W, int K, int N, bf16* WT, int kind, LAS float* scr, int item, int lane) {
    const int nblk = N / 64, kb = item / nblk, nb = item % nblk, k0 = 64 * kb, n0 = 64 * nb;
    { const float* wp = W + (size_t)(k0 + (lane >> 4)) * N + n0 + 4 * (lane & 15); LAS float* sp = scr + (lane >> 4) * 65 + 4 * (lane & 15); f32x4 tv[16];
#pragma unroll
      for (int i = 0; i < 16; ++i) tv[i] = __builtin_nontemporal_load((const f32x4*)(wp + (size_t)(4 * i) * N));
#pragma unroll
      for (int i = 0; i < 16; ++i) { sp[(4 * i) * 65 + 0] = tv[i].x; sp[(4 * i) * 65 + 1] = tv[i].y; sp[(4 * i) * 65 + 2] = tv[i].z; sp[(4 * i) * 65 + 3] = tv[i].w; } }
    LDS_WAIT(); asm volatile("" ::: "memory");
    const int c = lane & 7;
#pragma unroll
    for (int j = 0; j < 8; ++j) { const int n = (lane >> 3) + 8 * j; const LAS float* s = scr + (8 * c) * 65 + n;
        v4u o; o.x = pk2(s[0 * 65], s[1 * 65]); o.y = pk2(s[2 * 65], s[3 * 65]); o.z = pk2(s[4 * 65], s[5 * 65]); o.w = pk2(s[6 * 65], s[7 * 65]);
        __builtin_nontemporal_store(o, (GAS v4u*)(WT + (size_t)rowmap(n0 + n, kind) * K + k0 + 8 * c)); }
    LDS_WAIT(); asm volatile("" ::: "memory");
}
__device__ __forceinline__ void transpose_item8(const float* W, int K, int N, unsigned char* WT, int kind, LAS float* scr, int item, int lane) {
    const int nblk = N / 64, kb = item / nblk, nb = item % nblk, k0 = 64 * kb, n0 = 64 * nb;
    { const float* wp = W + (size_t)(k0 + (lane >> 4)) * N + n0 + 4 * (lane & 15); LAS float* sp = scr + (lane >> 4) * 65 + 4 * (lane & 15); f32x4 tv[16];
#pragma unroll
      for (int i = 0; i < 16; ++i) tv[i] = __builtin_nontemporal_load((const f32x4*)(wp + (size_t)(4 * i) * N));
#pragma unroll
      for (int i = 0; i < 16; ++i) { const f32x4 t = tv[i] * pg8::FP8_WGT; sp[(4 * i) * 65 + 0] = t.x; sp[(4 * i) * 65 + 1] = t.y; sp[(4 * i) * 65 + 2] = t.z; sp[(4 * i) * 65 + 3] = t.w; } }
    LDS_WAIT(); asm volatile("" ::: "memory");
    const int c = lane & 7;
#pragma unroll
    for (int j = 0; j < 8; ++j) { const int n = (lane >> 3) + 8 * j; const LAS float* s = scr + (8 * c) * 65 + n;
        v2u o; o.x = pg8::pack4_fp8(s[0 * 65], s[1 * 65], s[2 * 65], s[3 * 65]); o.y = pg8::pack4_fp8(s[4 * 65], s[5 * 65], s[6 * 65], s[7 * 65]);
        __builtin_nontemporal_store(o, (GAS v2u*)(WT + (size_t)rowmap(n0 + n, kind) * K + k0 + 8 * c)); }
    LDS_WAIT(); asm volatile("" ::: "memory");
}
struct MoeItem { const float* W; unsigned char* WT; int K, N, kind, k0, n0; };
__device__ __forceinline__ MoeItem moe_item_desc(Frame& F, int r) {
    const int le = r / 768, q = r % 768, which = q / 256, item = q % 256; MoeItem d;
    if (which == 0) { d.W = F.moe_w_gate + (size_t)le * 1024 * 2048; d.WT = F.ws + WS_WMOE1 + (size_t)le * 4096 * 1024; d.K = 1024; d.N = 2048; d.kind = 2; }
    else if (which == 1) { d.W = F.moe_w_up + (size_t)le * 1024 * 2048; d.WT = F.ws + WS_WMOE1 + (size_t)le * 4096 * 1024; d.K = 1024; d.N = 2048; d.kind = 3; }
    else { d.W = F.moe_w_down + (size_t)le * 2048 * 1024; d.WT = F.ws + WS_WMOE2 + (size_t)le * 1024 * 2048; d.K = 2048; d.N = 1024; d.kind = 0; }
    const int nblk = d.N / 64; d.k0 = 128 * (item / nblk); d.n0 = 64 * (item % nblk); return d;
}
__device__ __forceinline__ void moe_half_load(const MoeItem& d, int h, int lane, f32x4 (&tv)[16]) {
    const float* wp = d.W + (size_t)(d.k0 + 64 * h + 16 * (lane >> 4)) * d.N + d.n0 + 4 * (lane & 15);
#pragma unroll
    for (int i = 0; i < 16; ++i) tv[i] = __builtin_nontemporal_load((const f32x4*)(wp + (size_t)i * d.N));
}
__device__ __forceinline__ void moe_half_pack(int h, LAS unsigned* scr, int lane, const f32x4 (&tv)[16]) {
    LAS unsigned* sp = scr + (4 * (lane & 15)) * 36 + 16 * h + 4 * (lane >> 4);
#pragma unroll
    for (int g = 0; g < 4; ++g) { const f32x4 t0 = tv[4 * g] * pg8::FP8_WGT, t1 = tv[4 * g + 1] * pg8::FP8_WGT, t2 = tv[4 * g + 2] * pg8::FP8_WGT, t3 = tv[4 * g + 3] * pg8::FP8_WGT;
        sp[0 * 36 + g] = pg8::pack4_fp8(t0.x, t1.x, t2.x, t3.x); sp[1 * 36 + g] = pg8::pack4_fp8(t0.y, t1.y, t2.y, t3.y);
        sp[2 * 36 + g] = pg8::pack4_fp8(t0.z, t1.z, t2.z, t3.z); sp[3 * 36 + g] = pg8::pack4_fp8(t0.w, t1.w, t2.w, t3.w); }
}
__device__ __forceinline__ void moe_item_store(const MoeItem& d, LAS unsigned* scr, int lane) {
    LDS_WAIT(); asm volatile("" ::: "memory");
    const int c = lane & 7;
#pragma unroll
    for (int j = 0; j < 8; ++j) { const int n = (lane >> 3) + 8 * j; const v4u o = *(const LAS v4u*)(scr + n * 36 + 4 * c);
        __builtin_nontemporal_store(o, (GAS v4u*)(d.WT + (size_t)rowmap(d.n0 + n, d.kind) * d.K + d.k0 + 16 * c)); }
    LDS_WAIT(); asm volatile("" ::: "memory");
}
template <class RMap>
__device__ __forceinline__ void moe_items_pipelined(Frame& F, LAS float* scr_f, int j0, int step, int jend, const RMap& rmap) {
    f32x4 ta[16], tb[16]; int j = j0; LAS unsigned* scr = (LAS unsigned*)scr_f;
    if (j >= jend) return;
    MoeItem d = moe_item_desc(F, rmap(j)); moe_half_load(d, 0, F.lane, ta);
    for (;;) {
        moe_half_load(d, 1, F.lane, tb);
        moe_half_pack(0, scr, F.lane, ta);
        const int jn = j + step; const bool more = jn < jend; MoeItem dn = d;
        if (more) { dn = moe_item_desc(F, rmap(jn)); moe_half_load(dn, 0, F.lane, ta); }
        moe_half_pack(1, scr, F.lane, tb);
        moe_item_store(d, scr, F.lane);
        if (!more) break;
        d = dn; j = jn;
    }
}
#ifndef Q_OUT_V
#define Q_OUT_V 1
#define Q_DN_V 2
#define Q_SEL_V 2
#endif
constexpr int LITEMS = 12288, Q_EI = 1, Q_AT = 1, Q_OUT = Q_OUT_V, Q_SEL = Q_SEL_V, Q_DN = Q_DN_V;
constexpr int Z_EI = 64 * 8 * Q_EI, Z_AT = 128 * 8 * Q_AT, Z_OUT = 192 * 8 * Q_OUT, Z_SEL = 256 * 6 * Q_SEL, Z_DN = 128 * 8 * Q_DN, Z_OI1 = 192 * 8 + 64 * 8 * 2, Z_OI3 = Z_OI1;
constexpr int G0I = 0, G0A = G0I + Z_EI, G0O = G0A + Z_AT, G0S = G0O + Z_OUT, G0D = G0S + Z_SEL,
              G1I = G0D + Z_DN, G1O = G1I + Z_OI1, G1S = G1O + Z_OUT, G1D = G1S + Z_SEL,
              G2I = G1D + Z_DN, G2A = G2I + Z_EI, G2O = G2A + Z_AT, G2S = G2O + Z_OUT, G2D = G2S + Z_SEL,
              G3I = G2D + Z_DN, GEND = G3I + Z_OI3;
static_assert(GEND <= 3 * LITEMS, "the slots have no cap check");
constexpr int GD = 3 * LITEMS - GEND;
static_assert(GD + G1D >= LITEMS && GD + G2D >= 2 * LITEMS, "a layer's items must be converted before its expert GEMMs");
__device__ __forceinline__ void tail_convert(Frame& F, int l, int kind  , int bx) {
    int start = -1, rank = -1, nrank = 1, cnt = 0;
    if (kind == 0 && (l & 1)) {
        int r1, r2;
        if (l == 1) { r1 = bx < 128 ? bx : (bx >= 192 ? bx - 64 : -1); r2 = bx >= 192 ? bx - 192 : -1; } else { r1 = bx >= 64 ? bx - 64 : -1; r2 = (bx >= 64 && bx < 128) ? bx - 64 : -1; }
        if (r1 < 0) return;
        const int st = (l == 1) ? G1I : G3I, w1 = r1 * 8 + F.wave, w2 = r2 * 8 + F.wave;
        LAS float* scr = (LAS float*)(F.lds + F.wave * 16640);
        moe_items_pipelined(F, scr, 0, 1, r2 >= 0 ? 3 : 1, [=](int k) { return LITEMS + GD + (k == 0 ? st + w1 : st + 192 * 8 + (k - 1) * 64 * 8 + w2); });
        return; }
    if (kind == 0) { const int rem = 192; rank = (bx - rem) * 8 + F.wave; nrank = (256 - rem) * 8; cnt = Q_EI; if (bx < rem) rank = -1; start = (l == 0) ? G0I : G2I; }
    else if (kind == 1) { rank = (bx - 64) * 8 + F.wave; nrank = 192 * 8; cnt = Q_OUT; if (bx < 64) rank = -1; start = (l == 0) ? G0O : (l == 1) ? G1O : (l == 2) ? G2O : -1; }
    else if (kind == 2) { rank = (bx - 128) * 8 + F.wave; nrank = 128 * 8; cnt = Q_DN; if (bx < 128) rank = -1; start = (l == 0) ? G0D : (l == 1) ? G1D : (l == 2) ? G2D : -1; }
    else if (kind == 3) { rank = bx * 6 + F.wave - 2; nrank = 256 * 6; cnt = Q_SEL; if (F.wave < 2) rank = -1; start = (l == 0) ? G0S : (l == 1) ? G1S : (l == 2) ? G2S : -1; }
    else { rank = (bx - 128) * 8 + F.wave; nrank = 128 * 8; cnt = Q_AT; if (bx < 128) rank = -1; start = (l == 0) ? G0A : (l == 2) ? G2A : -1; }
    if (start < 0 || rank < 0) return;
    LAS float* scr = (LAS float*)(F.lds + F.wave * 16640);
    moe_items_pipelined(F, scr, 0, 1, cnt, [=](int k) { return LITEMS + GD + start + k * nrank + rank; });
}
#ifndef P0_REP_A
#define P0_REP_A 1
#define P0_REP_B 1
#endif
__device__ __forceinline__ void p0_prologue(Frame& F) {
    for (int repa_ = 0; repa_ < P0_REP_A; ++repa_) { if (repa_) __syncthreads();
        LAS float* S = (LAS float*)F.lds;
        LAS float* part = S + 17 * 1024;
        for (int idx = F.tid; idx < 17 * 1024; idx += NTHR) { const int r = idx >> 10, d = idx & 1023; const float v = r < 16 ? F.c_in[r * 1024 + d] : F.cctx_in[d]; S[idx] = v / (1.0f + expf(-v)); }
        __syncthreads();
        float* mod = (float*)(F.ws + WS_MOD);
        for (int item = blockIdx.x; item < 4 * 192; item += F.G) {
            const int l = item / 192, cb = item % 192, col = cb * 32 + (F.lane & 31), d0 = F.wave * 128 + 64 * (F.lane >> 5);
            float acc[17], w[64];
#pragma unroll
            for (int r = 0; r < 17; ++r) acc[r] = 0.f;
            const float* wp = F.w_mod + ((size_t)l * 1024 + d0) * 6144 + col;
#pragma unroll
            for (int i = 0; i < 64; ++i) w[i] = __builtin_nontemporal_load(wp + (size_t)i * 6144);
#pragma unroll
            for (int i = 0; i < 16; ++i) {
#pragma unroll
                for (int r = 0; r < 17; ++r) { const f32x4 s4 = *(const LAS f32x4*)(S + r * 1024 + d0 + 4 * i); acc[r] += (s4.x * w[4 * i] + s4.y * w[4 * i + 1]) + (s4.z * w[4 * i + 2] + s4.w * w[4 * i + 3]); } }
#pragma unroll
            for (int r = 0; r < 17; ++r) part[(F.wave * 17 + r) * 64 + F.lane] = acc[r];
            __syncthreads();
            for (int o = F.tid; o < 17 * 32; o += NTHR) { const int r = o >> 5, ln = o & 31; float s = 0.f;
#pragma unroll
                for (int w8 = 0; w8 < 8; ++w8) s += part[(w8 * 17 + r) * 64 + ln] + part[(w8 * 17 + r) * 64 + 32 + ln];
                mod[((size_t)l * 17 + r) * 6144 + cb * 32 + ln] = s + F.b_mod[l * 6144 + cb * 32 + ln]; }
            __syncthreads();
        }
    }
    for (int repb_ = 0; repb_ < P0_REP_B; ++repb_) { if (repb_) { VM_WAIT(); __syncthreads(); }
        LAS float* scr = (LAS float*)(F.lds + F.wave * 16640);
        const int gw = F.vcu * NWAVES + F.wave, NGW = F.G * NWAVES;
        constexpr int I_AIN = 16 * 48, I_SQ = 16 * 16, I_RIN = 16 * 80, I_MOE = 256;
        constexpr int T0 = 2 * I_AIN, T1 = T0 + 2 * I_SQ, T2 = T1 + 2 * I_RIN, T3 = T2 + 2 * I_SQ, NM = LITEMS + GD;
        static_assert(3 * I_MOE == 768 && 16 * 768 == LITEMS, "item arithmetic");
        bf16* wao = (bf16*)(F.ws + WS_WATT_OUT); bf16* wro = (bf16*)(F.ws + WS_WREC_OUT);
        for (int it = gw; it < T3; it += NGW) {
            int r = it;
            if (r < T0) { const int e = r / I_AIN; if (IN8E) transpose_item8(F.att_w_in + (size_t)e * 1024 * 3072, 1024, 3072, F.ws + WS_WATT_IN + (size_t)e * 3072 * 1024, 1, scr, r % I_AIN, F.lane);
                else transpose_item(F.att_w_in + (size_t)e * 1024 * 3072, 1024, 3072, (bf16*)(F.ws + WS_WATT_IN) + (size_t)e * 3072 * 1024, 1, scr, r % I_AIN, F.lane); continue; }
            if (r < T1) { r -= T0; const int e = r / I_SQ; transpose_item(F.att_w_out + (size_t)e * 1024 * 1024, 1024, 1024, wao + (size_t)e * 1024 * 1024, 0, scr, r % I_SQ, F.lane); continue; }
            if (r < T2) { r -= T1; const int e = r / I_RIN, it = r % I_RIN, nb = it % 80;
                if (nb >= 16 && nb < 48) transpose_item8(F.rec_w_in + (size_t)e * 1024 * 5120 + 1024, 1024, 5120, F.ws + WS_WREC_F8 + (size_t)e * 2048 * 1024, 0, scr, it - 16, F.lane);
                else transpose_item(F.rec_w_in + (size_t)e * 1024 * 5120, 1024, 5120, (bf16*)(F.ws + WS_WREC_IN) + (size_t)e * 5120 * 1024, 0, scr, it, F.lane); continue; }
            r -= T2; { const int e = r / I_SQ; transpose_item(F.rec_w_out + (size_t)e * 1024 * 1024, 1024, 1024, wro + (size_t)e * 1024 * 1024, 0, scr, r % I_SQ, F.lane); }
        }
        moe_items_pipelined(F, scr, (gw + NGW / 2) % NGW, NGW, NM, [](int r) { return r; });
    }
}

template <int MODE>
__device__ __forceinline__ void norm_phase(Frame& F, int l, int dbg_src_in = 0) {
    const float* mod = (const float*)(F.ws + WS_MOD);
    bf16* X = (bf16*)(F.ws + WS_X); bf16* H = (bf16*)(F.ws + WS_H);
    const int nrows = (MODE == 2 || (MODE == 1 && l == 3)) ? RL : RT;
    const int per = nrows / (F.G * NWAVES);
    const int gw = F.vcu * NWAVES + F.wave, lane = F.lane;
    LAS float* Wt = (LAS float*)F.lds;
    if (MODE == 1) {
        for (int idx = F.tid; idx < 4096; idx += NTHR) { const int d = idx >> 2, eg = idx & 3; const f32x4 w = *(const f32x4*)(F.moe_router + ((size_t)l * 1024 + d) * 16 + eg * 4);
#pragma unroll
            for (int i = 0; i < 4; ++i) Wt[(eg * 4 + i) * 1024 + d] = w[i]; }
        __syncthreads();
    }
    int cur_b = -1; f32x4 av[4], bv[4];
    const int kind_sh = (MODE == 0) ? 0 : 3, kind_sc = (MODE == 0) ? 1 : 4;
    const bool src_in = (MODE == 0 && l == 0) || (MODE == 2 && dbg_src_in);
    const bool comb = (MODE == 0 && l > 0) || (MODE == 2 && l >= 0);
#define XROW(r) ((r) < RL ? F.x_in + (size_t)(r) * 1024 : F.ctx_in + (size_t)((r) - RL) * 1024)
#define XLOAD(dst, r) do { if (src_in) { const float* xr_ = XROW(r); _Pragma("unroll") for (int j = 0; j < 4; ++j) dst[j] = *(const f32x4*)(xr_ + 256 * j + 4 * lane); } \
        else { const bf16* xr_ = X + (size_t)(r) * 1024; _Pragma("unroll") for (int j = 0; j < 4; ++j) { const v2u w_ = *(const v2u*)(xr_ + 256 * j + 4 * lane); dst[j] = (f32x4){bflo(w_.x), bfhi(w_.x), bflo(w_.y), bfhi(w_.y)}; } } } while (0)
    f32x4 nx[4]; v4u ni0 = {0u, 0u, 0u, 0u}, ni1 = {0u, 0u, 0u, 0u};
    { const int row = gw * per;
      XLOAD(nx, row);
      if (comb) { ni0 = *(const v4u*)(F.ws + WS_INV + (size_t)row * 32); ni1 = *(const v4u*)(F.ws + WS_INV + (size_t)row * 32 + 16); } }
    for (int rr = 0; rr < per; ++rr) {
        const int row = gw * per + rr; const bool latent = row < RL; const int bidx = latent ? (row >> 11) : 16;
        if (MODE != 2 && bidx != cur_b) { cur_b = bidx;
            const float* gq = F.norm_g + ((size_t)l * 2 + (MODE == 0 ? 0 : 1)) * 1024; const float* sc = mod + ((size_t)l * 17 + bidx) * 6144 + kind_sc * 1024; const float* sh = mod + ((size_t)l * 17 + bidx) * 6144 + kind_sh * 1024;
#pragma unroll
            for (int j = 0; j < 4; ++j) { const f32x4 g4 = *(const f32x4*)(gq + 256 * j + 4 * lane), s4 = *(const f32x4*)(sc + 256 * j + 4 * lane); av[j] = g4 * (s4 + 1.0f); bv[j] = *(const f32x4*)(sh + 256 * j + 4 * lane); } }
        f32x4 v[4];
#pragma unroll
        for (int j = 0; j < 4; ++j) v[j] = nx[j];
        const v4u i0 = ni0, i1 = ni1;
        if (rr + 1 < per) { const int rn = row + 1;
            XLOAD(nx, rn);
            if (comb) { ni0 = *(const v4u*)(F.ws + WS_INV + (size_t)rn * 32); ni1 = *(const v4u*)(F.ws + WS_INV + (size_t)rn * 32 + 16); } }
        if (comb) {
            const int lp = (MODE == 2) ? l : l - 1;
            const unsigned iw[8] = {i0.x, i0.y, i0.z, i0.w, i1.x, i1.y, i1.z, i1.w};
            const bf16* Y = (const bf16*)(F.ws + WS_O);
            const int xb = latent ? (row >> 11) * 256 : 4096 + ((row - RL) >> 8) * 32;
            f32x4 a[4];
#pragma unroll
            for (int j = 0; j < 4; ++j) a[j] = (f32x4){0.f, 0.f, 0.f, 0.f};
#pragma unroll
            for (int e = 0; e < 16; ++e) { const unsigned slot = (unsigned)__builtin_amdgcn_readfirstlane((int)((iw[e >> 1] >> (16 * (e & 1))) & 0xffffu));
                if (slot != 0xffffu) { const bf16* yr = Y + (size_t)(e * XR_E + xb + (int)slot) * 1024;
#pragma unroll
                    for (int j = 0; j < 4; ++j) { const v2u w = *(const v2u*)(yr + 256 * j + 4 * lane); a[j] += (f32x4){bflo(w.x), bfhi(w.x), bflo(w.y), bfhi(w.y)}; } } }
            const float* g2 = mod + ((size_t)lp * 17 + bidx) * 6144 + 5 * 1024;
#pragma unroll
            for (int j = 0; j < 4; ++j) { v[j] += *(const f32x4*)(g2 + 256 * j + 4 * lane) * a[j]; if (MODE == 0) { v2u w; w.x = pk2(v[j].x, v[j].y); w.y = pk2(v[j].z, v[j].w); *(v2u*)(X + (size_t)row * 1024 + 256 * j + 4 * lane) = w; } }
        }
        float ss = 0.f;
#pragma unroll
        for (int j = 0; j < 4; ++j) ss += (v[j].x * v[j].x + v[j].y * v[j].y) + (v[j].z * v[j].z + v[j].w * v[j].w);
        const float rstd = 1.0f / sqrtf(wave_sum(ss) * (1.0f / 1024.0f) + NORM_EPS);
        if (MODE == 2) {
#pragma unroll
            for (int j = 0; j < 4; ++j) *(f32x4*)(F.out + (size_t)row * 1024 + 256 * j + 4 * lane) = v[j] * rstd * *(const f32x4*)(F.final_g + 256 * j + 4 * lane);
            continue;
        }
        f32x4 hv[4];
#pragma unroll
        for (int j = 0; j < 4; ++j) { hv[j] = v[j] * rstd * av[j] + bv[j];
            if (MODE == 1 || (MODE == 0 && IN8E)) *(unsigned*)((unsigned char*)H + (size_t)row * 1024 + 256 * j + 4 * lane) = pg8::pack4_fp8(hv[j].x * pg8::FP8_ACT, hv[j].y * pg8::FP8_ACT, hv[j].z * pg8::FP8_ACT, hv[j].w * pg8::FP8_ACT);
            else { v2u w; w.x = pk2(hv[j].x, hv[j].y); w.y = pk2(hv[j].z, hv[j].w); *(v2u*)(H + (size_t)row * 1024 + 256 * j + 4 * lane) = w; } }
        if (MODE == 1) {
            float sp[16];
#pragma unroll
            for (int e = 0; e < 16; ++e) { float s = 0.f;
#pragma unroll
                for (int j = 0; j < 4; ++j) { const f32x4 w = *(const LAS f32x4*)(Wt + e * 1024 + 256 * j + 4 * lane); s += (hv[j].x * w.x + hv[j].y * w.y) + (hv[j].z * w.z + hv[j].w * w.w); }
                sp[e] = s; if ((e & 3) == 3) __builtin_amdgcn_sched_barrier(0); }
            { const bool b5 = (lane & 32) != 0, b4 = (lane & 16) != 0, b3 = (lane & 8) != 0, b2 = (lane & 4) != 0;
#pragma unroll
              for (int i = 0; i < 8; ++i) { const float mn = b5 ? sp[8 + i] : sp[i], ot = b5 ? sp[i] : sp[8 + i]; sp[i] = mn + __shfl_xor(ot, 32); }
#pragma unroll
              for (int i = 0; i < 4; ++i) { const float mn = b4 ? sp[4 + i] : sp[i], ot = b4 ? sp[i] : sp[4 + i]; sp[i] = mn + __shfl_xor(ot, 16); }
#pragma unroll
              for (int i = 0; i < 2; ++i) { const float mn = b3 ? sp[2 + i] : sp[i], ot = b3 ? sp[i] : sp[2 + i]; sp[i] = mn + __shfl_xor(ot, 8); }
              { const float mn = b2 ? sp[1] : sp[0], ot = b2 ? sp[0] : sp[1]; sp[0] = mn + __shfl_xor(ot, 4); }
              sp[0] += __shfl_xor(sp[0], 2); sp[0] += __shfl_xor(sp[0], 1); }
            float mine = sp[0], mx = mine;
#pragma unroll
            for (int o = 4; o < 64; o <<= 1) mx = fmaxf(mx, __shfl_xor(mx, o));
            const float ex = expf(mine - mx); float sum = ex;
#pragma unroll
            for (int o = 4; o < 64; o <<= 1) sum += __shfl_xor(sum, o);
            mine = ex / sum;
            const int eo = ((lane >> 5) & 1) * 8 + ((lane >> 4) & 1) * 4 + ((lane >> 3) & 1) * 2 + ((lane >> 2) & 1);
            if ((lane & 3) == 0) { float* aff = (float*)(F.ws + WS_AFF);
                if (latent) aff[((size_t)(row >> 11) * 16 + eo) * 2048 + (row & 2047)] = mine;
                else { const int rc = row - RL; aff[(size_t)524288 + ((size_t)(rc >> 8) * 16 + eo) * 256 + (rc & 255)] = mine; } }
        }
    }
    if (MODE == 1) __syncthreads();
#undef XROW
#undef XLOAD
}

__device__ __forceinline__ void router_norm_phase(Frame& F, int l) {
    const float* mod = (const float*)(F.ws + WS_MOD);
    const bf16* X = (const bf16*)(F.ws + WS_X); unsigned char* H8 = F.ws + WS_H;
    const int nrows = (l == 3) ? RL : RT, per = nrows / (F.G * NWAVES), gw = F.vcu * NWAVES + F.wave, lane = F.lane;
    LAS float* Wt = (LAS float*)F.lds;
    { f32x4 wv_[8];
#pragma unroll
      for (int k_ = 0; k_ < 8; ++k_) { const int idx = F.tid + k_ * NTHR; wv_[k_] = *(const f32x4*)(F.moe_router + ((size_t)l * 1024 + (idx >> 2)) * 16 + (idx & 3) * 4); }
#pragma unroll
      for (int k_ = 0; k_ < 8; ++k_) { const int idx = F.tid + k_ * NTHR, d = idx >> 2, eg = idx & 3;
#pragma unroll
          for (int i = 0; i < 4; ++i) Wt[(eg * 4 + i) * 1024 + d] = wv_[k_][i]; } }
    __syncthreads();
    int cur_b = -1; f32x4 av[4], bv[4];
    v2u nxa[4], nxb[4];
#ifndef N1_REP
#define N1_REP 1
#endif
#pragma unroll 1
    for (int n1rep_ = 0; n1rep_ < N1_REP; ++n1rep_) {
    { const bf16* xr = X + (size_t)(gw * per) * 1024;
#pragma unroll
      for (int j = 0; j < 4; ++j) { nxa[j] = *(const v2u*)(xr + 256 * j + 4 * lane); nxb[j] = *(const v2u*)(xr + 1024 + 256 * j + 4 * lane); } }
    const bool b5 = (lane & 32) != 0, b4 = (lane & 16) != 0, b3 = (lane & 8) != 0, b2 = (lane & 4) != 0;
    const int eo = ((lane >> 5) & 1) * 8 + ((lane >> 4) & 1) * 4 + ((lane >> 3) & 1) * 2 + ((lane >> 2) & 1);
    for (int rr = 0; rr < per; rr += 2) {
        const int row = gw * per + rr; const bool latent = row < RL; const int bidx = latent ? (row >> 11) : 16;
        if (bidx != cur_b) { cur_b = bidx;
            const float* gq = F.norm_g + ((size_t)l * 2 + 1) * 1024; const float* sc = mod + ((size_t)l * 17 + bidx) * 6144 + 4 * 1024; const float* sh = mod + ((size_t)l * 17 + bidx) * 6144 + 3 * 1024;
#pragma unroll
            for (int j = 0; j < 4; ++j) { const f32x4 g4 = *(const f32x4*)(gq + 256 * j + 4 * lane), s4 = *(const f32x4*)(sc + 256 * j + 4 * lane); av[j] = g4 * (s4 + 1.0f); bv[j] = *(const f32x4*)(sh + 256 * j + 4 * lane); } }
        f32x4 va[4], vb[4];
#pragma unroll
        for (int j = 0; j < 4; ++j) { va[j] = (f32x4){bflo(nxa[j].x), bfhi(nxa[j].x), bflo(nxa[j].y), bfhi(nxa[j].y)}; vb[j] = (f32x4){bflo(nxb[j].x), bfhi(nxb[j].x), bflo(nxb[j].y), bfhi(nxb[j].y)}; }
        if (rr + 2 < per) { const bf16* xr = X + (size_t)(row + 2) * 1024;
#pragma unroll
            for (int j = 0; j < 4; ++j) { nxa[j] = *(const v2u*)(xr + 256 * j + 4 * lane); nxb[j] = *(const v2u*)(xr + 1024 + 256 * j + 4 * lane); } }
        float ssa = 0.f, ssb = 0.f;
#pragma unroll
        for (int j = 0; j < 4; ++j) { ssa += (va[j].x * va[j].x + va[j].y * va[j].y) + (va[j].z * va[j].z + va[j].w * va[j].w); ssb += (vb[j].x * vb[j].x + vb[j].y * vb[j].y) + (vb[j].z * vb[j].z + vb[j].w * vb[j].w); }
        ssa = wave_sum_x(ssa); ssb = wave_sum_x(ssb);
        const float rsa = 1.0f / sqrtf(ssa * (1.0f / 1024.0f) + NORM_EPS), rsb = 1.0f / sqrtf(ssb * (1.0f / 1024.0f) + NORM_EPS);
#pragma unroll
        for (int j = 0; j < 4; ++j) { va[j] = va[j] * rsa * av[j] + bv[j]; vb[j] = vb[j] * rsb * av[j] + bv[j];
            *(unsigned*)(H8 + (size_t)row * 1024 + 256 * j + 4 * lane) = pg8::pack4_fp8(va[j].x * pg8::FP8_ACT, va[j].y * pg8::FP8_ACT, va[j].z * pg8::FP8_ACT, va[j].w * pg8::FP8_ACT);
            *(unsigned*)(H8 + (size_t)(row + 1) * 1024 + 256 * j + 4 * lane) = pg8::pack4_fp8(vb[j].x * pg8::FP8_ACT, vb[j].y * pg8::FP8_ACT, vb[j].z * pg8::FP8_ACT, vb[j].w * pg8::FP8_ACT); }
        float spa[16], spb[16];
        pg8::f32x2 h2[16];
#pragma unroll
        for (int j = 0; j < 4; ++j) { h2[4 * j] = (pg8::f32x2){va[j].x, vb[j].x}; h2[4 * j + 1] = (pg8::f32x2){va[j].y, vb[j].y}; h2[4 * j + 2] = (pg8::f32x2){va[j].z, vb[j].z}; h2[4 * j + 3] = (pg8::f32x2){va[j].w, vb[j].w}; }
#pragma unroll
        for (int e = 0; e < 16; ++e) { pg8::f32x2 s0 = {0.f, 0.f}, s1 = {0.f, 0.f};
#pragma unroll
            for (int j = 0; j < 4; ++j) { const f32x4 w = *(const LAS f32x4*)(Wt + e * 1024 + 256 * j + 4 * lane);
                s0 = __builtin_elementwise_fma(h2[4 * j], (pg8::f32x2){w.x, w.x}, s0); s1 = __builtin_elementwise_fma(h2[4 * j + 1], (pg8::f32x2){w.y, w.y}, s1);
                s0 = __builtin_elementwise_fma(h2[4 * j + 2], (pg8::f32x2){w.z, w.z}, s0); s1 = __builtin_elementwise_fma(h2[4 * j + 3], (pg8::f32x2){w.w, w.w}, s1); }
            const pg8::f32x2 st = s0 + s1; spa[e] = st.x; spb[e] = st.y; if ((e & 3) == 3) __builtin_amdgcn_sched_barrier(0); }
#pragma unroll
        for (int i = 0; i < 8; ++i) { spa[i] = sw32sum(spa[i], spa[8 + i]); spb[i] = sw32sum(spb[i], spb[8 + i]); }
#pragma unroll
        for (int i = 0; i < 4; ++i) { spa[i] = sw16sum(spa[i], spa[4 + i]); spb[i] = sw16sum(spb[i], spb[4 + i]); }
#pragma unroll
        for (int i = 0; i < 2; ++i) { const float ma = b3 ? spa[2 + i] : spa[i], oa = b3 ? spa[i] : spa[2 + i], mb = b3 ? spb[2 + i] : spb[i], ob = b3 ? spb[i] : spb[2 + i]; spa[i] = ma + lx8(oa); spb[i] = mb + lx8(ob); }
        { const float ma = b2 ? spa[1] : spa[0], oa = b2 ? spa[0] : spa[1], mb = b2 ? spb[1] : spb[0], ob = b2 ? spb[0] : spb[1]; spa[0] = ma + lx4(oa); spb[0] = mb + lx4(ob); }
        spa[0] += lx2(spa[0]); spb[0] += lx2(spb[0]); spa[0] += lx1(spa[0]); spb[0] += lx1(spb[0]);
        float mxa = spa[0], mxb = spb[0];
        mxa = fmaxf(mxa, lx4(mxa)); mxb = fmaxf(mxb, lx4(mxb)); mxa = fmaxf(mxa, lx8(mxa)); mxb = fmaxf(mxb, lx8(mxb)); mxa = sw16max(mxa); mxb = sw16max(mxb); mxa = sw32max(mxa); mxb = sw32max(mxb);
        const float exa = expf(spa[0] - mxa), exb = expf(spb[0] - mxb); float sma = exa, smb = exb;
        sma += lx4(sma); smb += lx4(smb); sma += lx8(sma); smb += lx8(smb); sma = sw16sum(sma, sma); smb = sw16sum(smb, smb); sma = sw32sum(sma, sma); smb = sw32sum(smb, smb);
        const float pa = exa / sma, pb = exb / smb;
        if ((lane & 3) == 0) { float* aff = (float*)(F.ws + WS_AFF);
            if (latent) { float* ap = aff + ((size_t)(row >> 11) * 16 + eo) * 2048 + (row & 2047); ap[0] = pa; ap[1] = pb; }
            else { const int rc = row - RL; float* ap = aff + (size_t)524288 + ((size_t)(rc >> 8) * 16 + eo) * 256 + (rc & 255); ap[0] = pa; ap[1] = pb; } }
    }
    }
    __syncthreads();
}

template <bool FINAL>
__device__ __forceinline__ void combine_norm_phase(Frame& F, int l, int lp) {
    const float* mod = (const float*)(F.ws + WS_MOD);
    bf16* X = (bf16*)(F.ws + WS_X); bf16* H = (bf16*)(F.ws + WS_H); const unsigned char* Y = F.ws + WS_O;
    const int nrows = FINAL ? RL : RT, per = nrows / (F.G * NWAVES), gw = F.vcu * NWAVES + F.wave, lane = F.lane, row0 = gw * per, rowend = row0 + per;
    struct XRow { v2u x[4]; };
    struct YBuf { unsigned y[4][4]; };
#define Y4F(w_) ({ const unsigned w__ = (w_); const pg8::f32x2 lo__ = __builtin_amdgcn_cvt_pk_f32_fp8((int)w__, false), hi__ = __builtin_amdgcn_cvt_pk_f32_fp8((int)w__, true); (f32x4){lo__.x, lo__.y, hi__.x, hi__.y}; })
    auto load_x = [&](XRow& R, int row) { if (row < rowend) {
#pragma unroll
        for (int j = 0; j < 4; ++j) R.x[j] = *(const v2u*)(X + (size_t)row * 1024 + 256 * j + 4 * lane); } };
    auto load_inv = [&](int row) -> unsigned { return (row < rowend) ? *(const unsigned*)(F.ws + WS_INV + (size_t)row * 32 + 4 * (lane & 7)) : 0xffffffffu; };
    auto mask_of = [&](unsigned inv) -> unsigned { unsigned m = 0u;
#pragma unroll
        for (int q = 0; q < 8; ++q) { const unsigned w = (unsigned)__builtin_amdgcn_readlane((int)inv, q); m |= ((w & 0xffffu) != 0xffffu ? 1u : 0u) << (2 * q); m |= ((w >> 16) != 0xffffu ? 1u : 0u) << (2 * q + 1); }
        return m; };
    auto slot_of = [&](unsigned inv, int e) -> int { unsigned w = 0u;
#pragma unroll
        for (int q = 0; q < 8; ++q) { const unsigned wq = (unsigned)__builtin_amdgcn_readlane((int)inv, q); w = ((e >> 1) == q) ? wq : w; }
        return (int)((w >> (16 * (e & 1))) & 0xffffu); };
    auto yrow = [&](int row, int e, int slot) -> const unsigned char* { const int xb = row < RL ? (row >> 11) * 256 : 4096 + ((row - RL) >> 8) * 32; return Y + (size_t)(e * XR_E + xb + slot) * 1024; };
    auto prefetch_y = [&](YBuf& B, unsigned inv, int row) { unsigned m = mask_of(inv);
#pragma unroll
        for (int k = 0; k < 4; ++k) { if (m) { const int e = __builtin_ctz(m); m &= m - 1u; const unsigned char* yr = yrow(row, e, slot_of(inv, e));
#pragma unroll
            for (int j = 0; j < 4; ++j) B.y[k][j] = *(const unsigned*)(yr + 256 * j + 4 * lane); } } };
    int cur_b = -1; f32x4 av[4], bv[4], g2v[4];
    const bool h8 = (l & 1) ? IN8O : IN8E;
    auto do_row = [&](const XRow& R, unsigned inv, const YBuf& B, int row) {
        const bool latent = row < RL; const int bidx = latent ? (row >> 11) : 16;
        if (bidx != cur_b) { cur_b = bidx;
            const float* g2 = mod + ((size_t)lp * 17 + bidx) * 6144 + 5 * 1024;
            const float* gq = FINAL ? F.final_g : F.norm_g + ((size_t)l * 2) * 1024; const float* sc = mod + ((size_t)l * 17 + bidx) * 6144 + 1 * 1024; const float* sh = mod + ((size_t)l * 17 + bidx) * 6144;
#pragma unroll
            for (int j = 0; j < 4; ++j) { g2v[j] = *(const f32x4*)(g2 + 256 * j + 4 * lane) * (1.0f / pg8::FP8_Y); const f32x4 g4 = *(const f32x4*)(gq + 256 * j + 4 * lane);
                if (FINAL) { av[j] = g4; bv[j] = (f32x4){0.f, 0.f, 0.f, 0.f}; } else { av[j] = g4 * (*(const f32x4*)(sc + 256 * j + 4 * lane) + 1.0f); bv[j] = *(const f32x4*)(sh + 256 * j + 4 * lane); } } }
        f32x4 a[4];
#pragma unroll
        for (int j = 0; j < 4; ++j) a[j] = (f32x4){0.f, 0.f, 0.f, 0.f};
        unsigned m = mask_of(inv);
#pragma unroll
        for (int k = 0; k < 4; ++k) { if (m) { m &= m - 1u;
#pragma unroll
            for (int j = 0; j < 4; ++j) a[j] += Y4F(B.y[k][j]); } }
        while (m) { const int e = __builtin_ctz(m); m &= m - 1u; const unsigned char* yr = yrow(row, e, slot_of(inv, e));
#pragma unroll
            for (int j = 0; j < 4; ++j) a[j] += Y4F(*(const unsigned*)(yr + 256 * j + 4 * lane)); }
        f32x4 v[4]; float ss = 0.f;
#pragma unroll
        for (int j = 0; j < 4; ++j) { v[j] = (f32x4){bflo(R.x[j].x), bfhi(R.x[j].x), bflo(R.x[j].y), bfhi(R.x[j].y)} + g2v[j] * a[j];
            if (!FINAL) { v2u w; w.x = pk2(v[j].x, v[j].y); w.y = pk2(v[j].z, v[j].w); *(v2u*)(X + (size_t)row * 1024 + 256 * j + 4 * lane) = w; } ss += (v[j].x * v[j].x + v[j].y * v[j].y) + (v[j].z * v[j].z + v[j].w * v[j].w); }
        const float rstd = 1.0f / sqrtf(wave_sum(ss) * (1.0f / 1024.0f) + NORM_EPS);
#pragma unroll
        for (int j = 0; j < 4; ++j) { const f32x4 hv = v[j] * rstd * av[j] + bv[j];
            if (FINAL) *(f32x4*)(F.out + (size_t)row * 1024 + 256 * j + 4 * lane) = hv;
            else if (h8) *(unsigned*)((unsigned char*)H + (size_t)row * 1024 + 256 * j + 4 * lane) = pg8::pack4_fp8(hv.x * pg8::FP8_ACT, hv.y * pg8::FP8_ACT, hv.z * pg8::FP8_ACT, hv.w * pg8::FP8_ACT);
            else { v2u w; w.x = pk2(hv.x, hv.y); w.y = pk2(hv.z, hv.w); *(v2u*)(H + (size_t)row * 1024 + 256 * j + 4 * lane) = w;
                if (l & 1) *(unsigned*)(F.ws + WS_H8O + (size_t)row * 1024 + 256 * j + 4 * lane) = pg8::pack4_fp8(hv.x * pg8::FP8_ACT, hv.y * pg8::FP8_ACT, hv.z * pg8::FP8_ACT, hv.w * pg8::FP8_ACT); } } };
    XRow XA, XB, XC, XD; YBuf YA, YB, YC, YD;
    unsigned iA = load_inv(row0), iB = load_inv(row0 + 1), iC = load_inv(row0 + 2), iD = load_inv(row0 + 3);
    load_x(XA, row0); load_x(XB, row0 + 1);
    prefetch_y(YA, iA, row0); prefetch_y(YB, iB, row0 + 1);
    for (int rr = 0; rr < per; rr += 2) {
        const int row = row0 + rr;
        load_x(XC, row + 2); load_x(XD, row + 3);
        const unsigned iE = load_inv(row + 4), iF = load_inv(row + 5);
        if (rr + 2 < per) { prefetch_y(YC, iC, row + 2); prefetch_y(YD, iD, row + 3); }
        do_row(XA, iA, YA, row);
        do_row(XB, iB, YB, row + 1);
        XA = XC; XB = XD; YA = YC; YB = YD; iA = iC; iB = iD; iC = iE; iD = iF;
    }
}

template <int NPL>
__device__ __forceinline__ void select_wave(const float* aff, int cap, int lane, LAS unsigned short* idx_lds, float* gate, unsigned short* inv, unsigned short* gidx, int rowbase) {
    unsigned v[NPL];
#pragma unroll
    for (int q = 0; q < NPL / 4; ++q) { const v4u w = *(const v4u*)(aff + lane * NPL + 4 * q); v[4 * q] = w.x; v[4 * q + 1] = w.y; v[4 * q + 2] = w.z; v[4 * q + 3] = w.w; }
    unsigned T = 0;
    for (int bit = 30; bit >= 0; --bit) { const unsigned cand = T | (1u << bit); int cnt = 0;
#pragma unroll
        for (int k = 0; k < NPL; ++k) cnt += __popcll(__ballot(v[k] >= cand));
        if (cnt >= cap) T = cand; }
    int cg = 0, ce = 0;
#pragma unroll
    for (int k = 0; k < NPL; ++k) { cg += (v[k] > T) ? 1 : 0; ce += (v[k] == T) ? 1 : 0; }
    const int need = cap - wave_sum_i(cg);
    int er = wave_incl_scan(ce, lane) - ce; int cs = 0; unsigned selmask = 0;
#pragma unroll
    for (int k = 0; k < NPL; ++k) { bool sel = v[k] > T; if (v[k] == T) { sel = er < need; ++er; } selmask |= (sel ? 1u : 0u) << k; cs += sel ? 1 : 0; }
    int slot = wave_incl_scan(cs, lane) - cs;
#pragma unroll
    for (int k = 0; k < NPL; ++k) { const int t = lane * NPL + k;
        if ((selmask >> k) & 1u) { idx_lds[slot] = (unsigned short)t; gidx[slot] = (unsigned short)(rowbase + t); gate[slot] = __builtin_bit_cast(float, v[k]); inv[(size_t)t * 16] = (unsigned short)slot; ++slot; }
        else inv[(size_t)t * 16] = (unsigned short)0xffffu; }
}
__device__ __forceinline__ void select_phase(Frame& F, int l, int parts = 3) {
    LAS unsigned short* idxL = (LAS unsigned short*)F.lds;
    LAS unsigned short* idxC = idxL + 256;
    const float* aff = (const float*)(F.ws + WS_AFF); float* gate = (float*)(F.ws + WS_GATE); unsigned short* inv = (unsigned short*)(F.ws + WS_INV);
    const unsigned char* H8 = F.ws + WS_H; unsigned char* XS = F.ws + WS_O;
    unsigned short* gix = (unsigned short*)(F.ws + WS_IDX);
    const bool with_ctx = l < 3;
    for (int u = F.vcu; u < 256; u += F.G) {
        const int b = u >> 4, e = u & 15;
        if ((parts & 1) && F.wave == 0) select_wave<32>(aff + ((size_t)b * 16 + e) * 2048, CAPL, F.lane, idxL, gate + (size_t)e * XR_E + b * 256, inv + (size_t)(b * 2048) * 16 + e, gix + (size_t)e * XR_E + b * 256, b * 2048);
        if ((parts & 1) && F.wave == 1 && with_ctx) select_wave<4>(aff + 524288 + ((size_t)b * 16 + e) * 256, CAPC, F.lane, idxC, gate + (size_t)e * XR_E + 4096 + b * 32, inv + (size_t)(RL + b * 256) * 16 + e, gix + (size_t)e * XR_E + 4096 + b * 32, RL + b * 256);
        __syncthreads();
        if (parts & 2) {
#pragma unroll 1
        for (int r0 = F.wave * 32; r0 < F.wave * 32 + 32; r0 += 8) { v4u tmp[8];
#pragma unroll
            for (int q = 0; q < 8; ++q) tmp[q] = ((const v4u*)(H8 + (size_t)(b * 2048 + (int)idxL[r0 + q]) * 1024))[F.lane];
#pragma unroll
            for (int q = 0; q < 8; ++q) ((v4u*)(XS + (size_t)(e * XR_E + b * 256 + r0 + q) * 1024))[F.lane] = tmp[q]; }
        if (with_ctx) { v4u tmp[4];
#pragma unroll
            for (int q = 0; q < 4; ++q) tmp[q] = ((const v4u*)(H8 + (size_t)(RL + b * 256 + (int)idxC[F.wave * 4 + q]) * 1024))[F.lane];
#pragma unroll
            for (int q = 0; q < 4; ++q) ((v4u*)(XS + (size_t)(e * XR_E + 4096 + b * 32 + F.wave * 4 + q) * 1024))[F.lane] = tmp[q]; }
        }
        __syncthreads();
    }
}


namespace att {
constexpr int SHM_V = 64 * 128 * 2, SHM_K = 64 * 128 * 2;
constexpr int OFF_V = 0, OFF_K = 2 * SHM_V, OFF_WS = OFF_K + 2 * SHM_K, OFF_RPB = OFF_WS + 8 * 1024, OFF_Q = OFF_RPB, OFF_END = OFF_Q + 8 * 8192;
#define KSWZ(row, colB) ((row) * 256 + ((colB) ^ (((row) & 7) << 4)))
#define SBAR() __builtin_amdgcn_sched_barrier(0)
__device__ __forceinline__ int crow(int r, int hi) { return (r & 3) + 8 * (r >> 2) + 4 * hi; }
__device__ __forceinline__ unsigned cvtpk(float lo, float hi) { return pg8::cvt_pk_bf16(lo, hi); }
__device__ __forceinline__ int v_st(int k, int c) { const int kk = (k & ~0xC) | ((k & 4) << 1) | ((k & 8) >> 1); return ((kk >> 3) * 4 + (c >> 5)) * 512 + ((kk & 7) * 32 + (c & 31)) * 2; }
__device__ __forceinline__ int v_rd_base(int lane) { return ((lane & 3) << 3) | (((lane >> 2) & 3) << 6) | (((lane >> 4) & 1) << 5) | (((lane >> 5) & 1) << 8); }
constexpr int v_rd_off(int d0, int ks, int half) { return d0 * 512 + ks * 4096 + half * 2048; }
template <int OFF> __device__ __forceinline__ s16x4 tr_read(int vb) { s16x4 r; asm volatile("ds_read_b64_tr_b16 %0, %1 offset:%2" : "=&v"(r) : "v"(vb), "i"(OFF) : "memory"); return r; }
template <int D0> __device__ __forceinline__ void pv_one(f32x16& od, int vb, bf16x8 pa0, bf16x8 pa1, bf16x8 pa2, bf16x8 pa3) {
    const s16x4 l0 = tr_read<v_rd_off(D0, 0, 0)>(vb), h0 = tr_read<v_rd_off(D0, 0, 1)>(vb), l1 = tr_read<v_rd_off(D0, 1, 0)>(vb), h1 = tr_read<v_rd_off(D0, 1, 1)>(vb);
    const s16x4 l2 = tr_read<v_rd_off(D0, 2, 0)>(vb), h2 = tr_read<v_rd_off(D0, 2, 1)>(vb), l3 = tr_read<v_rd_off(D0, 3, 0)>(vb), h3 = tr_read<v_rd_off(D0, 3, 1)>(vb);
    asm volatile("s_waitcnt lgkmcnt(0)" ::: "memory"); SBAR();
#define PKV(L, H) (bf16x8){L[0], L[1], L[2], L[3], H[0], H[1], H[2], H[3]}
    __builtin_amdgcn_s_setprio(1);
    od = __builtin_amdgcn_mfma_f32_32x32x16_bf16(pa0, PKV(l0, h0), od, 0, 0, 0);
    od = __builtin_amdgcn_mfma_f32_32x32x16_bf16(pa1, PKV(l1, h1), od, 0, 0, 0);
    od = __builtin_amdgcn_mfma_f32_32x32x16_bf16(pa2, PKV(l2, h2), od, 0, 0, 0);
    od = __builtin_amdgcn_mfma_f32_32x32x16_bf16(pa3, PKV(l3, h3), od, 0, 0, 0);
    __builtin_amdgcn_s_setprio(0);
#undef PKV
}
template <int MAP, bool QLDS> __device__ __forceinline__ void qkt_map(f32x16& p0, f32x16& p1, const LAS char* Ks, const bf16x8* qr, const LAS char* ql, int r32, int hi) {
    p0 = f32x16{}; p1 = f32x16{};
#pragma unroll
    for (int d0 = 4 * MAP; d0 < 4 * MAP + 4; ++d0) { const int cb = (d0 * 16 + hi * 8) * 2;
        const bf16x8 b0 = *(const LAS bf16x8*)(Ks + KSWZ(r32, cb));
        const bf16x8 b1 = *(const LAS bf16x8*)(Ks + KSWZ(32 + r32, cb));
        const bf16x8 q = QLDS ? *(const LAS bf16x8*)(ql + d0 * 1024) : qr[QLDS ? 0 : d0];
        p0 = __builtin_amdgcn_mfma_f32_32x32x16_bf16(b0, q, p0, 0, 0, 0);
        p1 = __builtin_amdgcn_mfma_f32_32x32x16_bf16(b1, q, p1, 0, 0, 0); }
}
template <bool RAW>
__device__ __forceinline__ void sm_step(f32x16& p0, f32x16& p1, float& m, float& l, float& alpha, bf16x8& pa0, bf16x8& pa1, bf16x8& pa2, bf16x8& pa3) {
    constexpr float C = 0.125f * 1.4426950408889634f;
    float pmax = p0[0];
#pragma unroll
    for (int r = 1; r < 16; ++r) pmax = fmaxf(pmax, p0[r]);
#pragma unroll
    for (int r = 0; r < 16; ++r) pmax = fmaxf(pmax, p1[r]);
    { auto rr = __builtin_amdgcn_permlane32_swap(__float_as_uint(pmax), __float_as_uint(pmax), false, false); pmax = fmaxf(__uint_as_float(rr[0]), __uint_as_float(rr[1])); }
    float mn;
    if (__builtin_expect(__all(pmax - m <= (RAW ? 64.0f : 11.5416f)), 1)) { mn = m; alpha = 1.f; }
    else { mn = fmaxf(m, pmax); alpha = __builtin_amdgcn_exp2f(RAW ? (m - mn) * C : (m - mn)); m = mn; }
    const float mnc = RAW ? -mn * C : -mn;
    typedef float f2v __attribute__((ext_vector_type(2)));
    f2v psv = {0.f, 0.f}; const f2v cv = {C, C}, mv = {mnc, mnc};
#pragma unroll
    for (int r = 0; r < 16; r += 2) { f2v t = {p0[r], p0[r + 1]}; t = RAW ? __builtin_elementwise_fma(t, cv, mv) : t + mv; t.x = __builtin_amdgcn_exp2f(t.x); t.y = __builtin_amdgcn_exp2f(t.y); p0[r] = t.x; p0[r + 1] = t.y; psv += t; }
#pragma unroll
    for (int r = 0; r < 16; r += 2) { f2v t = {p1[r], p1[r + 1]}; t = RAW ? __builtin_elementwise_fma(t, cv, mv) : t + mv; t.x = __builtin_amdgcn_exp2f(t.x); t.y = __builtin_amdgcn_exp2f(t.y); p1[r] = t.x; p1[r + 1] = t.y; psv += t; }
    float ps = psv.x + psv.y;
    { auto rr = __builtin_amdgcn_permlane32_swap(__float_as_uint(ps), __float_as_uint(ps), false, false); ps = __uint_as_float(rr[0]) + __uint_as_float(rr[1]); }
    l = l * alpha + ps;
#define PK4(P, BASE, OUT) do { unsigned a0 = cvtpk(P[BASE + 0], P[BASE + 1]), a1 = cvtpk(P[BASE + 2], P[BASE + 3]);   \
    unsigned b0 = cvtpk(P[BASE + 4], P[BASE + 5]), b1 = cvtpk(P[BASE + 6], P[BASE + 7]);                              \
    auto r0 = __builtin_amdgcn_permlane32_swap(a0, b0, false, false); auto r1 = __builtin_amdgcn_permlane32_swap(a1, b1, false, false); \
    v4u w = {r0[0], r1[0], r0[1], r1[1]}; OUT = __builtin_bit_cast(bf16x8, w); } while (0)
    PK4(p0, 0, pa0); PK4(p0, 8, pa1); PK4(p1, 0, pa2); PK4(p1, 8, pa3);
#undef PK4
}

struct UnitDesc {
    int qrow0;
    int qcol, kcol, vcol, ocol;
    int nloc, loc_row0, ctx_row0;
    int na_local;
    int qr0, kr0;
    int rpb_off;
};

template <bool DIFF>
__device__ __forceinline__ void attn_unit(LAS unsigned char* lds, const bf16* __restrict__ P, bf16* __restrict__ Out, const UnitDesc U, const float* __restrict__ rpb,
                                          float lam, float oscale, const float* __restrict__ subln_g, int wid_in) {
    int lane_; asm volatile("v_mbcnt_lo_u32_b32 %0, -1, 0\n\tv_mbcnt_hi_u32_b32 %0, -1, %0" : "=v"(lane_));
    const int lane = lane_, wid = wid_in, tid = wid * 64 + lane, r32 = lane & 31, hi = lane >> 5;
    constexpr float L2E = 1.4426950408889634f, C = 0.125f * L2E;
    LAS char* V_lds = (LAS char*)lds + OFF_V; LAS char* K_lds = (LAS char*)lds + OFF_K;
    LAS float* wsc = (LAS float*)(lds + OFF_WS) + wid * 256;
    LAS float* rpbx = (LAS float*)(lds + OFF_RPB);
    if (!DIFF && U.na_local) {
        float tv_[8];
#pragma unroll
        for (int k_ = 0; k_ < 8; ++k_) { const int idx = tid + k_ * NTHR; const int hd = idx / 1920, rem = idx % 1920, dr = rem >> 7, x = rem & 127;
            tv_[k_] = (idx < 2 * 15 * 128 && x >= 48 && x <= 78) ? rpb[U.rpb_off + hd * 465 + dr * 31 + (x - 48)] * L2E : 0.f; }
#pragma unroll
        for (int k_ = 0; k_ < 8; ++k_) { const int idx = tid + k_ * NTHR; if (idx < 2 * 15 * 128) rpbx[idx] = tv_[k_]; }
    }
    bf16x8 qr[DIFF ? 1 : 8];
    const LAS char* ql = (const LAS char*)lds + OFF_Q + wid * 8192 + lane * 16;
    { const bf16* Qw = P + (size_t)(U.qrow0 + wid * 32 + r32) * LD_EVEN + U.qcol + hi * 8;
#pragma unroll
      for (int d0 = 0; d0 < 8; ++d0) { const bf16x8 q = *(const bf16x8*)(Qw + d0 * 16); if (DIFF) *(LAS bf16x8*)((LAS char*)lds + OFF_Q + wid * 8192 + lane * 16 + d0 * 1024) = q; else qr[DIFF ? 0 : d0] = q; } }
    unsigned gK[2], gV[2];
#pragma unroll
    for (int p = 0; p < 2; ++p) { const int o = (2 * wid + p) * 1024 + 16 * lane;
        { const int row = o >> 8, cb = (o & 255) ^ ((row & 7) << 4); gK[p] = (unsigned)(row * LD_EVEN + (cb >> 1)); }
        { const int sub = o >> 9, w = (o & 511) >> 1, kk = (sub >> 2) * 8 + (w >> 5), c = (sub & 3) * 32 + (w & 31), k = (kk & ~0xC) | ((kk & 4) << 1) | ((kk & 8) >> 1); gV[p] = (unsigned)(k * LD_EVEN + c); } }
    const int vb0 = (int)(uintptr_t)V_lds + v_rd_base(lane);
    const int ntiles = U.nloc + 4;
    const int qrw = U.qr0 + (wid >> 1), qc = 32 * (wid & 1) + r32;
    const int cst = min(max(qc - 8, 0), 48), rsw = min(max(qrw - 4, 0), 24);
    float m0 = -1e30f, l0 = 0.f, m1 = -1e30f, l1 = 0.f;
    f32x16 oa[4] = {}, ob[DIFF ? 4 : 1] = {};
#define TILE_ROW(j) ((j) < U.nloc ? U.loc_row0 + 64 * (j) : U.ctx_row0 + 64 * ((j) - U.nloc))
#define SDMA(j, b) do { const bf16* base = P + (size_t)TILE_ROW(j) * LD_EVEN; _Pragma("unroll") for (int p = 0; p < 2; ++p) { \
        __builtin_amdgcn_global_load_lds((const unsigned*)(base + U.kcol + gK[p]), (LAS unsigned*)(K_lds + (b) * SHM_K + (2 * wid + p) * 1024), 16, 0, 0); \
        __builtin_amdgcn_global_load_lds((const unsigned*)(base + U.vcol + gV[p]), (LAS unsigned*)(V_lds + (b) * SHM_V + (2 * wid + p) * 1024), 16, 0, 0); } } while (0)
#define RESC(acc, n0, n1, a, slot) do { if (__any((a) < 1.f)) { if (hi == 0) wsc[(slot) * 32 + r32] = (a); asm volatile("s_waitcnt lgkmcnt(0)" ::: "memory"); \
        _Pragma("unroll") for (int r = 0; r < 16; ++r) { const float al = wsc[(slot) * 32 + crow(r, hi)]; _Pragma("unroll") for (int d = (n0); d < (n1); ++d) acc[d][r] *= al; } } } while (0)
    SDMA(0, 0); VM_WAIT(); __syncthreads();
    for (int j = 0; j < ntiles; ++j) {
        const int buf = j & 1;
        if (j + 1 < ntiles) SDMA(j + 1, buf ^ 1);
        const bool local = j < U.nloc;
        bool active = true; int kr = 0;
        if (!DIFF && U.na_local && local) { kr = U.kr0 + j; active = (kr >= rsw) && (kr < rsw + 8); }
        if (active) {
            const LAS char* Kb = K_lds + buf * SHM_K; const int vb = vb0 + buf * SHM_V;
            f32x16 p0, p1; bf16x8 pa0, pa1, pa2, pa3; float alpha;
            qkt_map<0, DIFF>(p0, p1, Kb, qr, ql, r32, hi);
            if (!DIFF && U.na_local && local) {
                const LAS float* bp = rpbx + (kr - qrw + 7) * 128 + (63 - qc + 4 * hi); const int vbs = 4 * hi - cst;
#pragma unroll
                for (int r = 0; r < 16; ++r) { const int kc0 = (r & 3) + 8 * (r >> 2);
                    p0[r] = ((unsigned)(vbs + kc0) < 16u) ? fmaf(p0[r], C, bp[kc0]) : -1e30f;
                    p1[r] = ((unsigned)(vbs + kc0 + 32) < 16u) ? fmaf(p1[r], C, bp[kc0 + 32]) : -1e30f; }
            } else if (!DIFF) {
#pragma unroll
                for (int r = 0; r < 16; ++r) { p0[r] *= C; p1[r] *= C; }
            }
            sm_step<DIFF>(p0, p1, m0, l0, alpha, pa0, pa1, pa2, pa3);
            if (DIFF) { RESC(oa, 0, 4, alpha, 0); pv_one<0>(oa[0], vb, pa0, pa1, pa2, pa3); pv_one<1>(oa[1], vb, pa0, pa1, pa2, pa3); pv_one<2>(oa[2], vb, pa0, pa1, pa2, pa3); pv_one<3>(oa[3], vb, pa0, pa1, pa2, pa3); }
            else      { RESC(oa, 0, 2, alpha, 0); pv_one<0>(oa[0], vb, pa0, pa1, pa2, pa3); pv_one<1>(oa[1], vb, pa0, pa1, pa2, pa3); }
            qkt_map<1, DIFF>(p0, p1, Kb, qr, ql, r32, hi);
            if (!DIFF && U.na_local && local) {
                const LAS float* bp = rpbx + 1920 + (kr - qrw + 7) * 128 + (63 - qc + 4 * hi); const int vbs = 4 * hi - cst;
#pragma unroll
                for (int r = 0; r < 16; ++r) { const int kc0 = (r & 3) + 8 * (r >> 2);
                    p0[r] = ((unsigned)(vbs + kc0) < 16u) ? fmaf(p0[r], C, bp[kc0]) : -1e30f;
                    p1[r] = ((unsigned)(vbs + kc0 + 32) < 16u) ? fmaf(p1[r], C, bp[kc0 + 32]) : -1e30f; }
            } else if (!DIFF) {
#pragma unroll
                for (int r = 0; r < 16; ++r) { p0[r] *= C; p1[r] *= C; }
            }
            sm_step<DIFF>(p0, p1, m1, l1, alpha, pa0, pa1, pa2, pa3);
            if (DIFF) { RESC(ob, 0, 4, alpha, 1); pv_one<0>(ob[0], vb, pa0, pa1, pa2, pa3); pv_one<1>(ob[1], vb, pa0, pa1, pa2, pa3); pv_one<2>(ob[2], vb, pa0, pa1, pa2, pa3); pv_one<3>(ob[3], vb, pa0, pa1, pa2, pa3); }
            else      { RESC(oa, 2, 4, alpha, 1); pv_one<2>(oa[2], vb, pa0, pa1, pa2, pa3); pv_one<3>(oa[3], vb, pa0, pa1, pa2, pa3); }
        }
        VM_WAIT(); __syncthreads();
    }
    if (hi == 0) { wsc[r32] = 1.0f / l0; wsc[32 + r32] = 1.0f / l1; }
    asm volatile("s_waitcnt lgkmcnt(0)" ::: "memory");
    bf16* Ow = Out + (size_t)(U.qrow0 + wid * 32) * 1024 + U.ocol;
    if (DIFF) {
        float gl[4];
#pragma unroll
        for (int d0 = 0; d0 < 4; ++d0) gl[d0] = subln_g[d0 * 32 + r32] * oscale;
#pragma unroll
        for (int r = 0; r < 16; ++r) { const int q = crow(r, hi); const float ra = wsc[q], rb = wsc[32 + q] * lam; float v[4], ss = 0.f;
#pragma unroll
            for (int d0 = 0; d0 < 4; ++d0) { v[d0] = oa[d0][r] * ra - ob[d0][r] * rb; ss += v[d0] * v[d0]; }
#pragma unroll
            for (int o = 0; o < 1; ++o) { ss += lx1(ss); ss += lx2(ss); ss += lx4(ss); ss += lx8(ss); ss = sw16sum(ss, ss); }
            const float rstd = 1.0f / sqrtf(ss * (1.0f / 128.0f) + NORM_EPS);
#pragma unroll
            for (int d0 = 0; d0 < 4; ++d0) Ow[(size_t)q * 1024 + d0 * 32 + r32] = (bf16)f2bf(v[d0] * rstd * gl[d0]); }
    } else {
#pragma unroll
        for (int r = 0; r < 16; ++r) { const int q = crow(r, hi); const float ra = wsc[q], rb = wsc[32 + q];
            Ow[(size_t)q * 1024 + r32] = (bf16)f2bf(oa[0][r] * ra); Ow[(size_t)q * 1024 + 32 + r32] = (bf16)f2bf(oa[1][r] * ra);
            Ow[(size_t)q * 1024 + 64 + r32] = (bf16)f2bf(oa[2][r] * rb); Ow[(size_t)q * 1024 + 96 + r32] = (bf16)f2bf(oa[3][r] * rb); }
    }
    __syncthreads();
#undef TILE_ROW
#undef SDMA
#undef RESC
}

__device__ __forceinline__ void attn_phase(Frame& F, int l) {
    const int ev = l >> 1;
    const bf16* P = (const bf16*)(F.ws + WS_P); bf16* O = (bf16*)(F.ws + WS_O);
    const float lam_init = 0.8f - 0.6f * expf(-0.3f * (float)l);
    const float* lv = F.diff_lambda + ev * 256;
    const float s01 = wave_sum(lv[F.lane] * lv[64 + F.lane]), s23 = wave_sum(lv[128 + F.lane] * lv[192 + F.lane]);
    const float lam = expf(s01) - expf(s23) + lam_init;
    const float* subln = F.diff_subln_g + ev * 128;
    const float* rpb = F.na_rpb + (size_t)ev * 8 * 465;
#pragma unroll 1
    for (int i = 0; i < 3; ++i) {
        UnitDesc U; U.na_local = 0; U.qr0 = 0; U.kr0 = 0; U.rpb_off = 0;
        if (i < 2) { const int u = F.vcu + 256 * i; if (u >= 512) break; const int b = u >> 5, h = (u >> 3) & 3, qb = u & 7;
            U.qrow0 = b * 2048 + qb * 256; U.nloc = 32; U.loc_row0 = b * 2048; U.ctx_row0 = RL + b * 256; U.qcol = 512 + h * 128; U.kcol = 2048 + h * 128; U.vcol = 2560 + h * 128; U.ocol = 512 + h * 128; }
        else { const int u = F.vcu; if (u >= 64) break; const int b = u >> 2, h = u & 3;
            U.qrow0 = RL + b * 256; U.nloc = 0; U.loc_row0 = 0; U.ctx_row0 = RL + b * 256; U.qcol = 512 + h * 128; U.kcol = 2048 + h * 128; U.vcol = 2560 + h * 128; U.ocol = 512 + h * 128; }
        attn_unit<true>(F.lds, P, O, U, rpb, lam, 1.0f - lam_init, subln, F.wave);
    }
#pragma unroll 1
    for (int i = 0; i < 3; ++i) {
        UnitDesc U;
        if (i < 2) { const int u = F.vcu + 256 * i; if (u >= 512) break; const int b = u >> 5, hp = (u >> 3) & 3, g = u & 7;
            const int krlo = min(max(4 * g - 4, 0), 24), krhi = min(max(4 * g + 3 - 4, 0), 24) + 7;
            U.qrow0 = b * 2048 + g * 256; U.nloc = krhi - krlo + 1; U.loc_row0 = b * 2048 + krlo * 64; U.ctx_row0 = RL + b * 256; U.qcol = hp * 128; U.kcol = 1024 + hp * 128; U.vcol = 1536 + hp * 128; U.ocol = hp * 128;
            U.na_local = 1; U.qr0 = 4 * g; U.kr0 = krlo; U.rpb_off = hp * 2 * 465; }
        else { const int u = F.vcu - 64; if (u < 0 || u >= 64) break; const int b = u >> 2, hp = u & 3;
            U.qrow0 = RL + b * 256; U.nloc = 0; U.loc_row0 = 0; U.ctx_row0 = RL + b * 256; U.qcol = hp * 128; U.kcol = 1024 + hp * 128; U.vcol = 1536 + hp * 128; U.ocol = hp * 128;
            U.na_local = 0; U.qr0 = 0; U.kr0 = 0; U.rpb_off = 0; }
        attn_unit<false>(F.lds, P, O, U, rpb, 0.f, 1.f, subln, F.wave);
    }
}
}


namespace scan {
typedef float f4 __attribute__((ext_vector_type(4)));
constexpr int QD_STRIDE = 272, KT_STRIDE = 80;
constexpr int OFF_QD = 0, OFF_KD = OFF_QD + 32 * QD_STRIDE, OFF_KLT = OFF_KD + 32 * QD_STRIDE, OFF_VT = OFF_KLT + 128 * KT_STRIDE, OFF_D = OFF_VT + 128 * KT_STRIDE, OFF_PT = OFF_D + 512, BUF_BYTES = OFF_PT + 2048;
__device__ __forceinline__ bf16x8 pack8(f4 a, f4 b) { v4u w; w.x = pg8::cvt_pk_bf16(a[0], a[1]); w.y = pg8::cvt_pk_bf16(a[2], a[3]); w.z = pg8::cvt_pk_bf16(b[0], b[1]); w.w = pg8::cvt_pk_bf16(b[2], b[3]); return __builtin_bit_cast(bf16x8, w); }
__device__ __forceinline__ bf16x8 ld2x8(const LAS char* p0, const LAS char* p1) { const v2u a = *(const LAS v2u*)p0, b = *(const LAS v2u*)p1; v4u w = {a.x, a.y, b.x, b.y}; return __builtin_bit_cast(bf16x8, w); }

__device__ __forceinline__ void scan_phase(Frame& F, int l) {
    const bf16* P = (const bf16*)(F.ws + WS_P);
    const int lane = F.lane, wid = F.wave, ln = lane & 15, g = lane >> 4;
    const bool prep = wid < 4; const int mw = wid - 4;
    const int d0 = 32 * (wid & 3) + 2 * (lane & 15), tg = lane >> 4;
    for (int u = F.vcu; u < 256; u += F.G) {
        const int b = u >> 4, h = (u >> 1) & 7, dir = u & 1, sgn = dir ? -1 : 1;
        bf16* Od = (bf16*)(F.ws + (dir ? WS_OB : WS_OF));
        float lbv[2];
#pragma unroll
        for (int cc = 0; cc < 2; ++cc) { const float* lg = F.rec_lb_logits + (size_t)dir * 4 * 1024 + h * 128 + d0 + cc; const float a0 = lg[0], a1 = lg[1024], a2 = lg[2048], a3 = lg[3072];
          const float mx = fmaxf(fmaxf(a0, a1), fmaxf(a2, a3)); const float e0 = expf(a0 - mx), e1 = expf(a1 - mx), e2 = expf(a2 - mx), e3 = expf(a3 - mx); const float inv = 1.0f / (e0 + e1 + e2 + e3);
          lbv[cc] = (l == 1) ? e1 * inv : (e1 + e2 + e3) * inv; }
        const float lb0 = lbv[0], lb1 = lbv[1], om0 = 1.0f - lb0, om1 = 1.0f - lb1;
        const int qcol = h * 128 + d0, fcol = (dir ? 2048 : 1024) + h * 128 + d0, vcol = 3072 + h * 128 + d0;
        f4 st[2][8];
#pragma unroll
        for (int s2 = 0; s2 < 2; ++s2)
#pragma unroll
            for (int k = 0; k < 8; ++k) st[s2][k] = (f4){0.f, 0.f, 0.f, 0.f};
        const int nchunks = 8 + 64;
        unsigned rq[8], rf[8], rv[8];
#define SROW0(c) ((c) < 8 ? (RL + b * 256 + (dir ? 255 - 32 * (c) : 32 * (c))) : (b * 2048 + (dir ? 2047 - 32 * ((c) - 8) : 32 * ((c) - 8))))
#define SLOADC(c) do { const unsigned rb_ = (unsigned)(SROW0(c) + sgn * 8 * tg) * (unsigned)(LD_ODD * 2); const unsigned rs_ = (unsigned)(sgn * LD_ODD * 2);     \
            _Pragma("unroll") for (int k = 0; k < 8; ++k) { const unsigned ro = rb_ + (unsigned)k * rs_; \
            rq[k] = *(const unsigned*)((const char*)P + (ro + 2u * (unsigned)qcol)); rf[k] = *(const unsigned*)((const char*)P + (ro + 2u * (unsigned)fcol)); rv[k] = *(const unsigned*)((const char*)P + (ro + 2u * (unsigned)vcol)); } } while (0)
        if (prep) SLOADC(0);
        for (int it = 0; it <= nchunks; ++it) {
            if (prep) {
                if (it < nchunks) {
                    const int c = it; LAS char* buf = (LAS char*)F.lds + (c & 1) * BUF_BYTES;
                    float kk0[8], kk1[8], lp0[8], lp1[8]; unsigned qp[8], vp[8];
                    { float run0 = 1.0f, run1 = 1.0f;
#pragma unroll
                      for (int k = 0; k < 8; ++k) { const float sg0 = bflo(rf[k]), sg1 = bfhi(rf[k]);
                          kk0[k] = om0 * (1.0f - sg0); kk1[k] = om1 * (1.0f - sg1); run0 *= lb0 + om0 * sg0; run1 *= lb1 + om1 * sg1; lp0[k] = run0; lp1[k] = run1; qp[k] = rq[k]; vp[k] = rv[k]; } }
                    if (c + 1 < nchunks) SLOADC(c + 1);
                    const float ta0 = px16(lp0[7], (tg & 1) != 0), ta1 = px16(lp1[7], (tg & 1) != 0); const float pp0 = lp0[7] * ta0, pp1 = lp1[7] * ta1;
                    const float pq0 = px32(pp0, (tg & 2) != 0), pq1 = px32(pp1, (tg & 2) != 0); const float plast0 = pp0 * pq0, plast1 = pp1 * pq1;
                    const float po0 = ((tg & 2) ? pq0 : 1.0f) * ((tg & 1) ? ta0 : 1.0f), po1 = ((tg & 2) ? pq1 : 1.0f) * ((tg & 1) ? ta1 : 1.0f);
                    float kl0[8], kl1[8];
#pragma unroll
                    for (int k = 0; k < 8; ++k) { const float p0 = po0 * lp0[k], p1 = po1 * lp1[k]; const float kd0 = kk0[k] * __builtin_amdgcn_rcpf(p0), kd1 = kk1[k] * __builtin_amdgcn_rcpf(p1);
                        kl0[k] = kd0 * plast0; kl1[k] = kd1 * plast1;
                        *(LAS unsigned*)(buf + OFF_QD + (8 * tg + k) * QD_STRIDE + 2 * d0) = pk2(bflo(qp[k]) * p0, bfhi(qp[k]) * p1);
                        *(LAS unsigned*)(buf + OFF_KD + (8 * tg + k) * QD_STRIDE + 2 * d0) = pk2(kd0, kd1); }
                    *(LAS v4u*)(buf + OFF_KLT + d0 * KT_STRIDE + 16 * tg) = (v4u){pk2(kl0[0], kl0[1]), pk2(kl0[2], kl0[3]), pk2(kl0[4], kl0[5]), pk2(kl0[6], kl0[7])};
                    *(LAS v4u*)(buf + OFF_KLT + (d0 + 1) * KT_STRIDE + 16 * tg) = (v4u){pk2(kl1[0], kl1[1]), pk2(kl1[2], kl1[3]), pk2(kl1[4], kl1[5]), pk2(kl1[6], kl1[7])};
                    *(LAS v4u*)(buf + OFF_VT + d0 * KT_STRIDE + 16 * tg) = (v4u){(vp[0] & 0xffffu) | (vp[1] << 16), (vp[2] & 0xffffu) | (vp[3] << 16), (vp[4] & 0xffffu) | (vp[5] << 16), (vp[6] & 0xffffu) | (vp[7] << 16)};
                    *(LAS v4u*)(buf + OFF_VT + (d0 + 1) * KT_STRIDE + 16 * tg) = (v4u){(vp[0] >> 16) | (vp[1] & 0xffff0000u), (vp[2] >> 16) | (vp[3] & 0xffff0000u), (vp[4] >> 16) | (vp[5] & 0xffff0000u), (vp[6] >> 16) | (vp[7] & 0xffff0000u)};
                    if (tg == 0) *(LAS v2u*)(buf + OFF_D + 4 * d0) = (v2u){__float_as_uint(plast0), __float_as_uint(plast1)};
                }
            } else if (it >= 1) {
                const int c = it - 1; const LAS char* buf = (const LAS char*)F.lds + (c & 1) * BUF_BYTES;
                const bool has_q = (c >= 8) || (l == 1);
                const LAS char* qd = buf + OFF_QD; const LAS char* kdp = buf + OFF_KD; const LAS char* klt = buf + OFF_KLT;
                const LAS char* vt0 = buf + OFF_VT + (32 * mw + ln) * KT_STRIDE; const LAS char* vt1 = vt0 + 16 * KT_STRIDE;
                if (has_q) {
                    f4 at00 = {0.f, 0.f, 0.f, 0.f}, at01 = at00, at11 = at00;
#pragma unroll
                    for (int ks = 0; ks < 4; ++ks) {
                        const bf16x8 kd0 = *(const LAS bf16x8*)(kdp + ln * QD_STRIDE + (32 * ks + 8 * g) * 2), kd1 = *(const LAS bf16x8*)(kdp + (16 + ln) * QD_STRIDE + (32 * ks + 8 * g) * 2);
                        const bf16x8 q0 = *(const LAS bf16x8*)(qd + ln * QD_STRIDE + (32 * ks + 8 * g) * 2), q1 = *(const LAS bf16x8*)(qd + (16 + ln) * QD_STRIDE + (32 * ks + 8 * g) * 2);
                        at00 = __builtin_amdgcn_mfma_f32_16x16x32_bf16(kd0, q0, at00, 0, 0, 0);
                        at01 = __builtin_amdgcn_mfma_f32_16x16x32_bf16(kd0, q1, at01, 0, 0, 0);
                        at11 = __builtin_amdgcn_mfma_f32_16x16x32_bf16(kd1, q1, at11, 0, 0, 0); }
#pragma unroll
                    for (int j = 0; j < 4; ++j) { const bool keep = (4 * g + j) <= ln; at00[j] = keep ? at00[j] : 0.f; at11[j] = keep ? at11[j] : 0.f; }
                    const bf16x8 a0p = pack8(at00, (f4){0.f, 0.f, 0.f, 0.f}), a1p = pack8(at01, at11);
                    const bf16x8 vp0 = ld2x8(vt0 + 8 * g, vt0 + 32 + 8 * g), vp1 = ld2x8(vt1 + 8 * g, vt1 + 32 + 8 * g);
                    f4 o00 = {0.f, 0.f, 0.f, 0.f}, o01 = o00, o10 = o00, o11 = o00;
                    o00 = __builtin_amdgcn_mfma_f32_16x16x32_bf16(a0p, vp0, o00, 0, 0, 0); o01 = __builtin_amdgcn_mfma_f32_16x16x32_bf16(a1p, vp0, o01, 0, 0, 0);
                    o10 = __builtin_amdgcn_mfma_f32_16x16x32_bf16(a0p, vp1, o10, 0, 0, 0); o11 = __builtin_amdgcn_mfma_f32_16x16x32_bf16(a1p, vp1, o11, 0, 0, 0);
#pragma unroll
                    for (int ks = 0; ks < 4; ++ks) {
                        const bf16x8 qa0 = ld2x8(qd + ln * QD_STRIDE + (32 * ks + 4 * g) * 2, qd + ln * QD_STRIDE + (32 * ks + 16 + 4 * g) * 2);
                        const bf16x8 qa1 = ld2x8(qd + (16 + ln) * QD_STRIDE + (32 * ks + 4 * g) * 2, qd + (16 + ln) * QD_STRIDE + (32 * ks + 16 + 4 * g) * 2);
                        const bf16x8 sb0 = pack8(st[0][2 * ks], st[0][2 * ks + 1]), sb1 = pack8(st[1][2 * ks], st[1][2 * ks + 1]);
                        o00 = __builtin_amdgcn_mfma_f32_16x16x32_bf16(qa0, sb0, o00, 0, 0, 0); o01 = __builtin_amdgcn_mfma_f32_16x16x32_bf16(qa1, sb0, o01, 0, 0, 0);
                        o10 = __builtin_amdgcn_mfma_f32_16x16x32_bf16(qa0, sb1, o10, 0, 0, 0); o11 = __builtin_amdgcn_mfma_f32_16x16x32_bf16(qa1, sb1, o11, 0, 0, 0); }
                    const int oc = h * 128 + 32 * mw + ln;
                    char* ob0 = (char*)Od + ((unsigned)(SROW0(c) + sgn * 4 * g) * 2048u + 2u * (unsigned)oc); const int ost = sgn * 2048;
#pragma unroll
                    for (int j = 0; j < 4; ++j) { bf16* r0 = (bf16*)(ob0 + j * ost); bf16* r1 = (bf16*)(ob0 + (16 + j) * ost);
                        r0[0] = (bf16)f2bf(o00[j]); r0[16] = (bf16)f2bf(o10[j]); r1[0] = (bf16)f2bf(o01[j]); r1[16] = (bf16)f2bf(o11[j]); }
                }
                { const bf16x8 vn0 = *(const LAS bf16x8*)(vt0 + 16 * g), vn1 = *(const LAS bf16x8*)(vt1 + 16 * g);
#pragma unroll
                  for (int kt = 0; kt < 8; ++kt) { const f4 dd = *(const LAS f4*)(buf + OFF_D + (16 * kt + 4 * g) * 4);
                      const bf16x8 ka = *(const LAS bf16x8*)(klt + (16 * kt + ln) * KT_STRIDE + 16 * g);
                      st[0][kt] = __builtin_amdgcn_mfma_f32_16x16x32_bf16(ka, vn0, st[0][kt] * dd, 0, 0, 0);
                      st[1][kt] = __builtin_amdgcn_mfma_f32_16x16x32_bf16(ka, vn1, st[1][kt] * dd, 0, 0, 0); } }
            }
            asm volatile("s_waitcnt lgkmcnt(0)" ::: "memory"); __builtin_amdgcn_s_barrier(); asm volatile("" ::: "memory");
        }
        __syncthreads();
#undef SROW0
#undef SLOADC
    }
}

__device__ __forceinline__ void scan_combine_phase(Frame& F, int l) {
    const int nrows = (l == 3) ? RL : RT, per = nrows / (F.G * NWAVES), gw = F.vcu * NWAVES + F.wave, lane = F.lane;
    const bf16* OFp = (const bf16*)(F.ws + WS_OF); const bf16* OBp = (const bf16*)(F.ws + WS_OB); const bf16* P = (const bf16*)(F.ws + WS_P); bf16* O = (bf16*)(F.ws + WS_O);
    const float* gn = F.rec_gnorm_g + (size_t)(l >> 1) * 128;
    f32x4 gv[4];
#pragma unroll
    for (int j = 0; j < 4; ++j) gv[j] = *(const f32x4*)(gn + ((256 * j + 4 * lane) & 127));
    v2u na[4], nb[4], ng[4];
#define CLOAD(r) do { _Pragma("unroll") for (int j = 0; j < 4; ++j) { const int col = 256 * j + 4 * lane; na[j] = *(const v2u*)(OFp + (size_t)(r) * 1024 + col); nb[j] = *(const v2u*)(OBp + (size_t)(r) * 1024 + col); ng[j] = *(const v2u*)(P + (size_t)(r) * LD_ODD + 4096 + col); } } while (0)
    CLOAD(gw * per);
    for (int rr = 0; rr < per; ++rr) {
        const int row = gw * per + rr;
        v2u ca[4], cb[4], cg[4];
#pragma unroll
        for (int j = 0; j < 4; ++j) { ca[j] = na[j]; cb[j] = nb[j]; cg[j] = ng[j]; }
        if (rr + 1 < per) CLOAD(row + 1);
        f32x4 v[4]; float ss[4];
#pragma unroll
        for (int j = 0; j < 4; ++j) { const v2u a = ca[j], b2 = cb[j];
            v[j] = (f32x4){bflo(a.x) + bflo(b2.x), bfhi(a.x) + bfhi(b2.x), bflo(a.y) + bflo(b2.y), bfhi(a.y) + bfhi(b2.y)};
            ss[j] = (v[j].x * v[j].x + v[j].y * v[j].y) + (v[j].z * v[j].z + v[j].w * v[j].w); }
#pragma unroll
        for (int j = 0; j < 4; ++j) ss[j] += lx1(ss[j]);
#pragma unroll
        for (int j = 0; j < 4; ++j) ss[j] += lx2(ss[j]);
#pragma unroll
        for (int j = 0; j < 4; ++j) ss[j] += lx4(ss[j]);
#pragma unroll
        for (int j = 0; j < 4; ++j) ss[j] += lx8(ss[j]);
#pragma unroll
        for (int j = 0; j < 4; ++j) ss[j] = sw16sum(ss[j], ss[j]);
#pragma unroll
        for (int j = 0; j < 4; ++j) { const int col = 256 * j + 4 * lane; const v2u gg = cg[j];
            const float rstd = 1.0f / sqrtf(ss[j] * (1.0f / 128.0f) + NORM_EPS);
            const f32x4 sg = (f32x4){bflo(gg.x), bfhi(gg.x), bflo(gg.y), bfhi(gg.y)};
            const f32x4 r = v[j] * rstd * gv[j] * sg; v2u w; w.x = pk2(r.x, r.y); w.y = pk2(r.z, r.w);
            *(v2u*)(O + (size_t)row * 1024 + col) = w; }
    }
#undef CLOAD
}
}


constexpr int NPH = 38;
#ifndef DBG_STOP
#define DBG_STOP 37
#endif
#ifndef DBG_FINAL_LP
#define DBG_FINAL_LP 3
#endif
#ifndef DBG_FINAL_XIN
#define DBG_FINAL_XIN 0
#endif
#ifndef REP_P0
#define REP_P0 1
#define REP_INP 1
#define REP_ATT 1
#define REP_SCAN 1
#define REP_N1 1
#define REP_SEL 1
#define XTRA_BAR 0
#define SEL_EXTRA 1
#define REP_G1 1
#define REP_G2 1
#define REP_FIN 1
#endif
#ifndef MK_ONE_LAUNCH
#define MK_ONE_LAUNCH 1
#endif
struct Args { const float* in[21]; float* out; unsigned char* ws; int ph_lo, ph_hi; };
__global__ void __launch_bounds__(NTHR, 2) fwd_kernel(Args args) {
    extern __shared__ __attribute__((aligned(16))) unsigned char lds_raw[];
    Frame F;
    F.lds = (LAS unsigned char*)lds_raw;
    const int wave0 = __builtin_amdgcn_readfirstlane((int)threadIdx.x >> 6);
    F.tid = threadIdx.x; F.lane = F.tid & 63; F.wave = wave0;
    const int G0 = gridDim.x; F.G = G0; const int bx0 = blockIdx.x; const int vcu0 = (F.G % 8 == 0) ? (bx0 % 8) * (F.G / 8) + bx0 / 8 : bx0; F.vcu = vcu0; int bx = bx0, wv = 0;
    F.x_in = (const float*)(GAS const float*)args.in[0]; F.c_in = (const float*)(GAS const float*)args.in[1]; F.ctx_in = (const float*)(GAS const float*)args.in[2]; F.cctx_in = (const float*)(GAS const float*)args.in[3]; F.w_mod = (const float*)(GAS const float*)args.in[4]; F.b_mod = (const float*)(GAS const float*)args.in[5]; F.norm_g = (const float*)(GAS const float*)args.in[6]; F.att_w_in = (const float*)(GAS const float*)args.in[7]; F.att_w_out = (const float*)(GAS const float*)args.in[8];
    F.na_rpb = (const float*)(GAS const float*)args.in[9]; F.diff_lambda = (const float*)(GAS const float*)args.in[10]; F.diff_subln_g = (const float*)(GAS const float*)args.in[11]; F.rec_w_in = (const float*)(GAS const float*)args.in[12]; F.rec_w_out = (const float*)(GAS const float*)args.in[13]; F.rec_lb_logits = (const float*)(GAS const float*)args.in[14]; F.rec_gnorm_g = (const float*)(GAS const float*)args.in[15];
    F.moe_router = (const float*)(GAS const float*)args.in[16]; F.moe_w_gate = (const float*)(GAS const float*)args.in[17]; F.moe_w_up = (const float*)(GAS const float*)args.in[18]; F.moe_w_down = (const float*)(GAS const float*)args.in[19]; F.final_g = (const float*)(GAS const float*)args.in[20];
    F.out = (float*)(GAS float*)args.out; F.ws = (unsigned char*)(GAS unsigned char*)args.ws;
    volatile LAS unsigned* MISC = (volatile LAS unsigned*)(F.lds + MISC_OFF);
    if (F.tid < 32) MISC[F.tid] = 0u;
    __syncthreads();
    const int lo = args.ph_lo, hi = args.ph_hi;
    XcdBarrier bar; bar.bar = (unsigned*)(F.ws + WS_CTL) + CW_BAR; bar.x = 0; bar.st = nullptr;
    if (MK_ONE_LAUNCH || hi - lo > 1) bar = xcd_barrier_post((unsigned*)(F.ws + WS_CTL) + CW_BAR, MISC + 8);
#if MK_ONE_LAUNCH
#define IN(p) true
#else
#define IN(p) (lo <= (p) && (p) < hi)
#endif
#define REFRESH() do { int l_; asm volatile("v_mbcnt_lo_u32_b32 %0, -1, 0\n\tv_mbcnt_hi_u32_b32 %0, -1, %0" : "=v"(l_)); int w_ = wave0, v_ = vcu0, b_ = bx0, g_ = G0; GAS unsigned char* ws_ = (GAS unsigned char*)args.ws; asm volatile("" : "+s"(w_), "+s"(v_), "+s"(b_), "+s"(g_), "+s"(ws_)); \
        F.lane = l_; F.wave = w_; F.tid = w_ * 64 + l_; F.vcu = v_; F.G = g_; F.ws = (unsigned char*)ws_; bx = b_; wv = w_; } while (0)
#define BARRIER() do { unsigned x_ = bar.x; unsigned* b_ = bar.bar; asm volatile("" : "+s"(x_), "+s"(b_)); XcdBarrier bb_; bb_.bar = b_; bb_.x = x_; bb_.st = bar.st; xcd_barrier(bb_); } while (0)
#define SEAM(p) do { if (IN(p) && IN((p) + 1)) { BARRIER(); for (int xb_ = 0; xb_ < XTRA_BAR; ++xb_) BARRIER(); } } while (0)
#define REPEAT(n, ...) do { for (int rep_ = 0; rep_ < (n); ++rep_) { __VA_ARGS__; if (rep_ + 1 < (n)) BARRIER(); } } while (0)
#define H ((bf16*)(F.ws + WS_H))
#define P ((bf16*)(F.ws + WS_P))
#define O ((bf16*)(F.ws + WS_O))
#define X ((bf16*)(F.ws + WS_X))
#define mod ((const float*)(F.ws + WS_MOD))

    if (IN(0)) REPEAT(REP_P0, { REFRESH(); p0_prologue(F); VM_WAIT(); __syncthreads(); });
    SEAM(0);
#pragma unroll 1
    for (int l = 0; l < DEPTH; ++l) {
        const int pb = 1 + 9 * l; const bool odd = (l & 1) != 0; const int ev = l >> 1;
        if (IN(pb + 0)) { REFRESH(); if (l == 0) norm_phase<0>(F, l); else combine_norm_phase<false>(F, l, l - 1); }
        SEAM(pb + 0);
        if (IN(pb + 1)) REPEAT(REP_INP, { REFRESH();
            if (!odd) { pg8::Gemm g{H, (const bf16*)(F.ws + WS_WATT_IN + (size_t)ev * 3072 * 1024 * (IN8E ? 1 : 2)), RT, 3072, IN8E ? 512 : 1024}; pg8::RectOrder S; S.init(144, 12, 0, 0, 0, 0, 0, 0, F.G, bx);
                pg8::EpiEvenIn<IN8E> E{P}; pg8::gemm_phase<pg8::EpiEvenIn<IN8E>, pg8::RectOrder, true, true, IN8E>(F.lds, g, S, E, wv); }
            else {
                { pg8::Gemm g{H, (const bf16*)(F.ws + WS_WREC_IN) + (size_t)ev * 5120 * 1024, RT, 5120, 1024}; pg8::Rect3Order S;
                  if (l == 1) S.init(144, 4, 0, 0, 144, 8, 0, 12, 0, 0, 0, 0, F.G, bx); else S.init(128, 4, 0, 0, 144, 4, 0, 12, 128, 4, 0, 16, F.G, bx);
                  pg8::EpiOddIn<false> E{P, 0}; pg8::gemm_phase<pg8::EpiOddIn<false>, pg8::Rect3Order, true, true>(F.lds, g, S, E, wv); }
                VM_WAIT(); __syncthreads(); REFRESH();
                { pg8::Gemm g{(const bf16*)(F.ws + WS_H8O), (const bf16*)(F.ws + WS_WREC_F8 + (size_t)ev * 2048 * 1024), RT, 2048, 512}; pg8::RectOrder S; S.init(144, 8, 0, 0, 0, 0, 0, 0, F.G, (bx + 128) & 255);
                  pg8::EpiOddIn<true> E{P, 4}; pg8::gemm_phase<pg8::EpiOddIn<true>, pg8::RectOrder, true, true, true>(F.lds, g, S, E, wv); } }
            tail_convert(F, l, 0, bx);
        });
        SEAM(pb + 1);
        if (IN(pb + 2)) REPEAT(odd ? REP_SCAN : REP_ATT, { REFRESH(); if (!odd) { att::attn_phase(F, l); REFRESH(); tail_convert(F, l, 4, F.vcu); } else scan::scan_phase(F, l); });
        SEAM(pb + 2);
        if (IN(pb + 3) && odd) { REFRESH(); scan::scan_combine_phase(F, l); }
        if (odd) SEAM(pb + 3);
        if (IN(pb + 4)) { REFRESH();
            pg8::Gemm g{O, (const bf16*)(F.ws + (odd ? WS_WREC_OUT : WS_WATT_OUT)) + (size_t)ev * 1024 * 1024, RT, 1024, 1024}; pg8::RectOrder S; S.init(l < 3 ? 144 : 128, 4, 0, 0, 0, 0, 0, 0, F.G, bx);
            pg8::EpiOutRes E{F.x_in, F.ctx_in, X, mod + (size_t)l * 17 * 6144 + 2 * 1024, l == 0};
            pg8::gemm_phase<pg8::EpiOutRes, pg8::RectOrder, true, true>(F.lds, g, S, E, wv);
            tail_convert(F, l, 1, bx);
        }
        SEAM(pb + 4);
        if (IN(pb + 5)) REPEAT(REP_N1, { REFRESH(); router_norm_phase(F, l); });
        SEAM(pb + 5);
        if (IN(pb + 6)) REPEAT(REP_SEL, { REFRESH(); tail_convert(F, l, 3, F.vcu); REFRESH(); select_phase(F, l, 1); });
        SEAM(pb + 6);
        if (IN(pb + 7)) REPEAT(REP_G1, { REFRESH();
            pg8::Gemm g{H, (const bf16*)(F.ws + WS_WMOE1 + (size_t)l * 16 * 4096 * 1024), XR, 4096, 512}; pg8::MoeOrder S; S.init(l < 3 ? 18 : 16, 16, F.G, bx);
            pg8::EpiSwiGLU E{(unsigned char*)P}; pg8::gemm_phase<pg8::EpiSwiGLU, pg8::MoeOrder, true, true, true, true>(F.lds, g, S, E, wv, (const unsigned short*)(F.ws + WS_IDX), (LAS unsigned short*)(F.lds + 131072));
        });
        SEAM(pb + 7);
        if (IN(pb + 8)) REPEAT(REP_G2, { REFRESH();
            pg8::Gemm g{P, (const bf16*)(F.ws + WS_WMOE2 + (size_t)l * 16 * 1024 * 2048), XR, 1024, 1024}; pg8::MoeOrder S; S.init(l < 3 ? 18 : 16, 4, F.G, bx);
            pg8::EpiDown E{F.ws + WS_O, (const float*)(F.ws + WS_GATE)}; pg8::gemm_phase<pg8::EpiDown, pg8::MoeOrder, true, true, true>(F.lds, g, S, E, wv);
            tail_convert(F, l, 2, bx);
        });
        SEAM(pb + 8);
    }
    if (IN(37)) REPEAT(REP_FIN, { REFRESH(); combine_norm_phase<true>(F, 0, 3); });
#undef IN
#undef H
#undef P
#undef O
#undef X
#undef mod
#undef REFRESH
#undef SEAM
#undef BARRIER
#undef REPEAT
}

extern "C" void kernel_launch(void* const* d_in, const int* in_sizes, int n_in, void* d_out, int out_size, void* d_ws, size_t ws_size, hipStream_t stream) {
    static int grid = 0;
    if (grid == 0) {
        if (n_in != 21 || in_sizes[0] != RL * 1024 || out_size != RL * 1024 || ws_size < WS_END) { fprintf(stderr, "kernel_launch: unexpected shapes (n_in %d, in0 %d, out %d, ws %zu; need ws >= %zu); nothing launched\n", n_in, n_in > 0 ? in_sizes[0] : -1, out_size, ws_size, (size_t)WS_END); grid = -1; return; }
        int dev = 0, cus = 0, per_cu = 0;
        if (hipGetDevice(&dev) != hipSuccess || hipDeviceGetAttribute(&cus, hipDeviceAttributeMultiprocessorCount, dev) != hipSuccess) { fprintf(stderr, "kernel_launch: device query failed\n"); grid = -1; return; }
        if (hipFuncSetAttribute((const void*)fwd_kernel, hipFuncAttributeMaxDynamicSharedMemorySize, LDS_BYTES) != hipSuccess) { fprintf(stderr, "kernel_launch: hipFuncSetAttribute failed\n"); grid = -1; return; }
        if (hipOccupancyMaxActiveBlocksPerMultiprocessor(&per_cu, (const void*)fwd_kernel, NTHR, LDS_BYTES) != hipSuccess || per_cu < 1) fprintf(stderr, "kernel_launch: note: occupancy query reports %d workgroups per CU\n", per_cu);
        (void)hipGetLastError();
        if (cus != 256) { fprintf(stderr, "kernel_launch: built for a 256-CU device, found %d CUs; nothing launched\n", cus); grid = -1; return; }
        grid = 256;
    }
    if (grid < 0) return;
    if (hipMemsetAsync((char*)d_ws + WS_CTL, 0, CTL_ZERO_BYTES, stream) != hipSuccess) { fprintf(stderr, "kernel_launch: memset failed\n"); return; }
    Args a{};
    for (int i = 0; i < 21; ++i) a.in[i] = (const float*)d_in[i];
    a.out = (float*)d_out; a.ws = (unsigned char*)d_ws;
#if MK_ONE_LAUNCH
    a.ph_lo = 0; a.ph_hi = NPH;
    hipLaunchKernelGGL(fwd_kernel, dim3(grid), dim3(NTHR), LDS_BYTES, stream, a);
#else
    for (int p = 0; p < NPH; ++p) {
        if (p >= DBG_STOP && p != 37) continue;
        if (p >= 1 && p < 37 && ((p - 1) % 9) == 3 && ((((p - 1) / 9) & 1) == 0)) continue;
        a.ph_lo = p; a.ph_hi = p + 1;
        hipLaunchKernelGGL(fwd_kernel, dim3(grid), dim3(NTHR), LDS_BYTES, stream, a);
    }
#endif
    const hipError_t le = hipPeekAtLastError();
    if (le != hipSuccess) fprintf(stderr, "kernel_launch: launch failed: %s\n", hipGetErrorName(le));
}
```
